# Optimizing an MI355X kernel written in HIP

```python
import math
import jax, jax.numpy as jnp
from jax import lax
import numpy as np

D_MODEL = 1024
BATCH = 1
SEQ = 16384
DEPTH = 1

N_META = 16
HEAD_DIM = 64
N_HEADS = 8
N_KV_HEADS = 2
Q_PER_KV = N_HEADS // N_KV_HEADS
ATTN_W = N_HEADS * HEAD_DIM
KV_W = N_KV_HEADS * HEAD_DIM
F_GROUPS = 8
F_GROUP_DIM = 64
F_W = F_GROUPS * F_GROUP_DIM
MIX_W = ATTN_W + F_W
IN_W = ATTN_W + 2 * KV_W + F_W
WINDOW = 128
BLOCK = 128
D_FF = 2816
ALIBI_MAX = 8.0
EPS = 1e-6
NEG = -1e30

kernel_name = "hybrid_swa_fnet_macaron_encoder"


def rms_norm(x, g):
    xf = x.astype(jnp.float32)
    y = xf * lax.rsqrt(jnp.mean(xf * xf, axis=-1, keepdims=True) + EPS)
    return (y * g.astype(jnp.float32)).astype(x.dtype)


def swiglu(x, w_gate, w_up, w_down):
    return (jax.nn.silu(x @ w_gate) * (x @ w_up)) @ w_down


def alibi_slopes():
    h = jnp.arange(1, N_HEADS + 1, dtype=jnp.float32)
    return jnp.exp2(-ALIBI_MAX * h / N_HEADS)


def windowed_gqa(q, k, v, sink):
    B = q.shape[0]
    slopes = alibi_slopes().reshape(N_KV_HEADS, Q_PER_KV)
    sink_f = sink.astype(jnp.float32).reshape(N_KV_HEADS, Q_PER_KV)
    scale = HEAD_DIM ** -0.5

    qm, qr = q[:, :N_META], q[:, N_META:]
    km, kr = k[:, :N_META], k[:, N_META:]
    vm, vr = v[:, :N_META], v[:, N_META:]
    S = qr.shape[1]
    nb = S // BLOCK

    qb = qr.reshape(B, nb, BLOCK, N_KV_HEADS, Q_PER_KV, HEAD_DIM)
    pad = ((0, 0), (BLOCK, BLOCK), (0, 0), (0, 0))
    kp = jnp.pad(kr, pad).reshape(B, nb + 2, BLOCK, N_KV_HEADS, HEAD_DIM)
    vp = jnp.pad(vr, pad).reshape(B, nb + 2, BLOCK, N_KV_HEADS, HEAD_DIM)
    kb = jnp.concatenate([kp[:, :-2], kp[:, 1:-1], kp[:, 2:]], axis=2)
    vb = jnp.concatenate([vp[:, :-2], vp[:, 1:-1], vp[:, 2:]], axis=2)

    tpos = N_META + jnp.arange(S).reshape(nb, BLOCK)
    kpos = N_META + (jnp.arange(nb)[:, None] - 1) * BLOCK + jnp.arange(3 * BLOCK)[None]
    dist = jnp.abs(tpos[:, :, None] - kpos[:, None, :])
    valid = (dist <= WINDOW) & (kpos[:, None, :] >= N_META) & (kpos[:, None, :] < N_META + S)
    bias_band = jnp.where(valid[:, None, None],
                          -slopes[None, :, :, None, None] * dist[:, None, None].astype(jnp.float32),
                          NEG)
    mpos = jnp.arange(N_META)
    dist_m = jnp.minimum(jnp.abs(tpos[:, :, None] - mpos[None, None, :]), WINDOW)
    bias_meta = -slopes[None, :, :, None, None] * dist_m[:, None, None].astype(jnp.float32)

    s_band = jnp.einsum('bnqkgd,bnskd->bnkgqs', qb, kb).astype(jnp.float32) * scale + bias_band[None]
    s_meta = jnp.einsum('bnqkgd,bmkd->bnkgqm', qb, km).astype(jnp.float32) * scale + bias_meta[None]
    s_sink = jnp.broadcast_to(sink_f[None, None, :, :, None, None], s_meta.shape[:-1] + (1,))
    p = jax.nn.softmax(jnp.concatenate([s_meta, s_band, s_sink], axis=-1), axis=-1)
    p_meta = p[..., :N_META].astype(v.dtype)
    p_band = p[..., N_META:N_META + 3 * BLOCK].astype(v.dtype)
    out_r = (jnp.einsum('bnkgqm,bmkd->bnqkgd', p_meta, vm)
             + jnp.einsum('bnkgqs,bnskd->bnqkgd', p_band, vb))
    out_r = out_r.reshape(B, S, ATTN_W)

    qmm = qm.reshape(B, N_META, N_KV_HEADS, Q_PER_KV, HEAD_DIM)
    kr0, vr0 = kr[:, :WINDOW], vr[:, :WINDOW]
    rpos = N_META + jnp.arange(WINDOW)
    d_mm = jnp.abs(mpos[:, None] - mpos[None, :]).astype(jnp.float32)
    d_mr = jnp.abs(mpos[:, None] - rpos[None, :])
    b_mm = -slopes[:, :, None, None] * d_mm[None, None]
    b_mr = jnp.where((d_mr <= WINDOW)[None, None],
                     -slopes[:, :, None, None] * d_mr[None, None].astype(jnp.float32), NEG)
    s_mm = jnp.einsum('bqkgd,bmkd->bkgqm', qmm, km).astype(jnp.float32) * scale + b_mm[None]
    s_mr = jnp.einsum('bqkgd,bskd->bkgqs', qmm, kr0).astype(jnp.float32) * scale + b_mr[None]
    s_ms = jnp.broadcast_to(sink_f[None, :, :, None, None], s_mm.shape[:-1] + (1,))
    pm = jax.nn.softmax(jnp.concatenate([s_mm, s_mr, s_ms], axis=-1), axis=-1)
    out_m = (jnp.einsum('bkgqm,bmkd->bqkgd', pm[..., :N_META].astype(v.dtype), vm)
             + jnp.einsum('bkgqs,bskd->bqkgd', pm[..., N_META:N_META + WINDOW].astype(v.dtype), vr0))
    out_m = out_m.reshape(B, N_META, ATTN_W)
    return jnp.concatenate([out_m, out_r], axis=1)


def fourier_mix(f):
    B, L, _ = f.shape
    ff = f.astype(jnp.float32).reshape(B, L, F_GROUPS, F_GROUP_DIM)
    y = jnp.fft.fft2(ff, axes=(1, 3), norm="ortho").real
    return y.reshape(B, L, F_W).astype(f.dtype)


def setup_inputs(seed: int = 0) -> dict:
    key = jax.random.key(seed)
    ks = jax.random.split(key, 24)
    f32 = jnp.float32

    def nrm(k, shape, scale):
        return jax.random.normal(k, shape, f32) * scale

    def gain(k, n):
        return 1.0 + 0.05 * jax.random.normal(k, (n,), f32)

    return {
        "x": jax.random.normal(ks[0], (BATCH, SEQ, D_MODEL), f32),
        "meta_tokens": nrm(ks[1], (N_META, D_MODEL), 1.0),
        "ffn1_norm": gain(ks[2], D_MODEL),
        "ffn1_w_gate": nrm(ks[3], (D_MODEL, D_FF), D_MODEL ** -0.5),
        "ffn1_w_up": nrm(ks[4], (D_MODEL, D_FF), D_MODEL ** -0.5),
        "ffn1_w_down": nrm(ks[5], (D_FF, D_MODEL), D_FF ** -0.5),
        "mix_norm": gain(ks[6], D_MODEL),
        "w_in": nrm(ks[7], (D_MODEL, IN_W), D_MODEL ** -0.5),
        "q_norm": gain(ks[8], HEAD_DIM),
        "k_norm": gain(ks[9], HEAD_DIM),
        "sink": nrm(ks[10], (N_HEADS,), 0.5),
        "attn_out_norm": gain(ks[11], ATTN_W),
        "fourier_out_norm": gain(ks[12], F_W),
        "w_out": nrm(ks[13], (MIX_W, D_MODEL), MIX_W ** -0.5),
        "ffn2_norm": gain(ks[14], D_MODEL),
        "ffn2_w_gate": nrm(ks[15], (D_MODEL, D_FF), D_MODEL ** -0.5),
        "ffn2_w_up": nrm(ks[16], (D_MODEL, D_FF), D_MODEL ** -0.5),
        "ffn2_w_down": nrm(ks[17], (D_FF, D_MODEL), D_FF ** -0.5),
        "final_norm": gain(ks[18], D_MODEL),
    }


def reference(x, meta_tokens, ffn1_norm, ffn1_w_gate, ffn1_w_up, ffn1_w_down,
              mix_norm, w_in, q_norm, k_norm, sink, attn_out_norm, fourier_out_norm,
              w_out, ffn2_norm, ffn2_w_gate, ffn2_w_up, ffn2_w_down, final_norm):
    B = x.shape[0]
    meta = jnp.broadcast_to(meta_tokens[None].astype(x.dtype), (B, N_META, D_MODEL))
    h = jnp.concatenate([meta, x], axis=1)
    L = h.shape[1]

    for _ in range(DEPTH):
        h = h + 0.5 * swiglu(rms_norm(h, ffn1_norm), ffn1_w_gate, ffn1_w_up, ffn1_w_down)

        u = rms_norm(h, mix_norm) @ w_in
        q = u[..., :ATTN_W].reshape(B, L, N_HEADS, HEAD_DIM)
        k = u[..., ATTN_W:ATTN_W + KV_W].reshape(B, L, N_KV_HEADS, HEAD_DIM)
        v = u[..., ATTN_W + KV_W:ATTN_W + 2 * KV_W].reshape(B, L, N_KV_HEADS, HEAD_DIM)
        f = u[..., ATTN_W + 2 * KV_W:]
        q = rms_norm(q, q_norm)
        k = rms_norm(k, k_norm)

        a_out = windowed_gqa(q, k, v, sink)
        f_out = fourier_mix(f)
        mixed = jnp.concatenate([rms_norm(a_out, attn_out_norm),
                                 rms_norm(f_out, fourier_out_norm)], axis=-1)
        h = h + mixed @ w_out

        h = h + 0.5 * swiglu(rms_norm(h, ffn2_norm), ffn2_w_gate, ffn2_w_up, ffn2_w_down)
        h = rms_norm(h, final_norm)

    return h[:, N_META:]
```

```cpp
#include <hip/hip_runtime.h>
#include <hip/hip_cooperative_groups.h>
#include <cstdio>
#include <cstdint>
namespace cg = cooperative_groups;
namespace pg8 {
#define PG8_LAS __attribute__((address_space(3)))
typedef unsigned short bf16_t;
typedef short bf16x8 __attribute__((ext_vector_type(8)));
typedef float f32x4 __attribute__((ext_vector_type(4)));
typedef unsigned u32x4 __attribute__((ext_vector_type(4)));
constexpr int BM = 256, BK = 64, HALF = 128, HTB = HALF * BK * 2  , STAGE_BYTES = 8 * HTB, NXCD = 8, WGM = 8;

__host__ __device__ __forceinline__ int lds_byte(int r, int c) { const int st = (r >> 4) * 2 + (c >> 5), rr = r & 15, cc = c & 31, ob = rr * 64 + cc * 2; return st * 1024 + (ob ^ (((ob >> 9) & 1) << 5)); }
__host__ __device__ __forceinline__ void stage_rc(int b, int& R, int& C) { const int st = b / 1024, sb = b % 1024, swz = sb ^ (((sb >> 9) & 1) << 5); R = (st >> 1) * 16 + swz / 64; C = (st & 1) * 32 + (swz % 64) / 2; }
__host__ __device__ __forceinline__ int perm32(int rho) { const int n = rho >> 4, i = rho & 15; return 8 * (i >> 2) + 4 * n + (i & 3); }

struct Unit { int pm, pn; };
struct Gemm { const bf16_t* A; const bf16_t* Bt; int M, N, K; };

struct StaticOrder {
    int nM, nN, nwg, G, c;
    __host__ __device__ void init(int M, int N, int G_, int c_) { nM = M / BM; nN = N / BM; nwg = nM * nN; G = G_; c = c_; }
    __host__ __device__ bool next(int i, Unit& u) const {
        const long L = (long)i * G + c; if (L >= nwg) return false;
        int wgid = (int)L; { const int q = nwg / NXCD, r = nwg % NXCD, xcd = wgid % NXCD, off = wgid / NXCD; wgid = (xcd < r ? xcd * (q + 1) : r * (q + 1) + (xcd - r) * q) + off; }
        const int nig = WGM * nN, gid = wgid / nig, fm = gid * WGM, gsz = (nM - fm) < WGM ? (nM - fm) : WGM;
        u.pm = fm + ((wgid % nig) % gsz); u.pn = (wgid % nig) / gsz; return true;
    }
    __device__ __forceinline__ void a_ready(const Unit&) const {}
    __device__ __forceinline__ void done(const Unit&) const {}
};
__device__ __forceinline__ unsigned cvt_pk_bf16(float lo, float hi) { unsigned r; asm volatile("v_cvt_pk_bf16_f32 %0, %1, %2" : "=v"(r) : "v"(lo), "v"(hi)); return r; }
typedef float f32x2 __attribute__((ext_vector_type(2)));
template <class Epi, class Sched, bool ALIGN_EPI = false, bool SP2 = false>
__device__ __forceinline__ void gemm_phase(PG8_LAS unsigned char* lds, const Gemm g, const Sched& S, const Epi& E) {
    int tid_ = threadIdx.x; asm volatile("" : "+v"(tid_));
    const int tid = tid_, wid = __builtin_amdgcn_readfirstlane(tid >> 6), lane = tid & 63, wr = wid >> 2, wc = wid & 3, fr = lane & 15, fq = lane >> 4;
    const int K = g.K, nt = K / BK;
    unsigned voffA[2], voffB[2];
#pragma unroll
    for (int i = 0; i < 2; ++i) { int R, C; stage_rc(tid * 16 + i * 8192, R, C); const int Rb = Epi::PERM ? ((R & ~31) + perm32(R & 31)) : R;
        voffA[i] = (unsigned)(R * K + C) * 2u; voffB[i] = (unsigned)(Rb * K + C) * 2u; }
    const size_t kstep = (size_t)(BK * 2);
    const size_t hstep = (size_t)HALF * K * 2;
    const size_t tstep = 2 * hstep;
    const unsigned ldsw = (unsigned)wid * 1024u;
    const int aoff = lds_byte(wr * 64 + fr, fq * 8), boff = lds_byte(wc * 32 + fr, fq * 8);
#define PG8_SA(b, h) (((b) * 2 + (h)) * HTB)
#define PG8_SB(b, h) ((4 + (b) * 2 + (h)) * HTB)
#define PG8_STAGE(bufoff, gbase, voff) do { _Pragma("unroll") for (int _i = 0; _i < 2; ++_i) \
        __builtin_amdgcn_global_load_lds((const unsigned*)((const char*)(gbase) + (voff)[_i]), (PG8_LAS unsigned*)(lds + (bufoff) + ldsw + _i * 8192), 16, 0, 0); } while (0)
#define PG8_LDA(dst, b, h) do { _Pragma("unroll") for (int m = 0; m < 4; ++m) _Pragma("unroll") for (int k = 0; k < 2; ++k) dst[m][k] = *(const PG8_LAS bf16x8*)(lds + PG8_SA(b, h) + aoff + m * 2048 + k * 1024); } while (0)
#define PG8_LDB(dst, b, h) do { _Pragma("unroll") for (int n = 0; n < 2; ++n) _Pragma("unroll") for (int k = 0; k < 2; ++k) dst[n][k] = *(const PG8_LAS bf16x8*)(lds + PG8_SB(b, h) + boff + n * 2048 + k * 1024); } while (0)
#define PG8_MMA(ai, bj, At, Bt) do { __builtin_amdgcn_s_setprio(1); _Pragma("unroll") for (int m = 0; m < 4; ++m) _Pragma("unroll") for (int n = 0; n < 2; ++n) _Pragma("unroll") for (int k = 0; k < 2; ++k) \
        acc[ai][bj][m][n] = __builtin_amdgcn_mfma_f32_16x16x32_bf16(Bt[n][k], At[m][k], acc[ai][bj][m][n], 0, 0, 0); __builtin_amdgcn_s_setprio(0); } while (0)
#define PG8_WAIT_V(n) asm volatile("s_waitcnt vmcnt(" #n ")" ::: "memory")
#define PG8_WAIT_L(n) asm volatile("s_waitcnt lgkmcnt(" #n ")" ::: "memory")
#define PG8_BAR __builtin_amdgcn_s_barrier()
#define PG8_SCHED __builtin_amdgcn_sched_barrier(0)
    Unit cur, nxt; int ui = 0;
    if (!S.next(0, cur)) return;
    f32x4 acc[2][2][4][2];
#pragma unroll
    for (int a = 0; a < 2; ++a)
#pragma unroll
        for (int b = 0; b < 2; ++b)
#pragma unroll
            for (int m = 0; m < 4; ++m)
#pragma unroll
                for (int n = 0; n < 2; ++n) acc[a][b][m][n] = (f32x4){0.f, 0.f, 0.f, 0.f};
    bf16x8 At[4][2], B0[2][2], B1[2][2];
    const char* cA = (const char*)g.A + (size_t)cur.pm * tstep; const char* cB = (const char*)g.Bt + (size_t)cur.pn * tstep;
    S.a_ready(cur);
    if constexpr (SP2) {
        PG8_STAGE(PG8_SB(0, 0), cB, voffB); PG8_STAGE(PG8_SB(0, 1), cB + hstep, voffB); PG8_STAGE(PG8_SA(0, 0), cA, voffA); PG8_STAGE(PG8_SA(0, 1), cA + hstep, voffA);
        if (wr == 1) PG8_BAR;
        PG8_WAIT_V(2); PG8_BAR;
        PG8_STAGE(PG8_SB(1, 0), cB + kstep, voffB); PG8_STAGE(PG8_SA(1, 0), cA + kstep, voffA); PG8_STAGE(PG8_SB(1, 1), cB + hstep + kstep, voffB);
        PG8_WAIT_V(6); PG8_BAR;
    } else {
        PG8_STAGE(PG8_SB(0, 0), cB, voffB); PG8_STAGE(PG8_SA(0, 0), cA, voffA); PG8_STAGE(PG8_SB(0, 1), cB + hstep, voffB); PG8_STAGE(PG8_SA(0, 1), cA + hstep, voffA);
        if (wr == 1) PG8_BAR;
        PG8_WAIT_V(4); PG8_BAR;
        PG8_STAGE(PG8_SB(1, 0), cB + kstep, voffB); PG8_STAGE(PG8_SA(1, 0), cA + kstep, voffA); PG8_STAGE(PG8_SB(1, 1), cB + hstep + kstep, voffB);
        PG8_WAIT_V(6); PG8_BAR;
    }
    for (;;) {
        const bool has_next = S.next(ui + 1, nxt);
        const char* nA = has_next ? (const char*)g.A + (size_t)nxt.pm * tstep : cA; const char* nB = has_next ? (const char*)g.Bt + (size_t)nxt.pn * tstep : cB;
        for (int t = 0; t < nt; t += 2) {
            const bool last = (t == nt - 2);
            const char* a1 = cA + (size_t)(t + 1) * kstep;
            const char* a2 = last ? nA : cA + (size_t)(t + 2) * kstep; const char* b2 = last ? nB : cB + (size_t)(t + 2) * kstep;
            const char* a3 = a2 + kstep; const char* b3 = b2 + kstep;
            if (last && has_next) S.a_ready(nxt);
            if constexpr (Epi::MIDSCALE) { if (t == (nt >> 1)) E.mid(acc, cur, wr, wc, fr, fq); }
            if constexpr (SP2) {
            PG8_LDB(B0, 0, 0); PG8_LDB(B1, 0, 1); PG8_SCHED; PG8_LDA(At, 0, 0); PG8_STAGE(PG8_SA(1, 1), a1 + hstep, voffA);
            PG8_WAIT_V(8); PG8_WAIT_L(0); PG8_BAR; PG8_MMA(0, 0, At, B0); PG8_MMA(0, 1, At, B1); PG8_BAR; PG8_SCHED;
            PG8_LDA(At, 0, 1); PG8_STAGE(PG8_SB(0, 0), b2, voffB); PG8_STAGE(PG8_SB(0, 1), b2 + hstep, voffB); PG8_STAGE(PG8_SA(0, 0), a2, voffA);
            PG8_WAIT_V(8); PG8_WAIT_L(0); PG8_BAR; PG8_MMA(1, 0, At, B0); PG8_MMA(1, 1, At, B1); PG8_BAR; PG8_SCHED;
            PG8_LDB(B0, 1, 0); PG8_LDB(B1, 1, 1); PG8_SCHED; PG8_LDA(At, 1, 0); PG8_STAGE(PG8_SA(0, 1), a2 + hstep, voffA);
            PG8_WAIT_V(8); PG8_WAIT_L(0); PG8_BAR; PG8_MMA(0, 0, At, B0); PG8_MMA(0, 1, At, B1); PG8_BAR; PG8_SCHED;
            PG8_LDA(At, 1, 1); PG8_STAGE(PG8_SB(1, 0), b3, voffB); PG8_STAGE(PG8_SB(1, 1), b3 + hstep, voffB); PG8_STAGE(PG8_SA(1, 0), a3, voffA);
            PG8_WAIT_V(8); PG8_WAIT_L(0); PG8_BAR; PG8_MMA(1, 0, At, B0); PG8_MMA(1, 1, At, B1); PG8_BAR; PG8_SCHED;
            } else {
            PG8_LDB(B0, 0, 0); PG8_SCHED; PG8_LDA(At, 0, 0); PG8_STAGE(PG8_SA(1, 1), a1 + hstep, voffA);
            PG8_WAIT_L(8); PG8_BAR; PG8_WAIT_L(0); PG8_MMA(0, 0, At, B0); PG8_BAR; PG8_SCHED;
            PG8_LDB(B1, 0, 1); PG8_STAGE(PG8_SB(0, 0), b2, voffB);
            PG8_BAR; PG8_WAIT_L(0); PG8_MMA(0, 1, At, B1); PG8_BAR;
            PG8_LDA(At, 0, 1); PG8_STAGE(PG8_SA(0, 0), a2, voffA);
            PG8_BAR; PG8_WAIT_L(0); PG8_MMA(1, 0, At, B0); PG8_BAR; PG8_SCHED;
            PG8_STAGE(PG8_SB(0, 1), b2 + hstep, voffB);
            PG8_WAIT_V(6); PG8_BAR; PG8_MMA(1, 1, At, B1); PG8_BAR;
            PG8_LDB(B0, 1, 0); PG8_SCHED; PG8_LDA(At, 1, 0); PG8_STAGE(PG8_SA(0, 1), a2 + hstep, voffA);
            PG8_WAIT_L(8); PG8_BAR; PG8_WAIT_L(0); PG8_MMA(0, 0, At, B0); PG8_BAR; PG8_SCHED;
            PG8_LDB(B1, 1, 1); PG8_STAGE(PG8_SB(1, 0), b3, voffB);
            PG8_BAR; PG8_WAIT_L(0); PG8_MMA(0, 1, At, B1); PG8_BAR;
            PG8_LDA(At, 1, 1); PG8_STAGE(PG8_SA(1, 0), a3, voffA);
            PG8_BAR; PG8_WAIT_L(0); PG8_MMA(1, 0, At, B0); PG8_BAR; PG8_SCHED;
            PG8_STAGE(PG8_SB(1, 1), b3 + hstep, voffB);
            PG8_WAIT_V(6); PG8_BAR; PG8_MMA(1, 1, At, B1); PG8_BAR;
            }
        }
        if constexpr (ALIGN_EPI) { if (wr == 0) PG8_BAR; }
        if constexpr (!Epi::AFTER_DRAIN) { E(acc, cur, wr, wc, fr, fq); S.done(cur); }
        if (!has_next) break;
#pragma unroll
        for (int a = 0; a < 2; ++a)
#pragma unroll
            for (int b = 0; b < 2; ++b)
#pragma unroll
                for (int m = 0; m < 4; ++m)
#pragma unroll
                    for (int n = 0; n < 2; ++n) acc[a][b][m][n] = (f32x4){0.f, 0.f, 0.f, 0.f};
        cur = nxt; cA = nA; cB = nB; ++ui;
        if constexpr (ALIGN_EPI) { if (wr == 1) PG8_BAR; }
    }
    PG8_WAIT_V(0);
    if constexpr (!ALIGN_EPI) { if (wr == 0) PG8_BAR; }
    PG8_BAR;
    if constexpr (Epi::AFTER_DRAIN) { E.fused(acc, cur, wr, wc, fr, fq, lds, wid, lane); S.done(cur); }
#undef PG8_SA
#undef PG8_SB
#undef PG8_STAGE
#undef PG8_LDA
#undef PG8_LDB
#undef PG8_MMA
#undef PG8_WAIT_V
#undef PG8_WAIT_L
#undef PG8_BAR
#undef PG8_SCHED
}

typedef unsigned u32x2 __attribute__((ext_vector_type(2)));
constexpr float RMS_EPS = 1e-6f;
__device__ __forceinline__ float rstd_of(float ss, float inv_n) { return __builtin_amdgcn_rsqf(ss * inv_n + RMS_EPS); }
__device__ __forceinline__ float silu_f(float x) { return x * __builtin_amdgcn_rcpf(1.0f + __builtin_amdgcn_exp2f(-1.4426950408889634f * x)); }

struct EpiSwiglu {
    static constexpr bool PERM = true, AFTER_DRAIN = false, MIDSCALE = false;
    bf16_t* H; const float* ss; int ldh;
    __device__ __forceinline__ void operator()(const f32x4 (&acc)[2][2][4][2], const Unit& u, int wr, int wc, int fr, int fq) const {
        asm volatile("" : "+v"(fr), "+v"(fq), "+s"(wr), "+s"(wc));
        const int row0 = u.pm * BM + wr * 64 + fr, col0 = u.pn * HALF + wc * 32 + 8 * fq;
        float rsv[8];
#pragma unroll
        for (int q = 0; q < 8; ++q) rsv[q] = ss[row0 + (q >> 2) * HALF + (q & 3) * 16];
#pragma unroll
        for (int ai = 0; ai < 2; ++ai)
#pragma unroll
            for (int m = 0; m < 4; ++m) {
                const int row = row0 + ai * HALF + m * 16;
                const float rs = rstd_of(rsv[ai * 4 + m], 1.0f / 1024.0f);
                float o[8];
#pragma unroll
                for (int n = 0; n < 2; ++n)
#pragma unroll
                    for (int j = 0; j < 4; ++j) { const float g = acc[ai][0][m][n][j] * rs, up = acc[ai][1][m][n][j] * rs; o[n * 4 + j] = silu_f(g) * up; }
                u32x4 w; w.x = cvt_pk_bf16(o[0], o[1]); w.y = cvt_pk_bf16(o[2], o[3]); w.z = cvt_pk_bf16(o[4], o[5]); w.w = cvt_pk_bf16(o[6], o[7]);
                *(u32x4*)(H + (size_t)row * ldh + col0) = w;
            }
    }
};

struct EpiRes {
    static constexpr bool PERM = true, AFTER_DRAIN = true, MIDSCALE = false;
    const bf16_t* residh; bf16_t* ob; bf16_t* operm; float* ss; float alpha;
    __device__ __forceinline__ void fused(f32x4 (&acc)[2][2][4][2], const Unit& u, int wr, int wc, int fr, int fq, PG8_LAS unsigned char* lds, int wid, int lane) const {
        PG8_LAS float* Pl = (PG8_LAS float*)lds;
        asm volatile("" : "+v"(fr), "+v"(fq), "+s"(wr), "+s"(wc));
        const int col0 = u.pn * BM + wc * 32 + 8 * fq, s0 = u.pm * BM + wr * 64 + fr;
        u32x4 rh[3][2];
#define EPI_LOADH(q) do { const size_t o_ = (size_t)(s0 + ((q) >> 2) * HALF + ((q) & 3) * 16) * 1024 + col0; \
        _Pragma("unroll") for (int x_ = 0; x_ < 2; ++x_) rh[(q) % 3][x_] = *(const u32x4*)(residh + o_ + x_ * HALF); } while (0)
#define EPI_UNLO(v_) ((f32x4){__builtin_bit_cast(float, (v_).x << 16), __builtin_bit_cast(float, (v_).x & 0xffff0000u), __builtin_bit_cast(float, (v_).y << 16), __builtin_bit_cast(float, (v_).y & 0xffff0000u)})
#define EPI_UNHI(v_) ((f32x4){__builtin_bit_cast(float, (v_).z << 16), __builtin_bit_cast(float, (v_).z & 0xffff0000u), __builtin_bit_cast(float, (v_).w << 16), __builtin_bit_cast(float, (v_).w & 0xffff0000u)})
        EPI_LOADH(0); EPI_LOADH(1);
#pragma unroll
        for (int q = 0; q < 8; ++q) {
            const int ai = q >> 2, m = q & 3;
            if (q + 2 < 8) EPI_LOADH(q + 2);
            const int s = s0 + ai * HALF + m * 16;
            const int t = s + 16, b = t / 164, a = t - b * 164; const size_t nperm = (size_t)(a * 100 + b);
            float ps = 0.f;
#pragma unroll
            for (int bj = 0; bj < 2; ++bj) {
                const int col = col0 + bj * HALF; const size_t off = (size_t)s * 1024 + col;
                const f32x4 o0 = EPI_UNLO(rh[q % 3][bj]) + acc[ai][bj][m][0] * alpha, o1 = EPI_UNHI(rh[q % 3][bj]) + acc[ai][bj][m][1] * alpha;
                ps += ((o0[0] * o0[0] + o0[1] * o0[1]) + (o0[2] * o0[2] + o0[3] * o0[3])) + ((o1[0] * o1[0] + o1[1] * o1[1]) + (o1[2] * o1[2] + o1[3] * o1[3]));
                u32x4 w; w.x = cvt_pk_bf16(o0[0], o0[1]); w.y = cvt_pk_bf16(o0[2], o0[3]); w.z = cvt_pk_bf16(o1[0], o1[1]); w.w = cvt_pk_bf16(o1[2], o1[3]);
                *(u32x4*)(ob + off) = w;
                *(u32x4*)(operm + nperm * 1024 + col) = w;
            }
            ps += __shfl_xor(ps, 16); ps += __shfl_xor(ps, 32); if (fq == 0) Pl[(ai * HALF + wr * 64 + m * 16 + fr) * 4 + wc] = ps;
        }
        asm volatile("s_waitcnt lgkmcnt(0)" ::: "memory"); __syncthreads();
        if (threadIdx.x < 256) { const int row = threadIdx.x; atomicAdd(ss + u.pm * BM + row, (Pl[row * 4 + 0] + Pl[row * 4 + 1]) + (Pl[row * 4 + 2] + Pl[row * 4 + 3])); }
    }
};

struct EpiQKV {
    static constexpr bool PERM = true, AFTER_DRAIN = false, MIDSCALE = false;
    bf16_t* Q; bf16_t* Kb; bf16_t* Vt; const float* ss; const float* qn; const float* kn; int LPv;
    __device__ __forceinline__ void operator()(const f32x4 (&acc)[2][2][4][2], const Unit& u, int wr, int wc, int fr, int fq) const {
        asm volatile("" : "+v"(fr), "+v"(fq), "+s"(wr), "+s"(wc));
        const int hs = 4 * u.pn + wc;
        f32x4 gn[2][2];
        const float* gp = hs < 8 ? qn : kn;
#pragma unroll
        for (int bj = 0; bj < 2; ++bj)
#pragma unroll
            for (int n = 0; n < 2; ++n) gn[bj][n] = *(const f32x4*)(gp + 32 * bj + 8 * fq + 4 * n);
        const float qs = hs < 8 ? 0.125f * 1.4426950408889634f : 1.0f;
        float rsv[8];
#pragma unroll
        for (int q = 0; q < 8; ++q) rsv[q] = ss[u.pm * BM + (q >> 2) * HALF + wr * 64 + (q & 3) * 16 + fr];
#pragma unroll
        for (int ai = 0; ai < 2; ++ai)
#pragma unroll
            for (int m = 0; m < 4; ++m) {
                const int t = u.pm * BM + ai * HALF + wr * 64 + m * 16 + fr;
                const float rs = rstd_of(rsv[ai * 4 + m], 1.0f / 1024.0f);
                f32x4 v[2][2]; float q = 0.f;
#pragma unroll
                for (int bj = 0; bj < 2; ++bj)
#pragma unroll
                    for (int n = 0; n < 2; ++n) { v[bj][n] = acc[ai][bj][m][n] * rs; const f32x4 x = v[bj][n]; q += (x[0] * x[0] + x[1] * x[1]) + (x[2] * x[2] + x[3] * x[3]); }
                q += __shfl_xor(q, 16); q += __shfl_xor(q, 32);
                if (hs < 10) { const float hr = rstd_of(q, 1.0f / 64.0f) * qs;
#pragma unroll
                    for (int bj = 0; bj < 2; ++bj)
#pragma unroll
                        for (int n = 0; n < 2; ++n) v[bj][n] = v[bj][n] * gn[bj][n] * hr; }
#pragma unroll
                for (int bj = 0; bj < 2; ++bj) {
                    const int d = 32 * bj + 8 * fq; const f32x4 x0 = v[bj][0], x1 = v[bj][1];
                    u32x4 w; w.x = cvt_pk_bf16(x0[0], x0[1]); w.y = cvt_pk_bf16(x0[2], x0[3]); w.z = cvt_pk_bf16(x1[0], x1[1]); w.w = cvt_pk_bf16(x1[2], x1[3]);
                    if (hs < 8) *(u32x4*)(Q + (size_t)t * 512 + hs * 64 + d) = w;
                    else if (hs < 10) *(u32x4*)(Kb + (size_t)t * 128 + (hs - 8) * 64 + d) = w;
                    else { bf16_t* vp = Vt + (size_t)((hs - 10) * 64 + d) * LPv + t; const size_t L_ = (size_t)LPv;
                        vp[0] = (bf16_t)(w.x & 0xffffu); vp[L_] = (bf16_t)(w.x >> 16); vp[2 * L_] = (bf16_t)(w.y & 0xffffu); vp[3 * L_] = (bf16_t)(w.y >> 16);
                        vp[4 * L_] = (bf16_t)(w.z & 0xffffu); vp[5 * L_] = (bf16_t)(w.z >> 16); vp[6 * L_] = (bf16_t)(w.w & 0xffffu); vp[7 * L_] = (bf16_t)(w.w >> 16); }
                }
            }
    }
};

struct EpiG0 {
    static constexpr bool PERM = false, AFTER_DRAIN = false, MIDSCALE = false;
    bf16_t* X; const float* ss;
    __device__ __forceinline__ void operator()(const f32x4 (&acc)[2][2][4][2], const Unit& u, int wr, int wc, int fr, int fq) const {
        asm volatile("" : "+v"(fr), "+v"(fq), "+s"(wr), "+s"(wc));
        const int part = u.pm >> 1;
#pragma unroll
        for (int bj = 0; bj < 2; ++bj)
#pragma unroll
            for (int n = 0; n < 2; ++n) {
                const int nn = u.pn * BM + bj * HALF + wc * 32 + n * 16 + 4 * fq;
                if (nn >= 16400) continue;
                const int a = nn / 100, b = nn - a * 100;
                f32x4 rs;
#pragma unroll
                for (int j = 0; j < 4; ++j) rs[j] = rstd_of(ss[a + 164 * (b + j)], 1.0f / 1024.0f);
#pragma unroll
                for (int ai = 0; ai < 2; ++ai)
#pragma unroll
                    for (int m = 0; m < 4; ++m) {
                        const int c = ((u.pm & 1) * BM) + ai * HALF + wr * 64 + m * 16 + fr;
                        const f32x4 x = acc[ai][bj][m][n] * rs;
                        u32x2 w; w.x = cvt_pk_bf16(x[0], x[1]); w.y = cvt_pk_bf16(x[2], x[3]);
                        bf16_t* p = X + ((size_t)(c * 164 + a) * 2 + part) * 128 + b;
                        *(u32x2*)p = w;
                        if (b == 96) {
#pragma unroll
                            for (int z = 1; z < 8; ++z) *(u32x2*)(p + 4 * z) = (u32x2){0u, 0u}; }
                    }
            }
    }
};

struct EpiG1 {
    static constexpr bool PERM = false, AFTER_DRAIN = false, MIDSCALE = false;
    bf16_t* X1;
    __device__ __forceinline__ void operator()(const f32x4 (&acc)[2][2][4][2], const Unit& u, int wr, int wc, int fr, int fq) const {
        asm volatile("" : "+v"(fr), "+v"(fq), "+s"(wr), "+s"(wc));
#pragma unroll
        for (int m = 0; m < 4; ++m) {
            const int beta = wr * 64 + m * 16 + fr;
            if (beta >= 100) continue;
            const float cd = __builtin_amdgcn_cosf((float)beta * (1.0f / 16400.0f)), sd = __builtin_amdgcn_sinf((float)beta * (1.0f / 16400.0f));
#pragma unroll
            for (int bj = 0; bj < 2; ++bj)
#pragma unroll
                for (int n = 0; n < 2; ++n) {
                    const int n1 = u.pn * BM + bj * HALF + wc * 32 + n * 16 + 4 * fq;
                    const int c = n1 / 164, a0 = n1 - c * 164;
                    const f32x4 re = acc[0][bj][m][n], im = acc[1][bj][m][n];
                    f32x4 ore, oim;
                    float cs = __builtin_amdgcn_cosf((float)(a0 * beta) * (1.0f / 16400.0f)), sn = __builtin_amdgcn_sinf((float)(a0 * beta) * (1.0f / 16400.0f));
#pragma unroll
                    for (int j = 0; j < 4; ++j) {
                        ore[j] = re[j] * cs + im[j] * sn; oim[j] = im[j] * cs - re[j] * sn;
                        const float c2 = cs * cd - sn * sd; sn = sn * cd + cs * sd; cs = c2;
                    }
                    bf16_t* p = X1 + ((size_t)(beta * 512 + c) * 2) * 192 + a0;
                    u32x2 w; w.x = cvt_pk_bf16(ore[0], ore[1]); w.y = cvt_pk_bf16(ore[2], ore[3]); *(u32x2*)p = w;
                    w.x = cvt_pk_bf16(oim[0], oim[1]); w.y = cvt_pk_bf16(oim[2], oim[3]); *(u32x2*)(p + 192) = w;
                    if (a0 == 160) {
#pragma unroll
                        for (int z = 1; z < 8; ++z) { *(u32x2*)(p + 4 * z) = (u32x2){0u, 0u}; *(u32x2*)(p + 192 + 4 * z) = (u32x2){0u, 0u}; } }
                }
        }
    }
};

struct EpiG3 {
    static constexpr bool PERM = true, AFTER_DRAIN = false, MIDSCALE = false;
    bf16_t* MX; float* ssF;
    __device__ __forceinline__ void operator()(const f32x4 (&acc)[2][2][4][2], const Unit& u, int wr, int wc, int fr, int fq) const {
        asm volatile("" : "+v"(fr), "+v"(fq), "+s"(wr), "+s"(wc));
        const int beta = u.pn >> 1, cb = (u.pn & 1) * BM + wc * 32 + 8 * fq;
#pragma unroll
        for (int ai = 0; ai < 2; ++ai)
#pragma unroll
            for (int m = 0; m < 4; ++m) {
                const int alpha = ai * HALF + wr * 64 + m * 16 + fr;
                const int s = 100 * alpha + beta - 16;
                const bool ok = alpha < 164 && s >= 0;
                float ps = 0.f;
#pragma unroll
                for (int bj = 0; bj < 2; ++bj) {
                    const f32x4 x0 = acc[ai][bj][m][0], x1 = acc[ai][bj][m][1];
                    ps += ((x0[0] * x0[0] + x0[1] * x0[1]) + (x0[2] * x0[2] + x0[3] * x0[3])) + ((x1[0] * x1[0] + x1[1] * x1[1]) + (x1[2] * x1[2] + x1[3] * x1[3]));
                    if (ok) { u32x4 w; w.x = cvt_pk_bf16(x0[0], x0[1]); w.y = cvt_pk_bf16(x0[2], x0[3]); w.z = cvt_pk_bf16(x1[0], x1[1]); w.w = cvt_pk_bf16(x1[2], x1[3]);
                        *(u32x4*)(MX + (size_t)s * 1024 + 512 + cb + bj * HALF) = w; }
                }
                ps += __shfl_xor(ps, 16); ps += __shfl_xor(ps, 32);
                if (ok && fq == 0) atomicAdd(ssF + beta * 164 + alpha, ps);
            }
    }
};

struct EpiResMix {
    static constexpr bool PERM = true, AFTER_DRAIN = true, MIDSCALE = true;
    const bf16_t* residh; bf16_t* ob; float* ss; const float* ssA; const float* ssF;
    __device__ __forceinline__ void mid(f32x4 (&acc)[2][2][4][2], const Unit& u, int wr, int wc, int fr, int fq) const {
        asm volatile("" : "+v"(fr), "+s"(wr));
        const int s0 = u.pm * BM + wr * 64 + fr;
        float va[8], vf[8];
#pragma unroll
        for (int q = 0; q < 8; ++q) { const int s_ = s0 + (q >> 2) * HALF + (q & 3) * 16, al_ = (s_ + 16) / 100; va[q] = ssA[s_]; vf[q] = ssF[(s_ + 16 - 100 * al_) * 164 + al_]; }
#pragma unroll
        for (int q = 0; q < 8; ++q) {
            const float ratio = rstd_of(va[q], 1.0f / 512.0f) * __builtin_amdgcn_rcpf(rstd_of(vf[q], 1.0f / 512.0f));
#pragma unroll
            for (int bj = 0; bj < 2; ++bj)
#pragma unroll
                for (int n = 0; n < 2; ++n) acc[q >> 2][bj][q & 3][n] = acc[q >> 2][bj][q & 3][n] * ratio;
        }
    }
    __device__ __forceinline__ void fused(f32x4 (&acc)[2][2][4][2], const Unit& u, int wr, int wc, int fr, int fq, PG8_LAS unsigned char* lds, int wid, int lane) const {
        PG8_LAS float* Pl = (PG8_LAS float*)lds;
        asm volatile("" : "+v"(fr), "+v"(fq), "+s"(wr), "+s"(wc));
        const int col0 = u.pn * BM + wc * 32 + 8 * fq, s0 = u.pm * BM + wr * 64 + fr;
        float vf[8];
#pragma unroll
        for (int q = 0; q < 8; ++q) { const int s_ = s0 + (q >> 2) * HALF + (q & 3) * 16, al_ = (s_ + 16) / 100; vf[q] = ssF[(s_ + 16 - 100 * al_) * 164 + al_]; }
        u32x4 rh[3][2];
        EPI_LOADH(0); EPI_LOADH(1);
#pragma unroll
        for (int q = 0; q < 8; ++q) {
            const int ai = q >> 2, m = q & 3;
            if (q + 2 < 8) EPI_LOADH(q + 2);
            const int s = s0 + ai * HALF + m * 16;
            const float rf = rstd_of(vf[q], 1.0f / 512.0f);
            float ps = 0.f;
#pragma unroll
            for (int bj = 0; bj < 2; ++bj) {
                const size_t off = (size_t)s * 1024 + col0 + bj * HALF;
                const f32x4 o0 = EPI_UNLO(rh[q % 3][bj]) + acc[ai][bj][m][0] * rf, o1 = EPI_UNHI(rh[q % 3][bj]) + acc[ai][bj][m][1] * rf;
                ps += ((o0[0] * o0[0] + o0[1] * o0[1]) + (o0[2] * o0[2] + o0[3] * o0[3])) + ((o1[0] * o1[0] + o1[1] * o1[1]) + (o1[2] * o1[2] + o1[3] * o1[3]));
                u32x4 w; w.x = cvt_pk_bf16(o0[0], o0[1]); w.y = cvt_pk_bf16(o0[2], o0[3]); w.z = cvt_pk_bf16(o1[0], o1[1]); w.w = cvt_pk_bf16(o1[2], o1[3]);
                *(u32x4*)(ob + off) = w;
            }
            ps += __shfl_xor(ps, 16); ps += __shfl_xor(ps, 32); if (fq == 0) Pl[(ai * HALF + wr * 64 + m * 16 + fr) * 4 + wc] = ps;
        }
        asm volatile("s_waitcnt lgkmcnt(0)" ::: "memory"); __syncthreads();
        if (threadIdx.x < 256) { const int row = threadIdx.x; atomicAdd(ss + u.pm * BM + row, (Pl[row * 4 + 0] + Pl[row * 4 + 1]) + (Pl[row * 4 + 2] + Pl[row * 4 + 3])); }
    }
};


struct EpiResFinal {
    static constexpr bool PERM = true, AFTER_DRAIN = true, MIDSCALE = false;
    const bf16_t* residh; float* out; float* ss; unsigned* cnt; const float* gain; float alpha;
    __device__ __forceinline__ void fused(f32x4 (&acc)[2][2][4][2], const Unit& u, int wr, int wc, int fr, int fq, PG8_LAS unsigned char* lds, int wid, int lane) const {
        const int col0 = u.pn * BM + wc * 32 + 8 * fq, s0 = u.pm * BM + wr * 64 + fr;
        PG8_LAS float* Pl = (PG8_LAS float*)lds; PG8_LAS float* Tl = (PG8_LAS float*)(lds + 4096);
        u32x4 rh[3][2];
        EPI_LOADH(0); EPI_LOADH(1);
#pragma unroll
        for (int q = 0; q < 8; ++q) {
            const int ai = q >> 2, m = q & 3;
            if (q + 2 < 8) EPI_LOADH(q + 2);
            float ps = 0.f;
#pragma unroll
            for (int bj = 0; bj < 2; ++bj) {
                const f32x4 o0 = EPI_UNLO(rh[q % 3][bj]) + acc[ai][bj][m][0] * alpha, o1 = EPI_UNHI(rh[q % 3][bj]) + acc[ai][bj][m][1] * alpha;
                acc[ai][bj][m][0] = o0; acc[ai][bj][m][1] = o1;
                ps += ((o0[0] * o0[0] + o0[1] * o0[1]) + (o0[2] * o0[2] + o0[3] * o0[3])) + ((o1[0] * o1[0] + o1[1] * o1[1]) + (o1[2] * o1[2] + o1[3] * o1[3]));
            }
            ps += __shfl_xor(ps, 16); ps += __shfl_xor(ps, 32);
            if (fq == 0) Pl[(ai * HALF + wr * 64 + m * 16 + fr) * 4 + wc] = ps;
        }
        asm volatile("s_waitcnt lgkmcnt(0)" ::: "memory"); __syncthreads();
        if (threadIdx.x < 256) {
            const int row = threadIdx.x;
            const float part = (Pl[row * 4 + 0] + Pl[row * 4 + 1]) + (Pl[row * 4 + 2] + Pl[row * 4 + 3]);
            unsigned* sl = (unsigned*)ss + ((size_t)u.pm * 4) * 256 + row;
            __hip_atomic_store(sl + u.pn * 256, __builtin_bit_cast(unsigned, part) | 1u, __ATOMIC_RELAXED, __HIP_MEMORY_SCOPE_AGENT);
            float pv[4];
#pragma unroll
            for (int p2 = 0; p2 < 4; ++p2) { unsigned v = __builtin_bit_cast(unsigned, part) | 1u, spins = 0u;
                if (p2 != u.pn) { while ((v = __hip_atomic_load(sl + p2 * 256, __ATOMIC_RELAXED, __HIP_MEMORY_SCOPE_AGENT)) == 0u && ++spins < (1u << 20)) __builtin_amdgcn_s_sleep(1); }
                pv[p2] = __builtin_bit_cast(float, v); }
            const float tot = (pv[0] + pv[1]) + (pv[2] + pv[3]);
            Tl[row] = rstd_of(tot, 1.0f / 1024.0f);
        }
        asm volatile("s_waitcnt vmcnt(0) lgkmcnt(0)" ::: "memory"); __syncthreads();
        f32x4 gv[2][2];
#pragma unroll
        for (int bj = 0; bj < 2; ++bj)
#pragma unroll
            for (int n = 0; n < 2; ++n) gv[bj][n] = *(const f32x4*)(gain + col0 + bj * HALF + 4 * n);
#pragma unroll
        for (int q = 0; q < 8; ++q) {
            const int ai = q >> 2, m = q & 3; const int s = s0 + ai * HALF + m * 16;
            const float rs = Tl[ai * HALF + wr * 64 + m * 16 + fr];
#pragma unroll
            for (int bj = 0; bj < 2; ++bj)
#pragma unroll
                for (int n = 0; n < 2; ++n) *(f32x4*)(out + (size_t)s * 1024 + col0 + bj * HALF + 4 * n) = acc[ai][bj][m][n] * rs * gv[bj][n];
        }
    }
};
#undef EPI_LOADH
#undef EPI_UNLO
#undef EPI_UNHI
}

constexpr int NWAVES = 8;
constexpr int DM = 1024, LTOK = 16400, LP = 16640, SEQ = 16384, NMETA = 16, FF = 2816;
constexpr size_t MiB = 1u << 20;
constexpr size_t WS_CTL = 0, CTL_BYTES = MiB;
constexpr size_t CT_SS1 = 0, CT_SS2 = 128 * 1024, CT_MACC = 256 * 1024, CT_MCNT = 384 * 1024, CT_BAR = 512 * 1024, CT_TIX = 640 * 1024, CT_SSA = 768 * 1024, CT_SSF = 832 * 1024, CT_PCNT = 900 * 1024, CT_SS3 = 920 * 1024;
constexpr int MISC_OFF = 147456 - 256;
constexpr size_t WS_SS0 = 1 * MiB, WS_A1 = 1 * MiB + 128 * 1024, WS_A3 = 1 * MiB + 256 * 1024, WS_SLOT = 1 * MiB + 512 * 1024;
constexpr size_t WS_WGU1 = 2 * MiB, WS_WD1 = 13 * MiB, WS_WQKV = 19 * MiB, WS_WG = 21 * MiB, WS_WOUT = 23 * MiB, WS_WGU2 = 25 * MiB, WS_WD2 = 36 * MiB;
constexpr size_t WS_HID = 48 * MiB, WS_X = 48 * MiB, WS_X1 = 92 * MiB;
constexpr size_t WS_XB = 144 * MiB;
constexpr size_t WS_Q = 178 * MiB, WS_K = 195 * MiB, WS_VT = 200 * MiB;
constexpr size_t WS_Y = 178 * MiB, WS_H2B = 178 * MiB;
constexpr size_t WS_PERM = 212 * MiB, WS_O = 212 * MiB;
constexpr size_t WS_END = 246 * MiB;
constexpr int LDS_BYTES = 147456;

#define LAS __attribute__((address_space(3)))
typedef unsigned short bf16;
typedef unsigned v4u __attribute__((ext_vector_type(4)));
typedef unsigned v2u __attribute__((ext_vector_type(2)));
typedef float f32x4 __attribute__((ext_vector_type(4)));
typedef short bf16x8 __attribute__((ext_vector_type(8)));
#define LDS_WAIT() asm volatile("s_waitcnt lgkmcnt(0)" ::: "memory")
__device__ __forceinline__ unsigned f2bf(float f) { unsigned u = __builtin_bit_cast(unsigned, f); return (u + 0x7fffu + ((u >> 16) & 1u)) >> 16; }
__device__ __forceinline__ unsigned pk2(float lo, float hi) { return f2bf(lo) | (f2bf(hi) << 16); }
__device__ __forceinline__ float bf2f(unsigned h) { return __builtin_bit_cast(float, h << 16); }
__device__ __forceinline__ float wave_sum(float v) {
#pragma unroll
    for (int o = 1; o < 64; o <<= 1) v += __shfl_xor(v, o);
    return v;
}
__device__ __forceinline__ float wave_max(float v) {
#pragma unroll
    for (int o = 1; o < 64; o <<= 1) v = fmaxf(v, __shfl_xor(v, o));
    return v;
}

struct Args { const float* in[19]; float* out; unsigned char* ws; };

#define XB_TMO      128
#define XB_XCNT(j)  (256  + 64 * (j))
#define XB_XSUB(j)  (1280 + 64 * (j))
#define XB_XGEN(j)  (2304 + 64 * (j))
#define XB_TOP      3328
#define XB_TOPGEN   3392
#define XCD_BAR_WORDS 3456
#define XB_SPIN_CAP (1u << 18)

__device__ __forceinline__ unsigned xb_ld(unsigned* p)              { return __hip_atomic_load(p, __ATOMIC_RELAXED, __HIP_MEMORY_SCOPE_AGENT); }
__device__ __forceinline__ unsigned xb_add(unsigned* p, unsigned v) { return __hip_atomic_fetch_add(p, v, __ATOMIC_RELAXED, __HIP_MEMORY_SCOPE_AGENT); }
__device__ __forceinline__ unsigned xb_xcc_id() { return (unsigned)__builtin_amdgcn_s_getreg((3 << 11) | 20) & 0xFu; }
#define XB_SPIN(cond, bar) do { unsigned _sp = 0; while (cond) { __builtin_amdgcn_s_sleep(1); \
    if ((++_sp & 255u) == 0u) { if (xb_ld(&(bar)[XB_TMO])) break; if (_sp > XB_SPIN_CAP) { atomicAdd(&(bar)[XB_TMO], 1u); break; } } } } while (0)

struct XcdBarrier {
    unsigned* bar; unsigned x;
    volatile LAS unsigned* st;
};

__device__ __forceinline__ XcdBarrier xcd_barrier_post(unsigned* bar, volatile LAS unsigned* st) {
    XcdBarrier b; b.bar = bar; b.x = xb_xcc_id(); b.st = st;
    if (threadIdx.x == 0) (void)xb_add(&bar[XB_XCNT(b.x)], 1u);
    return b;
}
__device__ __forceinline__ void xcd_barrier_complete(unsigned* bar, unsigned x, unsigned& nloc, unsigned& nx) {
    const unsigned G = gridDim.x * gridDim.y * gridDim.z;
    unsigned sum, cnt, mine, sp = 0u;
    for (;;) {
        sum = 0u; cnt = 0u; mine = 0u;
#pragma unroll
        for (unsigned j = 0; j < 16; ++j) { const unsigned c = xb_ld(&bar[XB_XCNT(j)]); sum += c; cnt += (c > 0u) ? 1u : 0u; mine = (j == x) ? c : mine; }
        if (sum == G) break;
        __builtin_amdgcn_s_sleep(1);
        if ((++sp & 255u) == 0u) { if (xb_ld(&bar[XB_TMO])) break; if (sp > XB_SPIN_CAP) { atomicAdd(&bar[XB_TMO], 1u); break; } }
    }
    nloc = mine > 0u ? mine : 1u; nx = cnt > 0u ? cnt : 1u;
}

__device__ __forceinline__ void xcd_barrier(const XcdBarrier& b) {
    asm volatile("s_waitcnt vmcnt(0)" ::: "memory");
    __syncthreads();
    if (threadIdx.x == 0) {
        unsigned* bar = b.bar;
        __builtin_amdgcn_s_waitcnt(0);
        unsigned nloc = b.st[0], nx = b.st[1];
        if (nloc == 0u) { xcd_barrier_complete(bar, b.x, nloc, nx); b.st[0] = nloc; b.st[1] = nx; }
        const unsigned old = xb_add(&bar[XB_XSUB(b.x)], 1u);
        const unsigned gen = old / nloc;
        if (old + 1u == (gen + 1u) * nloc) {
            __builtin_amdgcn_fence(__ATOMIC_RELEASE, "agent");
            asm volatile("s_waitcnt vmcnt(0)" ::: "memory");
            const unsigned og = xb_add(&bar[XB_TOP], 1u);
            const unsigned tg = og / nx;
            if (og + 1u == (tg + 1u) * nx) xb_add(&bar[XB_TOPGEN], 1u);
            else XB_SPIN(xb_ld(&bar[XB_TOPGEN]) == tg, bar);
            __builtin_amdgcn_fence(__ATOMIC_ACQUIRE, "agent");
            xb_add(&bar[XB_XGEN(b.x)], 1u);
            asm volatile("s_waitcnt vmcnt(0)" ::: "memory");
        } else {
            XB_SPIN(xb_ld(&bar[XB_XGEN(b.x)]) == gen, bar);
            __builtin_amdgcn_fence(__ATOMIC_ACQUIRE, "agent");
            asm volatile("s_waitcnt vmcnt(0)" ::: "memory");
        }
    }
    __syncthreads();
}


__device__ __forceinline__ int dest_row(int mode, int n, int bj) {
    if (mode == 1) return 256 * (n >> 7) + 128 * bj + (n & 127);
    if (mode == 2) { const int hs = n >> 6, dd = n & 63; return 256 * (hs >> 2) + 128 * (dd >> 5) + 32 * (hs & 3) + (dd & 31); }
    return n;
}
#define TR_VARS(P) const float* P##W = nullptr; const float* P##gain = nullptr; bf16* P##WT = nullptr; int P##ldw = 0, P##K = 0, P##mode = 0, P##bj = 0, P##k0 = 0, P##n0 = 0
#define TR_SET(P, w_, g_, wt_, ldw_, K_, mode_, bj_, kb_, nb_) do { P##W = (w_); P##gain = (g_); P##WT = (bf16*)(wt_); P##ldw = (ldw_); P##K = (K_); P##mode = (mode_); P##bj = (bj_); P##k0 = 64 * (kb_); P##n0 = 64 * (nb_); } while (0)
#define TR_DECODE(P, it_) do { constexpr int I_GU = 16 * 44, I_DN = 44 * 16, I_QKV = 16 * 12; int r = (it_); \
    if (r < I_GU) { TR_SET(P, a.in[3], a.in[2], ws + WS_WGU1, FF, DM, 1, 0, r / 44, r % 44); break; } r -= I_GU; \
    if (r < I_GU) { TR_SET(P, a.in[4], a.in[2], ws + WS_WGU1, FF, DM, 1, 1, r / 44, r % 44); break; } r -= I_GU; \
    if (r < I_QKV) { TR_SET(P, a.in[7], a.in[6], ws + WS_WQKV, 1280, DM, 2, 0, r / 12, r % 12); break; } r -= I_QKV; \
    if (r < I_DN) { TR_SET(P, a.in[5], (const float*)nullptr, ws + WS_WD1, DM, FF, 0, 0, r / 16, r % 16); break; } r -= I_DN; \
    if (r < I_GU) { TR_SET(P, a.in[15], a.in[14], ws + WS_WGU2, FF, DM, 1, 0, r / 44, r % 44); break; } r -= I_GU; \
    if (r < I_GU) { TR_SET(P, a.in[16], a.in[14], ws + WS_WGU2, FF, DM, 1, 1, r / 44, r % 44); break; } r -= I_GU; \
    if (r < I_DN) { TR_SET(P, a.in[17], (const float*)nullptr, ws + WS_WD2, DM, FF, 0, 0, r / 16, r % 16); break; } r -= I_DN; \
    TR_SET(P, a.in[13], (r / 16) < 8 ? a.in[11] : a.in[12] - 512, ws + WS_WOUT, DM, DM, 0, 0, r / 16, r % 16); } while (0)
#define TR_LOAD(P, v) do { _Pragma("unroll") for (int i = 0; i < 16; ++i) { const int kk = 4 * i + (lane >> 4); \
        f32x4 x = __builtin_nontemporal_load((const f32x4*)(P##W + (size_t)(P##k0 + kk) * P##ldw + P##n0 + 4 * (lane & 15))); if (P##gain) x = x * P##gain[P##k0 + kk]; v[i] = x; } } while (0)
#define TR_FINISH(P, v) do { _Pragma("unroll") for (int i = 0; i < 16; ++i) { LAS float* w_ = scr + (4 * i + (lane >> 4)) * 65 + 4 * (lane & 15); w_[0] = v[i].x; w_[1] = v[i].y; w_[2] = v[i].z; w_[3] = v[i].w; } \
    LDS_WAIT(); asm volatile("" ::: "memory"); \
    _Pragma("unroll") for (int j = 0; j < 8; ++j) { const int n = (lane >> 3) + 8 * j; const LAS float* s_ = scr + (8 * (lane & 7)) * 65 + n; \
        v4u o; o.x = pk2(s_[0 * 65], s_[1 * 65]); o.y = pk2(s_[2 * 65], s_[3 * 65]); o.z = pk2(s_[4 * 65], s_[5 * 65]); o.w = pk2(s_[6 * 65], s_[7 * 65]); \
        *(v4u*)(P##WT + (size_t)dest_row(P##mode, P##n0 + n, P##bj) * P##K + P##k0 + 8 * (lane & 7)) = o; } \
    LDS_WAIT(); asm volatile("" ::: "memory"); } while (0)
__device__ __forceinline__ void wg_item(const float* Win, const float* gmix, bf16* WG, int g, int dq, int lane) {
    float re[4], im[4], gm[4];
#pragma unroll
    for (int dd = 0; dd < 4; ++dd) { re[dd] = 0.f; im[dd] = 0.f; gm[dd] = gmix[4 * dq + dd] * 0.125f; }
    const float* wrow = Win + (size_t)(4 * dq) * 1280 + 768 + 64 * g;
#pragma unroll 16
    for (int j = 0; j < 64; ++j) {
        const float ph = (float)((j * lane) & 63) * (1.0f / 64.0f);
        const float c = __builtin_amdgcn_cosf(ph), sn = __builtin_amdgcn_sinf(ph);
#pragma unroll
        for (int dd = 0; dd < 4; ++dd) { const float w = wrow[dd * 1280 + j]; re[dd] += w * c; im[dd] -= w * sn; }
    }
    *(v2u*)(WG + (size_t)(64 * g + lane) * 1024 + 4 * dq) = (v2u){pk2(re[0] * gm[0], re[1] * gm[1]), pk2(re[2] * gm[2], re[3] * gm[3])};
    *(v2u*)(WG + (size_t)(512 + 64 * g + lane) * 1024 + 4 * dq) = (v2u){pk2(im[0] * gm[0], im[1] * gm[1]), pk2(im[2] * gm[2], im[3] * gm[3])};
}

#define TR_RUN(it0_, stride_, itend_) do { f32x4 vA[16], vB[16]; TR_VARS(A_); TR_VARS(B_); \
        int it = (it0_); \
        if (it < (itend_)) { TR_DECODE(A_, it); TR_LOAD(A_, vA); } \
        while (it < (itend_)) { \
            const int it2 = it + (stride_); \
            if (it2 < (itend_)) { TR_DECODE(B_, it2); TR_LOAD(B_, vB); } \
            TR_FINISH(A_, vA); \
            if (it2 >= (itend_)) break; \
            const int it3 = it2 + (stride_); \
            if (it3 < (itend_)) { TR_DECODE(A_, it3); TR_LOAD(A_, vA); } \
            TR_FINISH(B_, vB); \
            it = it3; } } while (0)
__device__ __forceinline__ void late_weights(const Args& a, LAS unsigned char* lds, int first, int last, int widx, int nw, int lane, int wave) {
    unsigned char* ws = a.ws;
    LAS float* scr = (LAS float*)(lds + wave * 17408);
    TR_RUN(first + widx, nw, last);
}
constexpr int TR_N0 = 2 * (16 * 44), TR_N1 = TR_N0 + 16 * 12 + 44 * 16, TR_N = TR_N1 + 2 * (16 * 44) + 44 * 16 + 16 * 16;
__device__ __forceinline__ void p0_prologue(const Args& a, LAS unsigned char* lds, int tid, int lane, int wave) {
    unsigned char* ws = a.ws;
    LAS float* scr = (LAS float*)(lds + wave * 17408);
    const int gw = blockIdx.x * NWAVES + wave, NGW = gridDim.x * NWAVES;
    TR_RUN(gw, NGW, TR_N0);
    for (int it = gw; it < 2048; it += NGW) wg_item(a.in[7], a.in[6], (bf16*)(ws + WS_WG), it >> 8, it & 255, lane);
    {
        bf16* A1 = (bf16*)(ws + WS_A1); bf16* A3 = (bf16*)(ws + WS_A3);
        const int gt = gw * 64 + lane, NGT = NGW * 64;
        for (int e = gt; e < 256 * 256 + 256 * 384; e += NGT) {
            if (e < 65536) {
                const int rr = e >> 8, kk = e & 255, ai = rr >> 7, beta = rr & 127, part = kk >> 7, b = kk & 127; float v = 0.f;
                if (beta < 100 && b < 100) { const float ph = (float)((beta * b) % 100) * 0.01f; const float c = __builtin_amdgcn_cosf(ph) * 0.1f, s = __builtin_amdgcn_sinf(ph) * 0.1f;
                    v = ai == 0 ? (part == 0 ? c : s) : (part == 0 ? -s : c); }
                A1[e] = (bf16)f2bf(v);
            } else {
                const int e3 = e - 65536, al = e3 / 384, kk = e3 - al * 384, part = kk >= 192 ? 1 : 0, aa = kk - 192 * part; float v = 0.f;
                if (al < 164 && aa < 164) { const float ph = (float)((al * aa) % 164) * (1.0f / 164.0f); const float sc = 0.07808688094430304f;
                    v = (part == 0 ? __builtin_amdgcn_cosf(ph) : __builtin_amdgcn_sinf(ph)) * sc; }
                A3[e3] = (bf16)f2bf(v);
            }
        }
        v4u* pz = (v4u*)((bf16*)(ws + WS_PERM) + (size_t)LTOK * DM);
        for (int e = gt; e < (LP - LTOK) * DM / 8; e += NGT) pz[e] = (v4u){0u, 0u, 0u, 0u};
        v4u* ps_ = (v4u*)(ws + WS_SLOT);
        for (int e = gt; e < 256 * 1024 / 16; e += NGT) ps_[e] = (v4u){0u, 0u, 0u, 0u};
    }
    {
        bf16* xb = (bf16*)(ws + WS_XB); float* ss0 = (float*)(ws + WS_SS0);
#define XB_LOAD(V, T0) do { _Pragma("unroll") for (int r = 0; r < 4; ++r) { const int t = (T0) + r; \
            const float* src = t < NMETA ? a.in[1] + (size_t)t * DM : a.in[0] + (size_t)(t - NMETA) * DM; \
            _Pragma("unroll") for (int j = 0; j < 4; ++j) V[r][j] = t < LTOK ? __builtin_nontemporal_load((const f32x4*)src + lane + 64 * j) : (f32x4){0.f, 0.f, 0.f, 0.f}; } } while (0)
#define XB_FINISH(V, T0) do { float q[4]; \
            _Pragma("unroll") for (int r = 0; r < 4; ++r) { float s_ = 0.f; \
                _Pragma("unroll") for (int j = 0; j < 4; ++j) s_ += (V[r][j].x * V[r][j].x + V[r][j].y * V[r][j].y) + (V[r][j].z * V[r][j].z + V[r][j].w * V[r][j].w); q[r] = s_; } \
            _Pragma("unroll") for (int o = 1; o < 64; o <<= 1) { _Pragma("unroll") for (int r = 0; r < 4; ++r) q[r] += __shfl_xor(q[r], o); } \
            _Pragma("unroll") for (int r = 0; r < 4; ++r) { const int t = (T0) + r; if (lane == 0) ss0[t] = q[r]; \
                v2u* o8 = (v2u*)(xb + (size_t)t * DM) + lane; \
                _Pragma("unroll") for (int j = 0; j < 4; ++j) o8[64 * j] = (v2u){pk2(V[r][j].x, V[r][j].y), pk2(V[r][j].z, V[r][j].w)}; } } while (0)
        f32x4 va[4][4], vb4[4][4];
        int t0 = 4 * gw;
        if (t0 < LP) XB_LOAD(va, t0);
        while (t0 < LP) {
            const int t1 = t0 + 4 * NGW;
            if (t1 < LP) XB_LOAD(vb4, t1);
            XB_FINISH(va, t0);
            if (t1 >= LP) break;
            const int t2 = t1 + 4 * NGW;
            if (t2 < LP) XB_LOAD(va, t2);
            XB_FINISH(vb4, t1);
            t0 = t2;
        }
#undef XB_LOAD
#undef XB_FINISH
    }
}

__device__ __forceinline__ void meta_down(const Args& a, LAS unsigned char* lds, int tid, int lane, int wave) {
    unsigned char* ws = a.ws;
    const int cgp = blockIdx.x & 15, kq = (blockIdx.x >> 4) & 15, n0 = 64 * cgp, kbase = 176 * kq;
    LAS float* hk = (LAS float*)lds; LAS float* red = (LAS float*)(lds + 16384); LAS unsigned* flag = (LAS unsigned*)(lds + 16384 + 32768);
    const bf16* HID = (const bf16*)(ws + WS_HID);
    float* macc = (float*)(ws + WS_CTL + CT_MACC); unsigned* mcnt = (unsigned*)(ws + WS_CTL + CT_MCNT); float* ss1 = (float*)(ws + WS_CTL + CT_SS1);
    if (tid < 16 * 22) { const int r = tid / 22, k8 = (tid - r * 22) * 8; const v4u w = *(const v4u*)(HID + (size_t)r * FF + kbase + k8);
        hk[(k8 + 0) * 16 + r] = bf2f(w.x & 0xffffu); hk[(k8 + 1) * 16 + r] = bf2f(w.x >> 16); hk[(k8 + 2) * 16 + r] = bf2f(w.y & 0xffffu); hk[(k8 + 3) * 16 + r] = bf2f(w.y >> 16);
        hk[(k8 + 4) * 16 + r] = bf2f(w.z & 0xffffu); hk[(k8 + 5) * 16 + r] = bf2f(w.z >> 16); hk[(k8 + 6) * 16 + r] = bf2f(w.w & 0xffffu); hk[(k8 + 7) * 16 + r] = bf2f(w.w >> 16); }
    const float* wp = a.in[5] + (size_t)(kbase + 22 * wave) * DM + n0 + lane;
    float wv[22];
#pragma unroll
    for (int k = 0; k < 22; ++k) wv[k] = wp[(size_t)k * DM];
    __syncthreads();
    float acc[16];
#pragma unroll
    for (int r = 0; r < 16; ++r) acc[r] = 0.f;
#pragma unroll
    for (int k = 0; k < 22; ++k) {
        const float w = wv[k]; const LAS f32x4* h = (const LAS f32x4*)(hk + (22 * wave + k) * 16);
        const f32x4 h0 = h[0], h1 = h[1], h2 = h[2], h3 = h[3];
        acc[0] += w * h0.x; acc[1] += w * h0.y; acc[2] += w * h0.z; acc[3] += w * h0.w; acc[4] += w * h1.x; acc[5] += w * h1.y; acc[6] += w * h1.z; acc[7] += w * h1.w;
        acc[8] += w * h2.x; acc[9] += w * h2.y; acc[10] += w * h2.z; acc[11] += w * h2.w; acc[12] += w * h3.x; acc[13] += w * h3.y; acc[14] += w * h3.z; acc[15] += w * h3.w;
        if ((k & 3) == 3) asm volatile("" ::: "memory");
    }
#pragma unroll
    for (int r = 0; r < 16; ++r) red[(wave * 16 + r) * 64 + lane] = acc[r];
    __syncthreads();
    for (int o = tid; o < 1024; o += NWAVES * 64) { const int r = o >> 6, n = o & 63; float s = 0.f;
#pragma unroll
        for (int w = 0; w < 8; ++w) s += red[(w * 16 + r) * 64 + n];
        atomicAdd(macc + r * DM + n0 + n, s); }
    asm volatile("s_waitcnt vmcnt(0)" ::: "memory"); __syncthreads();
    if (tid == 0) { const unsigned old = atomicAdd(mcnt + cgp, 1u); flag[0] = (old == 15u) ? 1u : 0u; }
    __syncthreads();
    if (flag[0]) {
        const int r = tid >> 5, nn = (tid & 31) * 2;
        const float v0 = __hip_atomic_load(macc + r * DM + n0 + nn, __ATOMIC_RELAXED, __HIP_MEMORY_SCOPE_AGENT), v1 = __hip_atomic_load(macc + r * DM + n0 + nn + 1, __ATOMIC_RELAXED, __HIP_MEMORY_SCOPE_AGENT);
        const float h0 = a.in[1][r * DM + n0 + nn] + 0.5f * v0, h1 = a.in[1][r * DM + n0 + nn + 1] + 0.5f * v1;
        const unsigned w = pk2(h0, h1);
        *(unsigned*)((bf16*)(ws + WS_XB) + (size_t)r * DM + n0 + nn) = w;
        *(unsigned*)((bf16*)(ws + WS_PERM) + (size_t)(100 * r) * DM + n0 + nn) = w;
        float ps = h0 * h0 + h1 * h1;
#pragma unroll
        for (int o = 1; o < 32; o <<= 1) ps += __shfl_xor(ps, o);
        if ((tid & 31) == 0) atomicAdd(ss1 + r, ps);
    }
    __syncthreads();
}

#define ATT_LOAD(KF, VF, si) do { const int kk0_ = (si) == 0 ? 0 : ks + 32 * ((si) - 1); \
    _Pragma("unroll") for (int T = 0; T < 2; ++T) { const int krow = kk0_ + 8 * (i >> 2) + 4 * T + (i & 3); \
        _Pragma("unroll") for (int hf = 0; hf < 2; ++hf) KF[T][hf] = *(const bf16x8*)(Kb + (size_t)krow * 128 + kvh * 64 + hf * 32 + 8 * g); } \
    _Pragma("unroll") for (int dt = 0; dt < 4; ++dt) VF[dt] = *(const bf16x8*)(Vt + (size_t)(kvh * 64 + dt * 16 + i) * LP + kk0_ + 8 * g); } while (0)
#define ATT_COMPUTE(KF, VF, si) do { const bool metastep = (si) == 0; const int kk0_ = metastep ? 0 : ks + 32 * ((si) - 1); \
    float fd[8]; bool vl[8]; \
    _Pragma("unroll") for (int e = 0; e < 8; ++e) { const int tk = kk0_ + 8 * g + e; int dist = tq - tk; dist = dist < 0 ? -dist : dist; \
        vl[e] = metastep ? (tk < NMETA) : (dist <= 128 && tk >= NMETA && tk < LTOK); fd[e] = (float)(dist > 128 ? 128 : dist); } \
    _Pragma("unroll") for (int h = 0; h < 4; ++h) { float p[8]; \
        _Pragma("unroll") for (int T = 0; T < 2; ++T) { f32x4 S = (f32x4){0.f, 0.f, 0.f, 0.f}; \
            S = __builtin_amdgcn_mfma_f32_16x16x32_bf16(KF[T][0], Qf[h][0], S, 0, 0, 0); \
            S = __builtin_amdgcn_mfma_f32_16x16x32_bf16(KF[T][1], Qf[h][1], S, 0, 0, 0); \
            _Pragma("unroll") for (int j = 0; j < 4; ++j) { const float ex = __builtin_amdgcn_exp2f(S[j] - slope[h] * fd[4 * T + j] - M0); p[4 * T + j] = vl[4 * T + j] ? ex : 0.f; } } \
        l[h] += ((p[0] + p[1]) + (p[2] + p[3])) + ((p[4] + p[5]) + (p[6] + p[7])); \
        v4u pw; pw.x = pg8::cvt_pk_bf16(p[0], p[1]); pw.y = pg8::cvt_pk_bf16(p[2], p[3]); pw.z = pg8::cvt_pk_bf16(p[4], p[5]); pw.w = pg8::cvt_pk_bf16(p[6], p[7]); \
        const bf16x8 P = __builtin_bit_cast(bf16x8, pw); \
        _Pragma("unroll") for (int dt = 0; dt < 4; ++dt) Oa[h][dt] = __builtin_amdgcn_mfma_f32_16x16x32_bf16(VF[dt], P, Oa[h][dt], 0, 0, 0); } } while (0)
__device__ __forceinline__ void attn_phase(const Args& a, int lane, int wave) {
    unsigned char* ws = a.ws;
    const bf16* Q = (const bf16*)(ws + WS_Q); const bf16* Kb = (const bf16*)(ws + WS_K); const bf16* Vt = (const bf16*)(ws + WS_VT); bf16* O = (bf16*)(ws + WS_PERM); float* ssA = (float*)(ws + WS_CTL + CT_SSA);
    const int i = lane & 15, g = lane >> 4;
    constexpr float L2E = 1.4426950408889634f;
    const float gq = wave_max(fabsf(a.in[8][lane])), gk = wave_max(fabsf(a.in[9][lane]));
    const float M0 = fminf(8.0f * gq * gk, 80.0f) * L2E;
    const int gw = blockIdx.x * NWAVES + wave, NGW = gridDim.x * NWAVES;
    for (int unit = gw; unit < 2048; unit += NGW) {
        const int qt = unit >> 1, kvh = unit & 1;
        const int tq0 = NMETA + 16 * qt, tq = tq0 + i;
        bf16x8 Qf[4][2];
#pragma unroll
        for (int h = 0; h < 4; ++h)
#pragma unroll
            for (int hf = 0; hf < 2; ++hf) Qf[h][hf] = *(const bf16x8*)(Q + (size_t)tq * 512 + (kvh * 4 + h) * 64 + hf * 32 + 8 * g);
        f32x4 Oa[4][4]; float l[4], slope[4];
#pragma unroll
        for (int h = 0; h < 4; ++h) { l[h] = 0.f; slope[h] = __builtin_amdgcn_exp2f(-(float)(kvh * 4 + h + 1)) * L2E;
#pragma unroll
            for (int dt = 0; dt < 4; ++dt) Oa[h][dt] = (f32x4){0.f, 0.f, 0.f, 0.f}; }
        const int ks = (tq0 - 128) < 0 ? 0 : ((tq0 - 128) & ~31), ke = (tq0 + 143) & ~31;
        const int nsteps = 2 + (ke - ks) / 32;
        bf16x8 KfA[2][2], VfA[4], KfB[2][2], VfB[4];
        ATT_LOAD(KfA, VfA, 0);
        for (int si = 0; si < nsteps; si += 2) {
            if (si + 1 < nsteps) ATT_LOAD(KfB, VfB, si + 1);
            ATT_COMPUTE(KfA, VfA, si);
            if (si + 1 < nsteps) {
                if (si + 2 < nsteps) ATT_LOAD(KfA, VfA, si + 2);
                ATT_COMPUTE(KfB, VfB, si + 1);
            }
        }
        float sq = 0.f;
#pragma unroll
        for (int h = 0; h < 4; ++h) {
            float lt = l[h]; lt += __shfl_xor(lt, 16); lt += __shfl_xor(lt, 32);
            lt += __builtin_amdgcn_exp2f(a.in[10][kvh * 4 + h] * L2E - M0);
            const float inv = 1.0f / lt;
#pragma unroll
            for (int dt = 0; dt < 4; ++dt) { const f32x4 o = Oa[h][dt] * inv;
                sq += (o[0] * o[0] + o[1] * o[1]) + (o[2] * o[2] + o[3] * o[3]);
                *(v2u*)(O + (size_t)(tq - NMETA) * DM + (kvh * 4 + h) * 64 + dt * 16 + 4 * g) = (v2u){pg8::cvt_pk_bf16(o[0], o[1]), pg8::cvt_pk_bf16(o[2], o[3])}; }
        }
        sq += __shfl_xor(sq, 16); sq += __shfl_xor(sq, 32);
        if (g == 0) atomicAdd(ssA + (tq - NMETA), sq);
    }
}

__device__ __forceinline__ void mixnorm_phase(const Args& a, int lane, int wave) {
    unsigned char* ws = a.ws;
    const bf16* O = (const bf16*)(ws + WS_O); const float* Y = (const float*)(ws + WS_Y); bf16* MX = (bf16*)(ws + WS_XB);
    const int gw = blockIdx.x * NWAVES + wave, NGW = gridDim.x * NWAVES;
    for (int s0 = 4 * gw; s0 < SEQ; s0 += 4 * NGW) {
        v4u ov[4]; f32x4 y0[4], y1[4]; float sa[4], sf[4];
#pragma unroll
        for (int r = 0; r < 4; ++r) { const int s = s0 + r; ov[r] = *(const v4u*)(O + (size_t)s * 512 + 8 * lane);
            y0[r] = *(const f32x4*)(Y + (size_t)(NMETA + s) * 512 + 8 * lane); y1[r] = *(const f32x4*)(Y + (size_t)(NMETA + s) * 512 + 8 * lane + 4); }
        float of[4][8];
#pragma unroll
        for (int r = 0; r < 4; ++r) {
            of[r][0] = bf2f(ov[r].x & 0xffffu); of[r][1] = bf2f(ov[r].x >> 16); of[r][2] = bf2f(ov[r].y & 0xffffu); of[r][3] = bf2f(ov[r].y >> 16);
            of[r][4] = bf2f(ov[r].z & 0xffffu); of[r][5] = bf2f(ov[r].z >> 16); of[r][6] = bf2f(ov[r].w & 0xffffu); of[r][7] = bf2f(ov[r].w >> 16);
            float t = 0.f;
#pragma unroll
            for (int j = 0; j < 8; ++j) t += of[r][j] * of[r][j];
            sa[r] = t;
            sf[r] = (y0[r].x * y0[r].x + y0[r].y * y0[r].y) + (y0[r].z * y0[r].z + y0[r].w * y0[r].w) + (y1[r].x * y1[r].x + y1[r].y * y1[r].y) + (y1[r].z * y1[r].z + y1[r].w * y1[r].w);
        }
#pragma unroll
        for (int o = 1; o < 64; o <<= 1) {
#pragma unroll
            for (int r = 0; r < 4; ++r) { sa[r] += __shfl_xor(sa[r], o); sf[r] += __shfl_xor(sf[r], o); } }
#pragma unroll
        for (int r = 0; r < 4; ++r) { const int s = s0 + r;
            const float ra = pg8::rstd_of(sa[r], 1.0f / 512.0f), rf = pg8::rstd_of(sf[r], 1.0f / 512.0f);
            *(v4u*)(MX + (size_t)s * DM + 8 * lane) = (v4u){pk2(of[r][0] * ra, of[r][1] * ra), pk2(of[r][2] * ra, of[r][3] * ra), pk2(of[r][4] * ra, of[r][5] * ra), pk2(of[r][6] * ra, of[r][7] * ra)};
            *(v4u*)(MX + (size_t)s * DM + 512 + 8 * lane) = (v4u){pk2(y0[r].x * rf, y0[r].y * rf), pk2(y0[r].z * rf, y0[r].w * rf), pk2(y1[r].x * rf, y1[r].y * rf), pk2(y1[r].z * rf, y1[r].w * rf)};
        }
    }
}
__device__ __forceinline__ void finalnorm_phase(const Args& a, float* dst, int lane, int wave) {
    const int gw = blockIdx.x * NWAVES + wave, NGW = gridDim.x * NWAVES;
    const f32x4* gp = (const f32x4*)a.in[18];
    f32x4 gv[4];
#pragma unroll
    for (int j = 0; j < 4; ++j) gv[j] = gp[lane + 64 * j];
    for (int s0 = 4 * gw; s0 < SEQ; s0 += 4 * NGW) {
        f32x4 v[4][4]; float q[4];
#pragma unroll
        for (int r = 0; r < 4; ++r) { const f32x4* row = (const f32x4*)(a.out + (size_t)(s0 + r) * DM);
#pragma unroll
            for (int j = 0; j < 4; ++j) v[r][j] = row[lane + 64 * j]; }
#pragma unroll
        for (int r = 0; r < 4; ++r) { float t = 0.f;
#pragma unroll
            for (int j = 0; j < 4; ++j) t += (v[r][j].x * v[r][j].x + v[r][j].y * v[r][j].y) + (v[r][j].z * v[r][j].z + v[r][j].w * v[r][j].w);
            q[r] = t; }
#pragma unroll
        for (int o = 1; o < 64; o <<= 1) {
#pragma unroll
            for (int r = 0; r < 4; ++r) q[r] += __shfl_xor(q[r], o); }
#pragma unroll
        for (int r = 0; r < 4; ++r) { const float rs = pg8::rstd_of(q[r], 1.0f / 1024.0f); f32x4* orow = (f32x4*)(dst + (size_t)(s0 + r) * DM);
#pragma unroll
            for (int j = 0; j < 4; ++j) orow[lane + 64 * j] = v[r][j] * rs * gv[j]; }
    }
}

#ifndef PROBE_DUP
#define PROBE_DUP 0
#endif
#ifndef PHASE_MASK
#define PHASE_MASK 0xFFFF
#endif
constexpr int PM = PHASE_MASK;
#ifndef PG8_SP2
#define PG8_SP2 true
#endif
#ifndef PG8_ALIGN
#define PG8_ALIGN true
#endif

__global__ void __launch_bounds__(NWAVES * 64, 2) mega_fwd(Args args) {
    extern __shared__ __attribute__((aligned(16))) unsigned char lds_raw[];
    cg::grid_group grid = cg::this_grid();
    LAS unsigned char* lds = (LAS unsigned char*)lds_raw;
    const int tid = threadIdx.x, lane = tid & 63, wave = __builtin_amdgcn_readfirstlane(tid >> 6);
    const int G = gridDim.x, bx = blockIdx.x;
    unsigned char* ws = args.ws;
    float* ss0 = (float*)(ws + WS_SS0); float* ss1 = (float*)(ws + WS_CTL + CT_SS1); float* ss2 = (float*)(ws + WS_CTL + CT_SS2);
    bf16* XB = (bf16*)(ws + WS_XB); bf16* HID = (bf16*)(ws + WS_HID);

    if (tid < 16) ((LAS unsigned*)(lds + MISC_OFF))[tid] = 0u;
    __syncthreads();
    XcdBarrier bar = xcd_barrier_post((unsigned*)(ws + WS_CTL + CT_BAR), (volatile LAS unsigned*)(lds + MISC_OFF));
    if (tid == 0) { const unsigned r = xb_add((unsigned*)(ws + WS_CTL + CT_TIX) + 64 * bar.x, 1u); ((volatile LAS unsigned*)(lds + MISC_OFF))[4] = r * 8u + bar.x; }
    if (args.out == nullptr) grid.sync();
#if PROBE_DUP & 1
    p0_prologue(args, lds, tid, lane, wave); xcd_barrier(bar);
#endif
    if (PM & 1) p0_prologue(args, lds, tid, lane, wave);
    xcd_barrier(bar);
    int vb = bx;
    { bool ok = (G == 256);
      for (int j = 0; j < 8; ++j) ok = ok && (xb_ld((unsigned*)(ws + WS_CTL + CT_BAR) + XB_XCNT(j)) == 32u);
      if (ok) vb = (int)((volatile LAS unsigned*)(lds + MISC_OFF))[4]; vb = __builtin_amdgcn_readfirstlane(vb); }
    if (PM & 2) {
        pg8::Gemm g{XB, (const bf16*)(ws + WS_WGU1), LP, 2 * FF, DM}; pg8::StaticOrder S; S.init(LP, 2 * FF, G, vb);
        pg8::EpiSwiglu E{HID, ss0, FF};
        pg8::gemm_phase<pg8::EpiSwiglu, pg8::StaticOrder, PG8_ALIGN, PG8_SP2>(lds, g, S, E);
        if (vb >= 150) late_weights(args, lds, TR_N0, TR_N1, (vb - 150) * NWAVES + wave, (256 - 150) * NWAVES, lane, wave);
    }
    xcd_barrier(bar);
    if (PM & 4) {
        meta_down(args, lds, tid, lane, wave);
        pg8::Gemm g{HID + (size_t)NMETA * FF, (const bf16*)(ws + WS_WD1), SEQ, DM, FF}; pg8::StaticOrder S; S.init(SEQ, DM, G, vb);
        pg8::EpiRes E{XB + (size_t)NMETA * DM, XB + (size_t)NMETA * DM, (bf16*)(ws + WS_PERM), ss1 + NMETA, 0.5f};
        pg8::gemm_phase<pg8::EpiRes, pg8::StaticOrder, false, PG8_SP2>(lds, g, S, E);
    }
    xcd_barrier(bar);
    if (PM & 8) {
        pg8::Gemm g{XB, (const bf16*)(ws + WS_WQKV), LP, 768, DM}; pg8::StaticOrder S; S.init(LP, 768, G, vb);
        pg8::EpiQKV E{(bf16*)(ws + WS_Q), (bf16*)(ws + WS_K), (bf16*)(ws + WS_VT), ss1, args.in[8], args.in[9], LP};
        pg8::gemm_phase<pg8::EpiQKV, pg8::StaticOrder, PG8_ALIGN, PG8_SP2>(lds, g, S, E);
        pg8::Gemm g0{(const bf16*)(ws + WS_WG), (const bf16*)(ws + WS_PERM), 1024, LP, DM}; pg8::StaticOrder S0; S0.init(1024, LP, G, (vb + 61) & 255);
        pg8::EpiG0 E0{(bf16*)(ws + WS_X), ss1};
        pg8::gemm_phase<pg8::EpiG0, pg8::StaticOrder, PG8_ALIGN, PG8_SP2>(lds, g0, S0, E0);
        if (vb >= 199) late_weights(args, lds, TR_N1, TR_N1 + 704, (vb - 199) * NWAVES + wave, (256 - 199) * NWAVES, lane, wave);
    }
    xcd_barrier(bar);
    if (PM & 16) {
        int kdim = 256; asm volatile("" : "+s"(kdim));
        pg8::Gemm g{(const bf16*)(ws + WS_A1), (const bf16*)(ws + WS_X), 256, 512 * 164, kdim}; pg8::StaticOrder S; S.init(256, 512 * 164, G, vb);
        pg8::EpiG1 E{(bf16*)(ws + WS_X1)};
        pg8::gemm_phase<pg8::EpiG1, pg8::StaticOrder, PG8_ALIGN, PG8_SP2>(lds, g, S, E);
        attn_phase(args, lane, wave);
        if (vb >= 72) late_weights(args, lds, TR_N1 + 704, TR_N1 + 1408, (vb - 72) * NWAVES + wave, (256 - 72) * NWAVES, lane, wave);
    }
    xcd_barrier(bar);
#if PROBE_DUP & 2
    attn_phase(args, lane, wave); xcd_barrier(bar);
#endif
    if (PM & 32) {
        int kdim = 384; asm volatile("" : "+s"(kdim));
        pg8::Gemm g{(const bf16*)(ws + WS_A3), (const bf16*)(ws + WS_X1), 256, 100 * 512, kdim}; pg8::StaticOrder S; S.init(256, 100 * 512, G, vb);
        pg8::EpiG3 E{(bf16*)(ws + WS_PERM), (float*)(ws + WS_CTL + CT_SSF)};
        pg8::gemm_phase<pg8::EpiG3, pg8::StaticOrder, PG8_ALIGN, PG8_SP2>(lds, g, S, E);
        if (vb >= 200) late_weights(args, lds, TR_N1 + 2112, TR_N, (vb - 200) * NWAVES + wave, (256 - 200) * NWAVES, lane, wave);
    }
    xcd_barrier(bar);
    if (PM & 128) {
        pg8::Gemm g{(const bf16*)(ws + WS_PERM), (const bf16*)(ws + WS_WOUT), SEQ, DM, DM}; pg8::StaticOrder S; S.init(SEQ, DM, G, vb);
        pg8::EpiResMix E{XB + (size_t)NMETA * DM, (bf16*)(ws + WS_H2B), ss2, (const float*)(ws + WS_CTL + CT_SSA), (const float*)(ws + WS_CTL + CT_SSF)};
        pg8::gemm_phase<pg8::EpiResMix, pg8::StaticOrder, false, PG8_SP2>(lds, g, S, E);
    }
    xcd_barrier(bar);
    if (PM & 256) {
        pg8::Gemm g{(const bf16*)(ws + WS_H2B), (const bf16*)(ws + WS_WGU2), SEQ, 2 * FF, DM}; pg8::StaticOrder S; S.init(SEQ, 2 * FF, G, vb);
        pg8::EpiSwiglu E{HID, ss2, FF};
        pg8::gemm_phase<pg8::EpiSwiglu, pg8::StaticOrder, PG8_ALIGN, PG8_SP2>(lds, g, S, E);
        if (vb >= 128) late_weights(args, lds, TR_N1 + 1408, TR_N1 + 2112, (vb - 128) * NWAVES + wave, 128 * NWAVES, lane, wave);
    }
    xcd_barrier(bar);
    if (PM & 512) {
        pg8::Gemm g{HID, (const bf16*)(ws + WS_WD2), SEQ, DM, FF}; pg8::StaticOrder S; S.init(SEQ, DM, G, vb);
        pg8::EpiResFinal E{(const bf16*)(ws + WS_H2B), args.out, (float*)(ws + WS_SLOT), (unsigned*)(ws + WS_CTL + CT_PCNT), args.in[18], 0.5f};
        pg8::gemm_phase<pg8::EpiResFinal, pg8::StaticOrder, false, PG8_SP2>(lds, g, S, E);
    }
}

extern "C" void kernel_launch(void* const* d_in, const int* in_sizes, int n_in, void* d_out, int out_size, void* d_ws, size_t ws_size, hipStream_t stream) {
    static int grid = 0;
    if (grid == 0) {
        if (n_in != 19 || out_size != SEQ * DM || ws_size < WS_END) { fprintf(stderr, "kernel_launch: unexpected shapes (n_in %d out %d ws %zu)\n", n_in, out_size, ws_size); grid = -1; return; }
        int dev = 0, cus = 0, per_cu = 0;
        hipGetDevice(&dev); hipDeviceGetAttribute(&cus, hipDeviceAttributeMultiprocessorCount, dev);
        hipFuncSetAttribute((const void*)mega_fwd, hipFuncAttributeMaxDynamicSharedMemorySize, LDS_BYTES);
        hipOccupancyMaxActiveBlocksPerMultiprocessor(&per_cu, (const void*)mega_fwd, NWAVES * 64, LDS_BYTES);
        (void)hipGetLastError();
        if (per_cu < 1) per_cu = 1;
        grid = cus;
        if (grid != 256) fprintf(stderr, "kernel_launch: %d CUs (expected 256)\n", cus);
    }
    if (grid < 0) return;
    hipMemsetAsync((char*)d_ws + WS_CTL, 0, CTL_BYTES, stream);
    Args a{};
    for (int i = 0; i < 19; ++i) a.in[i] = (const float*)d_in[i];
    a.out = (float*)d_out; a.ws = (unsigned char*)d_ws;
    void* kargs[] = {&a};
    hipError_t e = hipLaunchCooperativeKernel((const void*)mega_fwd, dim3(grid), dim3(NWAVES * 64), kargs, LDS_BYTES, stream);
    if (e != hipSuccess) fprintf(stderr, "cooperative launch failed: %s (grid %d)\n", hipGetErrorString(e), grid);
}
```

```cpp
#include <hip/hip_runtime.h>
#include <hip/hip_cooperative_groups.h>
#include <cstdio>
#include <cstdint>
namespace cg = cooperative_groups;
namespace pg8 {
#define PG8_LAS __attribute__((address_space(3)))
typedef unsigned short bf16_t;
typedef short bf16x8 __attribute__((ext_vector_type(8)));
typedef float f32x4 __attribute__((ext_vector_type(4)));
typedef unsigned u32x4 __attribute__((ext_vector_type(4)));
constexpr int BM = 256, BK = 64, HALF = 128, HTB = HALF * BK * 2  , STAGE_BYTES = 8 * HTB, NXCD = 8, WGM = 8;

__host__ __device__ __forceinline__ int lds_byte(int r, int c) { const int st = (r >> 4) * 2 + (c >> 5), rr = r & 15, cc = c & 31, ob = rr * 64 + cc * 2; return st * 1024 + (ob ^ (((ob >> 9) & 1) << 5)); }
__host__ __device__ __forceinline__ void stage_rc(int b, int& R, int& C) { const int st = b / 1024, sb = b % 1024, swz = sb ^ (((sb >> 9) & 1) << 5); R = (st >> 1) * 16 + swz / 64; C = (st & 1) * 32 + (swz % 64) / 2; }
__host__ __device__ __forceinline__ int perm32(int rho) { const int n = rho >> 4, i = rho & 15; return 8 * (i >> 2) + 4 * n + (i & 3); }

struct Unit { int pm, pn; };
struct Gemm { const bf16_t* A; const bf16_t* Bt; int M, N, K; };

struct StaticOrder {
    int nM, nN, nwg, G, c;
    __host__ __device__ void init(int M, int N, int G_, int c_) { nM = M / BM; nN = N / BM; nwg = nM * nN; G = G_; c = c_; }
    __host__ __device__ bool next(int i, Unit& u) const {
        const long L = (long)i * G + c; if (L >= nwg) return false;
        int wgid = (int)L; { const int q = nwg / NXCD, r = nwg % NXCD, xcd = wgid % NXCD, off = wgid / NXCD; wgid = (xcd < r ? xcd * (q + 1) : r * (q + 1) + (xcd - r) * q) + off; }
        const int nig = WGM * nN, gid = wgid / nig, fm = gid * WGM, gsz = (nM - fm) < WGM ? (nM - fm) : WGM;
        u.pm = fm + ((wgid % nig) % gsz); u.pn = (wgid % nig) / gsz; return true;
    }
    __device__ __forceinline__ void a_ready(const Unit&) const {}
    __device__ __forceinline__ void done(const Unit&) const {}
};
__device__ __forceinline__ unsigned cvt_pk_bf16(float lo, float hi) { unsigned r; asm volatile("v_cvt_pk_bf16_f32 %0, %1, %2" : "=v"(r) : "v"(lo), "v"(hi)); return r; }
typedef float f32x2 __attribute__((ext_vector_type(2)));
template <class Epi, class Sched, bool ALIGN_EPI = false, bool SP2 = false>
__device__ __forceinline__ void gemm_phase(PG8_LAS unsigned char* lds, const Gemm g, const Sched& S, const Epi& E) {
    int tid_ = threadIdx.x; asm volatile("" : "+v"(tid_));
    const int tid = tid_, wid = __builtin_amdgcn_readfirstlane(tid >> 6), lane = tid & 63, wr = wid >> 2, wc = wid & 3, fr = lane & 15, fq = lane >> 4;
    const int K = g.K, nt = K / BK;
    unsigned voffA[2], voffB[2];
#pragma unroll
    for (int i = 0; i < 2; ++i) { int R, C; stage_rc(tid * 16 + i * 8192, R, C); const int Rb = Epi::PERM ? ((R & ~31) + perm32(R & 31)) : R;
        voffA[i] = (unsigned)(R * K + C) * 2u; voffB[i] = (unsigned)(Rb * K + C) * 2u; }
    const size_t kstep = (size_t)(BK * 2);
    const size_t hstep = (size_t)HALF * K * 2;
    const size_t tstep = 2 * hstep;
    const unsigned ldsw = (unsigned)wid * 1024u;
    const int aoff = lds_byte(wr * 64 + fr, fq * 8), boff = lds_byte(wc * 32 + fr, fq * 8);
#define PG8_SA(b, h) (((b) * 2 + (h)) * HTB)
#define PG8_SB(b, h) ((4 + (b) * 2 + (h)) * HTB)
#define PG8_STAGE(bufoff, gbase, voff) do { _Pragma("unroll") for (int _i = 0; _i < 2; ++_i) \
        __builtin_amdgcn_global_load_lds((const unsigned*)((const char*)(gbase) + (voff)[_i]), (PG8_LAS unsigned*)(lds + (bufoff) + ldsw + _i * 8192), 16, 0, 0); } while (0)
#define PG8_LDA(dst, b, h) do { _Pragma("unroll") for (int m = 0; m < 4; ++m) _Pragma("unroll") for (int k = 0; k < 2; ++k) dst[m][k] = *(const PG8_LAS bf16x8*)(lds + PG8_SA(b, h) + aoff + m * 2048 + k * 1024); } while (0)
#define PG8_LDB(dst, b, h) do { _Pragma("unroll") for (int n = 0; n < 2; ++n) _Pragma("unroll") for (int k = 0; k < 2; ++k) dst[n][k] = *(const PG8_LAS bf16x8*)(lds + PG8_SB(b, h) + boff + n * 2048 + k * 1024); } while (0)
#define PG8_MMA(ai, bj, At, Bt) do { __builtin_amdgcn_s_setprio(1); _Pragma("unroll") for (int m = 0; m < 4; ++m) _Pragma("unroll") for (int n = 0; n < 2; ++n) _Pragma("unroll") for (int k = 0; k < 2; ++k) \
        acc[ai][bj][m][n] = __builtin_amdgcn_mfma_f32_16x16x32_bf16(Bt[n][k], At[m][k], acc[ai][bj][m][n], 0, 0, 0); __builtin_amdgcn_s_setprio(0); } while (0)
#define PG8_WAIT_V(n) asm volatile("s_waitcnt vmcnt(" #n ")" ::: "memory")
#define PG8_WAIT_L(n) asm volatile("s_waitcnt lgkmcnt(" #n ")" ::: "memory")
#define PG8_BAR __builtin_amdgcn_s_barrier()
#define PG8_SCHED __builtin_amdgcn_sched_barrier(0)
    Unit cur, nxt; int ui = 0;
    if (!S.next(0, cur)) return;
    f32x4 acc[2][2][4][2];
#pragma unroll
    for (int a = 0; a < 2; ++a)
#pragma unroll
        for (int b = 0; b < 2; ++b)
#pragma unroll
            for (int m = 0; m < 4; ++m)
#pragma unroll
                for (int n = 0; n < 2; ++n) acc[a][b][m][n] = (f32x4){0.f, 0.f, 0.f, 0.f};
    bf16x8 At[4][2], B0[2][2], B1[2][2];
    const char* cA = (const char*)g.A + (size_t)cur.pm * tstep; const char* cB = (const char*)g.Bt + (size_t)cur.pn * tstep;
    S.a_ready(cur);
    if constexpr (SP2) {
        PG8_STAGE(PG8_SB(0, 0), cB, voffB); PG8_STAGE(PG8_SB(0, 1), cB + hstep, voffB); PG8_STAGE(PG8_SA(0, 0), cA, voffA); PG8_STAGE(PG8_SA(0, 1), cA + hstep, voffA);
        if (wr == 1) PG8_BAR;
        PG8_WAIT_V(2); PG8_BAR;
        PG8_STAGE(PG8_SB(1, 0), cB + kstep, voffB); PG8_STAGE(PG8_SA(1, 0), cA + kstep, voffA); PG8_STAGE(PG8_SB(1, 1), cB + hstep + kstep, voffB);
        PG8_WAIT_V(6); PG8_BAR;
    } else {
        PG8_STAGE(PG8_SB(0, 0), cB, voffB); PG8_STAGE(PG8_SA(0, 0), cA, voffA); PG8_STAGE(PG8_SB(0, 1), cB + hstep, voffB); PG8_STAGE(PG8_SA(0, 1), cA + hstep, voffA);
        if (wr == 1) PG8_BAR;
        PG8_WAIT_V(4); PG8_BAR;
        PG8_STAGE(PG8_SB(1, 0), cB + kstep, voffB); PG8_STAGE(PG8_SA(1, 0), cA + kstep, voffA); PG8_STAGE(PG8_SB(1, 1), cB + hstep + kstep, voffB);
        PG8_WAIT_V(6); PG8_BAR;
    }
    for (;;) {
        const bool has_next = S.next(ui + 1, nxt);
        const char* nA = has_next ? (const char*)g.A + (size_t)nxt.pm * tstep : cA; const char* nB = has_next ? (const char*)g.Bt + (size_t)nxt.pn * tstep : cB;
        for (int t = 0; t < nt; t += 2) {
            const bool last = (t == nt - 2);
            const char* a1 = cA + (size_t)(t + 1) * kstep;
            const char* a2 = last ? nA : cA + (size_t)(t + 2) * kstep; const char* b2 = last ? nB : cB + (size_t)(t + 2) * kstep;
            const char* a3 = a2 + kstep; const char* b3 = b2 + kstep;
            if (last && has_next) S.a_ready(nxt);
            if constexpr (Epi::MIDSCALE) { if (t == (nt >> 1)) E.mid(acc, cur, wr, wc, fr, fq); }
            if constexpr (SP2) {
            PG8_LDB(B0, 0, 0); PG8_LDB(B1, 0, 1); PG8_SCHED; PG8_LDA(At, 0, 0); PG8_STAGE(PG8_SA(1, 1), a1 + hstep, voffA);
            PG8_WAIT_V(8); PG8_WAIT_L(0); PG8_BAR; PG8_MMA(0, 0, At, B0); PG8_MMA(0, 1, At, B1); PG8_BAR; PG8_SCHED;
            PG8_LDA(At, 0, 1); PG8_STAGE(PG8_SB(0, 0), b2, voffB); PG8_STAGE(PG8_SB(0, 1), b2 + hstep, voffB); PG8_STAGE(PG8_SA(0, 0), a2, voffA);
            PG8_WAIT_V(8); PG8_WAIT_L(0); PG8_BAR; PG8_MMA(1, 0, At, B0); PG8_MMA(1, 1, At, B1); PG8_BAR; PG8_SCHED;
            PG8_LDB(B0, 1, 0); PG8_LDB(B1, 1, 1); PG8_SCHED; PG8_LDA(At, 1, 0); PG8_STAGE(PG8_SA(0, 1), a2 + hstep, voffA);
            PG8_WAIT_V(8); PG8_WAIT_L(0); PG8_BAR; PG8_MMA(0, 0, At, B0); PG8_MMA(0, 1, At, B1); PG8_BAR; PG8_SCHED;
            PG8_LDA(At, 1, 1); PG8_STAGE(PG8_SB(1, 0), b3, voffB); PG8_STAGE(PG8_SB(1, 1), b3 + hstep, voffB); PG8_STAGE(PG8_SA(1, 0), a3, voffA);
            PG8_WAIT_V(8); PG8_WAIT_L(0); PG8_BAR; PG8_MMA(1, 0, At, B0); PG8_MMA(1, 1, At, B1); PG8_BAR; PG8_SCHED;
            } else {
            PG8_LDB(B0, 0, 0); PG8_SCHED; PG8_LDA(At, 0, 0); PG8_STAGE(PG8_SA(1, 1), a1 + hstep, voffA);
            PG8_WAIT_L(8); PG8_BAR; PG8_WAIT_L(0); PG8_MMA(0, 0, At, B0); PG8_BAR; PG8_SCHED;
            PG8_LDB(B1, 0, 1); PG8_STAGE(PG8_SB(0, 0), b2, voffB);
            PG8_BAR; PG8_WAIT_L(0); PG8_MMA(0, 1, At, B1); PG8_BAR;
            PG8_LDA(At, 0, 1); PG8_STAGE(PG8_SA(0, 0), a2, voffA);
            PG8_BAR; PG8_WAIT_L(0); PG8_MMA(1, 0, At, B0); PG8_BAR; PG8_SCHED;
            PG8_STAGE(PG8_SB(0, 1), b2 + hstep, voffB);
            PG8_WAIT_V(6); PG8_BAR; PG8_MMA(1, 1, At, B1); PG8_BAR;
            PG8_LDB(B0, 1, 0); PG8_SCHED; PG8_LDA(At, 1, 0); PG8_STAGE(PG8_SA(0, 1), a2 + hstep, voffA);
            PG8_WAIT_L(8); PG8_BAR; PG8_WAIT_L(0); PG8_MMA(0, 0, At, B0); PG8_BAR; PG8_SCHED;
            PG8_LDB(B1, 1, 1); PG8_STAGE(PG8_SB(1, 0), b3, voffB);
            PG8_BAR; PG8_WAIT_L(0); PG8_MMA(0, 1, At, B1); PG8_BAR;
            PG8_LDA(At, 1, 1); PG8_STAGE(PG8_SA(1, 0), a3, voffA);
            PG8_BAR; PG8_WAIT_L(0); PG8_MMA(1, 0, At, B0); PG8_BAR; PG8_SCHED;
            PG8_STAGE(PG8_SB(1, 1), b3 + hstep, voffB);
            PG8_WAIT_V(6); PG8_BAR; PG8_MMA(1, 1, At, B1); PG8_BAR;
            }
        }
        if constexpr (ALIGN_EPI) { if (wr == 0) PG8_BAR; }
        if constexpr (!Epi::AFTER_DRAIN) { E(acc, cur, wr, wc, fr, fq); S.done(cur); }
        if (!has_next) break;
#pragma unroll
        for (int a = 0; a < 2; ++a)
#pragma unroll
            for (int b = 0; b < 2; ++b)
#pragma unroll
                for (int m = 0; m < 4; ++m)
#pragma unroll
                    for (int n = 0; n < 2; ++n) acc[a][b][m][n] = (f32x4){0.f, 0.f, 0.f, 0.f};
        cur = nxt; cA = nA; cB = nB; ++ui;
        if constexpr (ALIGN_EPI) { if (wr == 1) PG8_BAR; }
    }
    PG8_WAIT_V(0);
    if constexpr (!ALIGN_EPI) { if (wr == 0) PG8_BAR; }
    PG8_BAR;
    if constexpr (Epi::AFTER_DRAIN) { E.fused(acc, cur, wr, wc, fr, fq, lds, wid, lane); S.done(cur); }
#undef PG8_SA
#undef PG8_SB
#undef PG8_STAGE
#undef PG8_LDA
#undef PG8_LDB
#undef PG8_MMA
#undef PG8_WAIT_V
#undef PG8_WAIT_L
#undef PG8_BAR
#undef PG8_SCHED
}

typedef unsigned u32x2 __attribute__((ext_vector_type(2)));
constexpr float RMS_EPS = 1e-6f;
__device__ __forceinline__ float rstd_of(float ss, float inv_n) { return __builtin_amdgcn_rsqf(ss * inv_n + RMS_EPS); }
__device__ __forceinline__ float silu_f(float x) { return x * __builtin_amdgcn_rcpf(1.0f + __builtin_amdgcn_exp2f(-1.4426950408889634f * x)); }

struct EpiSwiglu {
    static constexpr bool PERM = true, AFTER_DRAIN = false, MIDSCALE = false;
    bf16_t* H; const float* ss; int ldh;
    __device__ __forceinline__ void operator()(const f32x4 (&acc)[2][2][4][2], const Unit& u, int wr, int wc, int fr, int fq) const {
        asm volatile("" : "+v"(fr), "+v"(fq), "+s"(wr), "+s"(wc));
        const int row0 = u.pm * BM + wr * 64 + fr, col0 = u.pn * HALF + wc * 32 + 8 * fq;
        float rsv[8];
#pragma unroll
        for (int q = 0; q < 8; ++q) rsv[q] = ss[row0 + (q >> 2) * HALF + (q & 3) * 16];
#pragma unroll
        for (int ai = 0; ai < 2; ++ai)
#pragma unroll
            for (int m = 0; m < 4; ++m) {
                const int row = row0 + ai * HALF + m * 16;
                const float rs = rstd_of(rsv[ai * 4 + m], 1.0f / 1024.0f);
                float o[8];
#pragma unroll
                for (int n = 0; n < 2; ++n)
#pragma unroll
                    for (int j = 0; j < 4; ++j) { const float g = acc[ai][0][m][n][j] * rs, up = acc[ai][1][m][n][j] * rs; o[n * 4 + j] = silu_f(g) * up; }
                u32x4 w; w.x = cvt_pk_bf16(o[0], o[1]); w.y = cvt_pk_bf16(o[2], o[3]); w.z = cvt_pk_bf16(o[4], o[5]); w.w = cvt_pk_bf16(o[6], o[7]);
                *(u32x4*)(H + (size_t)row * ldh + col0) = w;
            }
    }
};

struct EpiRes {
    static constexpr bool PERM = true, AFTER_DRAIN = true, MIDSCALE = false;
    const bf16_t* residh; bf16_t* ob; bf16_t* operm; float* ss; float alpha;
    __device__ __forceinline__ void fused(f32x4 (&acc)[2][2][4][2], const Unit& u, int wr, int wc, int fr, int fq, PG8_LAS unsigned char* lds, int wid, int lane) const {
        PG8_LAS float* Pl = (PG8_LAS float*)lds;
        asm volatile("" : "+v"(fr), "+v"(fq), "+s"(wr), "+s"(wc));
        const int col0 = u.pn * BM + wc * 32 + 8 * fq, s0 = u.pm * BM + wr * 64 + fr;
        u32x4 rh[3][2];
#define EPI_LOADH(q) do { const size_t o_ = (size_t)(s0 + ((q) >> 2) * HALF + ((q) & 3) * 16) * 1024 + col0; \
        _Pragma("unroll") for (int x_ = 0; x_ < 2; ++x_) rh[(q) % 3][x_] = *(const u32x4*)(residh + o_ + x_ * HALF); } while (0)
#define EPI_UNLO(v_) ((f32x4){__builtin_bit_cast(float, (v_).x << 16), __builtin_bit_cast(float, (v_).x & 0xffff0000u), __builtin_bit_cast(float, (v_).y << 16), __builtin_bit_cast(float, (v_).y & 0xffff0000u)})
#define EPI_UNHI(v_) ((f32x4){__builtin_bit_cast(float, (v_).z << 16), __builtin_bit_cast(float, (v_).z & 0xffff0000u), __builtin_bit_cast(float, (v_).w << 16), __builtin_bit_cast(float, (v_).w & 0xffff0000u)})
        EPI_LOADH(0); EPI_LOADH(1);
#pragma unroll
        for (int q = 0; q < 8; ++q) {
            const int ai = q >> 2, m = q & 3;
            if (q + 2 < 8) EPI_LOADH(q + 2);
            const int s = s0 + ai * HALF + m * 16;
            const int t = s + 16, b = t / 164, a = t - b * 164; const size_t nperm = (size_t)(a * 100 + b);
            float ps = 0.f;
#pragma unroll
            for (int bj = 0; bj < 2; ++bj) {
                const int col = col0 + bj * HALF; const size_t off = (size_t)s * 1024 + col;
                const f32x4 o0 = EPI_UNLO(rh[q % 3][bj]) + acc[ai][bj][m][0] * alpha, o1 = EPI_UNHI(rh[q % 3][bj]) + acc[ai][bj][m][1] * alpha;
                ps += ((o0[0] * o0[0] + o0[1] * o0[1]) + (o0[2] * o0[2] + o0[3] * o0[3])) + ((o1[0] * o1[0] + o1[1] * o1[1]) + (o1[2] * o1[2] + o1[3] * o1[3]));
                u32x4 w; w.x = cvt_pk_bf16(o0[0], o0[1]); w.y = cvt_pk_bf16(o0[2], o0[3]); w.z = cvt_pk_bf16(o1[0], o1[1]); w.w = cvt_pk_bf16(o1[2], o1[3]);
                *(u32x4*)(ob + off) = w;
                *(u32x4*)(operm + nperm * 1024 + col) = w;
            }
            ps += __shfl_xor(ps, 16); ps += __shfl_xor(ps, 32); if (fq == 0) Pl[(ai * HALF + wr * 64 + m * 16 + fr) * 4 + wc] = ps;
        }
        asm volatile("s_waitcnt lgkmcnt(0)" ::: "memory"); __syncthreads();
        if (threadIdx.x < 256) { const int row = threadIdx.x; atomicAdd(ss + u.pm * BM + row, (Pl[row * 4 + 0] + Pl[row * 4 + 1]) + (Pl[row * 4 + 2] + Pl[row * 4 + 3])); }
    }
};

struct EpiQKV {
    static constexpr bool PERM = true, AFTER_DRAIN = false, MIDSCALE = false;
    bf16_t* Q; bf16_t* Kb; bf16_t* Vt; const float* ss; const float* qn; const float* kn; int LPv;
    __device__ __forceinline__ void operator()(const f32x4 (&acc)[2][2][4][2], const Unit& u, int wr, int wc, int fr, int fq) const {
        asm volatile("" : "+v"(fr), "+v"(fq), "+s"(wr), "+s"(wc));
        const int hs = 4 * u.pn + wc;
        f32x4 gn[2][2];
        const float* gp = hs < 8 ? qn : kn;
#pragma unroll
        for (int bj = 0; bj < 2; ++bj)
#pragma unroll
            for (int n = 0; n < 2; ++n) gn[bj][n] = *(const f32x4*)(gp + 32 * bj + 8 * fq + 4 * n);
        const float qs = hs < 8 ? 0.125f * 1.4426950408889634f : 1.0f;
        float rsv[8];
#pragma unroll
        for (int q = 0; q < 8; ++q) rsv[q] = ss[u.pm * BM + (q >> 2) * HALF + wr * 64 + (q & 3) * 16 + fr];
#pragma unroll
        for (int ai = 0; ai < 2; ++ai)
#pragma unroll
            for (int m = 0; m < 4; ++m) {
                const int t = u.pm * BM + ai * HALF + wr * 64 + m * 16 + fr;
                const float rs = rstd_of(rsv[ai * 4 + m], 1.0f / 1024.0f);
                f32x4 v[2][2]; float q = 0.f;
#pragma unroll
                for (int bj = 0; bj < 2; ++bj)
#pragma unroll
                    for (int n = 0; n < 2; ++n) { v[bj][n] = acc[ai][bj][m][n] * rs; const f32x4 x = v[bj][n]; q += (x[0] * x[0] + x[1] * x[1]) + (x[2] * x[2] + x[3] * x[3]); }
                q += __shfl_xor(q, 16); q += __shfl_xor(q, 32);
                if (hs < 10) { const float hr = rstd_of(q, 1.0f / 64.0f) * qs;
#pragma unroll
                    for (int bj = 0; bj < 2; ++bj)
#pragma unroll
                        for (int n = 0; n < 2; ++n) v[bj][n] = v[bj][n] * gn[bj][n] * hr; }
#pragma unroll
                for (int bj = 0; bj < 2; ++bj) {
                    const int d = 32 * bj + 8 * fq; const f32x4 x0 = v[bj][0], x1 = v[bj][1];
                    u32x4 w; w.x = cvt_pk_bf16(x0[0], x0[1]); w.y = cvt_pk_bf16(x0[2], x0[3]); w.z = cvt_pk_bf16(x1[0], x1[1]); w.w = cvt_pk_bf16(x1[2], x1[3]);
                    if (hs < 8) *(u32x4*)(Q + (size_t)t * 512 + hs * 64 + d) = w;
                    else if (hs < 10) *(u32x4*)(Kb + (size_t)t * 128 + (hs - 8) * 64 + d) = w;
                    else { bf16_t* vp = Vt + (size_t)((hs - 10) * 64 + d) * LPv + t; const size_t L_ = (size_t)LPv;
                        vp[0] = (bf16_t)(w.x & 0xffffu); vp[L_] = (bf16_t)(w.x >> 16); vp[2 * L_] = (bf16_t)(w.y & 0xffffu); vp[3 * L_] = (bf16_t)(w.y >> 16);
                        vp[4 * L_] = (bf16_t)(w.z & 0xffffu); vp[5 * L_] = (bf16_t)(w.z >> 16); vp[6 * L_] = (bf16_t)(w.w & 0xffffu); vp[7 * L_] = (bf16_t)(w.w >> 16); }
                }
            }
    }
};

struct EpiG0 {
    static constexpr bool PERM = false, AFTER_DRAIN = false, MIDSCALE = false;
    bf16_t* X; const float* ss;
    __device__ __forceinline__ void operator()(const f32x4 (&acc)[2][2][4][2], const Unit& u, int wr, int wc, int fr, int fq) const {
        asm volatile("" : "+v"(fr), "+v"(fq), "+s"(wr), "+s"(wc));
        const int part = u.pm >> 1;
#pragma unroll
        for (int bj = 0; bj < 2; ++bj)
#pragma unroll
            for (int n = 0; n < 2; ++n) {
                const int nn = u.pn * BM + bj * HALF + wc * 32 + n * 16 + 4 * fq;
                if (nn >= 16400) continue;
                const int a = nn / 100, b = nn - a * 100;
                f32x4 rs;
#pragma unroll
                for (int j = 0; j < 4; ++j) rs[j] = rstd_of(ss[a + 164 * (b + j)], 1.0f / 1024.0f);
#pragma unroll
                for (int ai = 0; ai < 2; ++ai)
#pragma unroll
                    for (int m = 0; m < 4; ++m) {
                        const int c = ((u.pm & 1) * BM) + ai * HALF + wr * 64 + m * 16 + fr;
                        const f32x4 x = acc[ai][bj][m][n] * rs;
                        u32x2 w; w.x = cvt_pk_bf16(x[0], x[1]); w.y = cvt_pk_bf16(x[2], x[3]);
                        bf16_t* p = X + ((size_t)(c * 164 + a) * 2 + part) * 128 + b;
                        *(u32x2*)p = w;
                        if (b == 96) {
#pragma unroll
                            for (int z = 1; z < 8; ++z) *(u32x2*)(p + 4 * z) = (u32x2){0u, 0u}; }
                    }
            }
    }
};

struct EpiG1 {
    static constexpr bool PERM = true, AFTER_DRAIN = false, MIDSCALE = false;
    bf16_t* X1;
    __device__ __forceinline__ void operator()(const f32x4 (&acc)[2][2][4][2], const Unit& u, int wr, int wc, int fr, int fq) const {
        asm volatile("" : "+v"(fr), "+v"(fq), "+s"(wr), "+s"(wc));
#pragma unroll
        for (int m = 0; m < 4; ++m) {
            const int beta = wr * 64 + m * 16 + fr;
            if (beta >= 100) continue;
            const float cd = __builtin_amdgcn_cosf((float)beta * (1.0f / 16400.0f)), sd = __builtin_amdgcn_sinf((float)beta * (1.0f / 16400.0f));
#pragma unroll
            for (int bj = 0; bj < 2; ++bj) {
                const int n1 = u.pn * BM + bj * HALF + wc * 32 + 8 * fq;
                const int c = n1 / 164, a0 = n1 - c * 164;
                const bool cross = a0 == 160;
                float cs = __builtin_amdgcn_cosf((float)(a0 * beta) * (1.0f / 16400.0f)), sn = __builtin_amdgcn_sinf((float)(a0 * beta) * (1.0f / 16400.0f));
                unsigned wre[4], wim[4];
#pragma unroll
                for (int n = 0; n < 2; ++n) {
                    const f32x4 re = acc[0][bj][m][n], im = acc[1][bj][m][n];
                    f32x4 ore, oim;
                    if (n == 1 && cross) { cs = 1.0f; sn = 0.0f; }
#pragma unroll
                    for (int j = 0; j < 4; ++j) {
                        ore[j] = re[j] * cs + im[j] * sn; oim[j] = im[j] * cs - re[j] * sn;
                        const float c2 = cs * cd - sn * sd; sn = sn * cd + cs * sd; cs = c2;
                    }
                    wre[2 * n] = cvt_pk_bf16(ore[0], ore[1]); wre[2 * n + 1] = cvt_pk_bf16(ore[2], ore[3]);
                    wim[2 * n] = cvt_pk_bf16(oim[0], oim[1]); wim[2 * n + 1] = cvt_pk_bf16(oim[2], oim[3]);
                }
                bf16_t* p = X1 + ((size_t)(beta * 512 + c) * 2) * 192 + a0;
                if (!cross) {
                    *(u32x4*)p = (u32x4){wre[0], wre[1], wre[2], wre[3]};
                    *(u32x4*)(p + 192) = (u32x4){wim[0], wim[1], wim[2], wim[3]};
                } else {
                    *(u32x2*)p = (u32x2){wre[0], wre[1]}; *(u32x2*)(p + 192) = (u32x2){wim[0], wim[1]};
#pragma unroll
                    for (int z = 1; z < 8; ++z) { *(u32x2*)(p + 4 * z) = (u32x2){0u, 0u}; *(u32x2*)(p + 192 + 4 * z) = (u32x2){0u, 0u}; }
                    bf16_t* p2 = X1 + ((size_t)(beta * 512 + c + 1) * 2) * 192;
                    *(u32x2*)p2 = (u32x2){wre[2], wre[3]}; *(u32x2*)(p2 + 192) = (u32x2){wim[2], wim[3]};
                }
            }
        }
    }
};

struct EpiG3 {
    static constexpr bool PERM = true, AFTER_DRAIN = false, MIDSCALE = false;
    bf16_t* MX; float* ssF;
    __device__ __forceinline__ void operator()(const f32x4 (&acc)[2][2][4][2], const Unit& u, int wr, int wc, int fr, int fq) const {
        asm volatile("" : "+v"(fr), "+v"(fq), "+s"(wr), "+s"(wc));
        const int beta = u.pn >> 1, cb = (u.pn & 1) * BM + wc * 32 + 8 * fq;
#pragma unroll
        for (int ai = 0; ai < 2; ++ai)
#pragma unroll
            for (int m = 0; m < 4; ++m) {
                const int alpha = ai * HALF + wr * 64 + m * 16 + fr;
                const int s = 100 * alpha + beta - 16;
                const bool ok = alpha < 164 && s >= 0;
                float ps = 0.f;
#pragma unroll
                for (int bj = 0; bj < 2; ++bj) {
                    const f32x4 x0 = acc[ai][bj][m][0], x1 = acc[ai][bj][m][1];
                    ps += ((x0[0] * x0[0] + x0[1] * x0[1]) + (x0[2] * x0[2] + x0[3] * x0[3])) + ((x1[0] * x1[0] + x1[1] * x1[1]) + (x1[2] * x1[2] + x1[3] * x1[3]));
                    if (ok) { u32x4 w; w.x = cvt_pk_bf16(x0[0], x0[1]); w.y = cvt_pk_bf16(x0[2], x0[3]); w.z = cvt_pk_bf16(x1[0], x1[1]); w.w = cvt_pk_bf16(x1[2], x1[3]);
                        *(u32x4*)(MX + (size_t)s * 1024 + 512 + cb + bj * HALF) = w; }
                }
                ps += __shfl_xor(ps, 16); ps += __shfl_xor(ps, 32);
                if (ok && fq == 0) atomicAdd(ssF + beta * 164 + alpha, ps);
            }
    }
};

struct EpiResMix {
    static constexpr bool PERM = true, AFTER_DRAIN = true, MIDSCALE = true;
    const bf16_t* residh; bf16_t* ob; float* ss; const float* ssA; const float* ssF;
    __device__ __forceinline__ void mid(f32x4 (&acc)[2][2][4][2], const Unit& u, int wr, int wc, int fr, int fq) const {
        asm volatile("" : "+v"(fr), "+s"(wr));
        const int s0 = u.pm * BM + wr * 64 + fr;
        float va[8], vf[8];
#pragma unroll
        for (int q = 0; q < 8; ++q) { const int s_ = s0 + (q >> 2) * HALF + (q & 3) * 16, al_ = (s_ + 16) / 100; va[q] = ssA[s_]; vf[q] = ssF[(s_ + 16 - 100 * al_) * 164 + al_]; }
#pragma unroll
        for (int q = 0; q < 8; ++q) {
            const float ratio = rstd_of(va[q], 1.0f / 512.0f) * __builtin_amdgcn_rcpf(rstd_of(vf[q], 1.0f / 512.0f));
#pragma unroll
            for (int bj = 0; bj < 2; ++bj)
#pragma unroll
                for (int n = 0; n < 2; ++n) acc[q >> 2][bj][q & 3][n] = acc[q >> 2][bj][q & 3][n] * ratio;
        }
    }
    __device__ __forceinline__ void fused(f32x4 (&acc)[2][2][4][2], const Unit& u, int wr, int wc, int fr, int fq, PG8_LAS unsigned char* lds, int wid, int lane) const {
        PG8_LAS float* Pl = (PG8_LAS float*)lds;
        asm volatile("" : "+v"(fr), "+v"(fq), "+s"(wr), "+s"(wc));
        const int col0 = u.pn * BM + wc * 32 + 8 * fq, s0 = u.pm * BM + wr * 64 + fr;
        float vf[8];
#pragma unroll
        for (int q = 0; q < 8; ++q) { const int s_ = s0 + (q >> 2) * HALF + (q & 3) * 16, al_ = (s_ + 16) / 100; vf[q] = ssF[(s_ + 16 - 100 * al_) * 164 + al_]; }
        u32x4 rh[3][2];
        EPI_LOADH(0); EPI_LOADH(1);
#pragma unroll
        for (int q = 0; q < 8; ++q) {
            const int ai = q >> 2, m = q & 3;
            if (q + 2 < 8) EPI_LOADH(q + 2);
            const int s = s0 + ai * HALF + m * 16;
            const float rf = rstd_of(vf[q], 1.0f / 512.0f);
            float ps = 0.f;
#pragma unroll
            for (int bj = 0; bj < 2; ++bj) {
                const size_t off = (size_t)s * 1024 + col0 + bj * HALF;
                const f32x4 o0 = EPI_UNLO(rh[q % 3][bj]) + acc[ai][bj][m][0] * rf, o1 = EPI_UNHI(rh[q % 3][bj]) + acc[ai][bj][m][1] * rf;
                ps += ((o0[0] * o0[0] + o0[1] * o0[1]) + (o0[2] * o0[2] + o0[3] * o0[3])) + ((o1[0] * o1[0] + o1[1] * o1[1]) + (o1[2] * o1[2] + o1[3] * o1[3]));
                u32x4 w; w.x = cvt_pk_bf16(o0[0], o0[1]); w.y = cvt_pk_bf16(o0[2], o0[3]); w.z = cvt_pk_bf16(o1[0], o1[1]); w.w = cvt_pk_bf16(o1[2], o1[3]);
                *(u32x4*)(ob + off) = w;
            }
            ps += __shfl_xor(ps, 16); ps += __shfl_xor(ps, 32); if (fq == 0) Pl[(ai * HALF + wr * 64 + m * 16 + fr) * 4 + wc] = ps;
        }
        asm volatile("s_waitcnt lgkmcnt(0)" ::: "memory"); __syncthreads();
        if (threadIdx.x < 256) { const int row = threadIdx.x; atomicAdd(ss + u.pm * BM + row, (Pl[row * 4 + 0] + Pl[row * 4 + 1]) + (Pl[row * 4 + 2] + Pl[row * 4 + 3])); }
    }
};


struct EpiResFinal {
    static constexpr bool PERM = true, AFTER_DRAIN = true, MIDSCALE = false;
    const bf16_t* residh; float* out; float* ss; unsigned* cnt; const float* gain; float alpha;
    __device__ __forceinline__ void fused(f32x4 (&acc)[2][2][4][2], const Unit& u, int wr, int wc, int fr, int fq, PG8_LAS unsigned char* lds, int wid, int lane) const {
        const int col0 = u.pn * BM + wc * 32 + 8 * fq, s0 = u.pm * BM + wr * 64 + fr;
        PG8_LAS float* Pl = (PG8_LAS float*)lds; PG8_LAS float* Tl = (PG8_LAS float*)(lds + 4096);
        u32x4 rh[3][2];
        EPI_LOADH(0); EPI_LOADH(1);
#pragma unroll
        for (int q = 0; q < 8; ++q) {
            const int ai = q >> 2, m = q & 3;
            if (q + 2 < 8) EPI_LOADH(q + 2);
            float ps = 0.f;
#pragma unroll
            for (int bj = 0; bj < 2; ++bj) {
                const f32x4 o0 = EPI_UNLO(rh[q % 3][bj]) + acc[ai][bj][m][0] * alpha, o1 = EPI_UNHI(rh[q % 3][bj]) + acc[ai][bj][m][1] * alpha;
                acc[ai][bj][m][0] = o0; acc[ai][bj][m][1] = o1;
                ps += ((o0[0] * o0[0] + o0[1] * o0[1]) + (o0[2] * o0[2] + o0[3] * o0[3])) + ((o1[0] * o1[0] + o1[1] * o1[1]) + (o1[2] * o1[2] + o1[3] * o1[3]));
            }
            ps += __shfl_xor(ps, 16); ps += __shfl_xor(ps, 32);
            if (fq == 0) Pl[(ai * HALF + wr * 64 + m * 16 + fr) * 4 + wc] = ps;
        }
        asm volatile("s_waitcnt lgkmcnt(0)" ::: "memory"); __syncthreads();
        if (threadIdx.x < 256) {
            const int row = threadIdx.x;
            const float part = (Pl[row * 4 + 0] + Pl[row * 4 + 1]) + (Pl[row * 4 + 2] + Pl[row * 4 + 3]);
            unsigned* sl = (unsigned*)ss + ((size_t)u.pm * 4) * 256 + row;
            __hip_atomic_store(sl + u.pn * 256, __builtin_bit_cast(unsigned, part) | 1u, __ATOMIC_RELAXED, __HIP_MEMORY_SCOPE_AGENT);
            float pv[4];
#pragma unroll
            for (int p2 = 0; p2 < 4; ++p2) { unsigned v = __builtin_bit_cast(unsigned, part) | 1u, spins = 0u;
                if (p2 != u.pn) { while ((v = __hip_atomic_load(sl + p2 * 256, __ATOMIC_RELAXED, __HIP_MEMORY_SCOPE_AGENT)) == 0u && ++spins < (1u << 20)) __builtin_amdgcn_s_sleep(1); }
                pv[p2] = __builtin_bit_cast(float, v); }
            const float tot = (pv[0] + pv[1]) + (pv[2] + pv[3]);
            Tl[row] = rstd_of(tot, 1.0f / 1024.0f);
        }
        asm volatile("s_waitcnt vmcnt(0) lgkmcnt(0)" ::: "memory"); __syncthreads();
        f32x4 gv[2][2];
#pragma unroll
        for (int bj = 0; bj < 2; ++bj)
#pragma unroll
            for (int n = 0; n < 2; ++n) gv[bj][n] = *(const f32x4*)(gain + col0 + bj * HALF + 4 * n);
#pragma unroll
        for (int q = 0; q < 8; ++q) {
            const int ai = q >> 2, m = q & 3; const int s = s0 + ai * HALF + m * 16;
            const float rs = Tl[ai * HALF + wr * 64 + m * 16 + fr];
#pragma unroll
            for (int bj = 0; bj < 2; ++bj)
#pragma unroll
                for (int n = 0; n < 2; ++n) *(f32x4*)(out + (size_t)s * 1024 + col0 + bj * HALF + 4 * n) = acc[ai][bj][m][n] * rs * gv[bj][n];
        }
    }
};
#undef EPI_LOADH
#undef EPI_UNLO
#undef EPI_UNHI
}

constexpr int NWAVES = 8;
constexpr int DM = 1024, LTOK = 16400, LP = 16640, SEQ = 16384, NMETA = 16, FF = 2816;
constexpr size_t MiB = 1u << 20;
constexpr size_t WS_CTL = 0, CTL_BYTES = MiB;
constexpr size_t CT_SS1 = 0, CT_SS2 = 128 * 1024, CT_MACC = 256 * 1024, CT_MCNT = 384 * 1024, CT_BAR = 512 * 1024, CT_TIX = 640 * 1024, CT_SSA = 768 * 1024, CT_SSF = 832 * 1024, CT_PCNT = 900 * 1024, CT_SS3 = 920 * 1024;
constexpr int MISC_OFF = 147456 - 256;
constexpr size_t WS_SS0 = 1 * MiB, WS_A1 = 1 * MiB + 128 * 1024, WS_A3 = 1 * MiB + 256 * 1024, WS_SLOT = 1 * MiB + 512 * 1024;
constexpr size_t WS_WGU1 = 2 * MiB, WS_WD1 = 13 * MiB, WS_WQKV = 19 * MiB, WS_WG = 21 * MiB, WS_WOUT = 23 * MiB, WS_WGU2 = 25 * MiB, WS_WD2 = 36 * MiB;
constexpr size_t WS_HID = 48 * MiB, WS_X = 48 * MiB, WS_X1 = 92 * MiB;
constexpr size_t WS_XB = 144 * MiB;
constexpr size_t WS_Q = 178 * MiB, WS_K = 195 * MiB, WS_VT = 200 * MiB;
constexpr size_t WS_Y = 178 * MiB, WS_H2B = 178 * MiB;
constexpr size_t WS_PERM = 212 * MiB, WS_O = 212 * MiB;
constexpr size_t WS_END = 246 * MiB;
constexpr int LDS_BYTES = 147456;

#define LAS __attribute__((address_space(3)))
typedef unsigned short bf16;
typedef unsigned v4u __attribute__((ext_vector_type(4)));
typedef unsigned v2u __attribute__((ext_vector_type(2)));
typedef float f32x4 __attribute__((ext_vector_type(4)));
typedef short bf16x8 __attribute__((ext_vector_type(8)));
#define LDS_WAIT() asm volatile("s_waitcnt lgkmcnt(0)" ::: "memory")
__device__ __forceinline__ unsigned f2bf(float f) { unsigned u = __builtin_bit_cast(unsigned, f); return (u + 0x7fffu + ((u >> 16) & 1u)) >> 16; }
__device__ __forceinline__ unsigned pk2(float lo, float hi) { return f2bf(lo) | (f2bf(hi) << 16); }
__device__ __forceinline__ float bf2f(unsigned h) { return __builtin_bit_cast(float, h << 16); }
__device__ __forceinline__ float wave_sum(float v) {
#pragma unroll
    for (int o = 1; o < 64; o <<= 1) v += __shfl_xor(v, o);
    return v;
}
__device__ __forceinline__ float wave_max(float v) {
#pragma unroll
    for (int o = 1; o < 64; o <<= 1) v = fmaxf(v, __shfl_xor(v, o));
    return v;
}

struct Args { const float* in[19]; float* out; unsigned char* ws; };

#define XB_TMO      128
#define XB_XCNT(j)  (256  + 64 * (j))
#define XB_XSUB(j)  (1280 + 64 * (j))
#define XB_XGEN(j)  (2304 + 64 * (j))
#define XB_TOP      3328
#define XB_TOPGEN   3392
#define XCD_BAR_WORDS 3456
#define XB_SPIN_CAP (1u << 18)

__device__ __forceinline__ unsigned xb_ld(unsigned* p)              { return __hip_atomic_load(p, __ATOMIC_RELAXED, __HIP_MEMORY_SCOPE_AGENT); }
__device__ __forceinline__ unsigned xb_add(unsigned* p, unsigned v) { return __hip_atomic_fetch_add(p, v, __ATOMIC_RELAXED, __HIP_MEMORY_SCOPE_AGENT); }
__device__ __forceinline__ unsigned xb_xcc_id() { return (unsigned)__builtin_amdgcn_s_getreg((3 << 11) | 20) & 0xFu; }
#define XB_SPIN(cond, bar) do { unsigned _sp = 0; while (cond) { __builtin_amdgcn_s_sleep(1); \
    if ((++_sp & 255u) == 0u) { if (xb_ld(&(bar)[XB_TMO])) break; if (_sp > XB_SPIN_CAP) { atomicAdd(&(bar)[XB_TMO], 1u); break; } } } } while (0)

struct XcdBarrier {
    unsigned* bar; unsigned x;
    volatile LAS unsigned* st;
};

__device__ __forceinline__ XcdBarrier xcd_barrier_post(unsigned* bar, volatile LAS unsigned* st) {
    XcdBarrier b; b.bar = bar; b.x = xb_xcc_id(); b.st = st;
    if (threadIdx.x == 0) (void)xb_add(&bar[XB_XCNT(b.x)], 1u);
    return b;
}
__device__ __forceinline__ void xcd_barrier_complete(unsigned* bar, unsigned x, unsigned& nloc, unsigned& nx) {
    const unsigned G = gridDim.x * gridDim.y * gridDim.z;
    unsigned sum, cnt, mine, sp = 0u;
    for (;;) {
        sum = 0u; cnt = 0u; mine = 0u;
#pragma unroll
        for (unsigned j = 0; j < 16; ++j) { const unsigned c = xb_ld(&bar[XB_XCNT(j)]); sum += c; cnt += (c > 0u) ? 1u : 0u; mine = (j == x) ? c : mine; }
        if (sum == G) break;
        __builtin_amdgcn_s_sleep(1);
        if ((++sp & 255u) == 0u) { if (xb_ld(&bar[XB_TMO])) break; if (sp > XB_SPIN_CAP) { atomicAdd(&bar[XB_TMO], 1u); break; } }
    }
    nloc = mine > 0u ? mine : 1u; nx = cnt > 0u ? cnt : 1u;
}

__device__ __forceinline__ void xcd_barrier(const XcdBarrier& b) {
    asm volatile("s_waitcnt vmcnt(0)" ::: "memory");
    __syncthreads();
    if (threadIdx.x == 0) {
        unsigned* bar = b.bar;
        __builtin_amdgcn_s_waitcnt(0);
        unsigned nloc = b.st[0], nx = b.st[1];
        if (nloc == 0u) { xcd_barrier_complete(bar, b.x, nloc, nx); b.st[0] = nloc; b.st[1] = nx; }
        const unsigned old = xb_add(&bar[XB_XSUB(b.x)], 1u);
        const unsigned gen = old / nloc;
        if (old + 1u == (gen + 1u) * nloc) {
            __builtin_amdgcn_fence(__ATOMIC_RELEASE, "agent");
            asm volatile("s_waitcnt vmcnt(0)" ::: "memory");
            const unsigned og = xb_add(&bar[XB_TOP], 1u);
            const unsigned tg = og / nx;
            if (og + 1u == (tg + 1u) * nx) xb_add(&bar[XB_TOPGEN], 1u);
            else XB_SPIN(xb_ld(&bar[XB_TOPGEN]) == tg, bar);
            __builtin_amdgcn_fence(__ATOMIC_ACQUIRE, "agent");
            xb_add(&bar[XB_XGEN(b.x)], 1u);
            asm volatile("s_waitcnt vmcnt(0)" ::: "memory");
        } else {
            XB_SPIN(xb_ld(&bar[XB_XGEN(b.x)]) == gen, bar);
            __builtin_amdgcn_fence(__ATOMIC_ACQUIRE, "agent");
            asm volatile("s_waitcnt vmcnt(0)" ::: "memory");
        }
    }
    __syncthreads();
}


__device__ __forceinline__ int dest_row(int mode, int n, int bj) {
    if (mode == 1) return 256 * (n >> 7) + 128 * bj + (n & 127);
    if (mode == 2) { const int hs = n >> 6, dd = n & 63; return 256 * (hs >> 2) + 128 * (dd >> 5) + 32 * (hs & 3) + (dd & 31); }
    return n;
}
#define TR_VARS(P) const float* P##W = nullptr; const float* P##gain = nullptr; bf16* P##WT = nullptr; int P##ldw = 0, P##K = 0, P##mode = 0, P##bj = 0, P##k0 = 0, P##n0 = 0
#define TR_SET(P, w_, g_, wt_, ldw_, K_, mode_, bj_, kb_, nb_) do { P##W = (w_); P##gain = (g_); P##WT = (bf16*)(wt_); P##ldw = (ldw_); P##K = (K_); P##mode = (mode_); P##bj = (bj_); P##k0 = 64 * (kb_); P##n0 = 64 * (nb_); } while (0)
#define TR_DECODE(P, it_) do { constexpr int I_GU = 16 * 44, I_DN = 44 * 16, I_QKV = 16 * 12; int r = (it_); \
    if (r < I_GU) { TR_SET(P, a.in[3], a.in[2], ws + WS_WGU1, FF, DM, 1, 0, r / 44, r % 44); break; } r -= I_GU; \
    if (r < I_GU) { TR_SET(P, a.in[4], a.in[2], ws + WS_WGU1, FF, DM, 1, 1, r / 44, r % 44); break; } r -= I_GU; \
    if (r < I_QKV) { TR_SET(P, a.in[7], a.in[6], ws + WS_WQKV, 1280, DM, 2, 0, r / 12, r % 12); break; } r -= I_QKV; \
    if (r < I_DN) { TR_SET(P, a.in[5], (const float*)nullptr, ws + WS_WD1, DM, FF, 0, 0, r / 16, r % 16); break; } r -= I_DN; \
    if (r < I_GU) { TR_SET(P, a.in[15], a.in[14], ws + WS_WGU2, FF, DM, 1, 0, r / 44, r % 44); break; } r -= I_GU; \
    if (r < I_GU) { TR_SET(P, a.in[16], a.in[14], ws + WS_WGU2, FF, DM, 1, 1, r / 44, r % 44); break; } r -= I_GU; \
    if (r < I_DN) { TR_SET(P, a.in[17], (const float*)nullptr, ws + WS_WD2, DM, FF, 0, 0, r / 16, r % 16); break; } r -= I_DN; \
    TR_SET(P, a.in[13], (r / 16) < 8 ? a.in[11] : a.in[12] - 512, ws + WS_WOUT, DM, DM, 0, 0, r / 16, r % 16); } while (0)
#define TR_LOAD(P, v) do { _Pragma("unroll") for (int i = 0; i < 16; ++i) { const int kk = 4 * i + (lane >> 4); \
        f32x4 x = __builtin_nontemporal_load((const f32x4*)(P##W + (size_t)(P##k0 + kk) * P##ldw + P##n0 + 4 * (lane & 15))); if (P##gain) x = x * P##gain[P##k0 + kk]; v[i] = x; } } while (0)
#define TR_FINISH(P, v) do { _Pragma("unroll") for (int i = 0; i < 16; ++i) { LAS float* w_ = scr + (4 * i + (lane >> 4)) * 65 + 4 * (lane & 15); w_[0] = v[i].x; w_[1] = v[i].y; w_[2] = v[i].z; w_[3] = v[i].w; } \
    LDS_WAIT(); asm volatile("" ::: "memory"); \
    _Pragma("unroll") for (int j = 0; j < 8; ++j) { const int n = (lane >> 3) + 8 * j; const LAS float* s_ = scr + (8 * (lane & 7)) * 65 + n; \
        v4u o; o.x = pk2(s_[0 * 65], s_[1 * 65]); o.y = pk2(s_[2 * 65], s_[3 * 65]); o.z = pk2(s_[4 * 65], s_[5 * 65]); o.w = pk2(s_[6 * 65], s_[7 * 65]); \
        *(v4u*)(P##WT + (size_t)dest_row(P##mode, P##n0 + n, P##bj) * P##K + P##k0 + 8 * (lane & 7)) = o; } \
    LDS_WAIT(); asm volatile("" ::: "memory"); } while (0)
__device__ __forceinline__ void wg_item(const float* Win, const float* gmix, bf16* WG, int g, int dq, int lane) {
    float re[4], im[4], gm[4];
#pragma unroll
    for (int dd = 0; dd < 4; ++dd) { re[dd] = 0.f; im[dd] = 0.f; gm[dd] = gmix[4 * dq + dd] * 0.125f; }
    const float* wrow = Win + (size_t)(4 * dq) * 1280 + 768 + 64 * g;
#pragma unroll 16
    for (int j = 0; j < 64; ++j) {
        const float ph = (float)((j * lane) & 63) * (1.0f / 64.0f);
        const float c = __builtin_amdgcn_cosf(ph), sn = __builtin_amdgcn_sinf(ph);
#pragma unroll
        for (int dd = 0; dd < 4; ++dd) { const float w = wrow[dd * 1280 + j]; re[dd] += w * c; im[dd] -= w * sn; }
    }
    *(v2u*)(WG + (size_t)(64 * g + lane) * 1024 + 4 * dq) = (v2u){pk2(re[0] * gm[0], re[1] * gm[1]), pk2(re[2] * gm[2], re[3] * gm[3])};
    *(v2u*)(WG + (size_t)(512 + 64 * g + lane) * 1024 + 4 * dq) = (v2u){pk2(im[0] * gm[0], im[1] * gm[1]), pk2(im[2] * gm[2], im[3] * gm[3])};
}

#define TR_RUN(it0_, stride_, itend_) do { f32x4 vA[16], vB[16]; TR_VARS(A_); TR_VARS(B_); \
        int it = (it0_); \
        if (it < (itend_)) { TR_DECODE(A_, it); TR_LOAD(A_, vA); } \
        while (it < (itend_)) { \
            const int it2 = it + (stride_); \
            if (it2 < (itend_)) { TR_DECODE(B_, it2); TR_LOAD(B_, vB); } \
            TR_FINISH(A_, vA); \
            if (it2 >= (itend_)) break; \
            const int it3 = it2 + (stride_); \
            if (it3 < (itend_)) { TR_DECODE(A_, it3); TR_LOAD(A_, vA); } \
            TR_FINISH(B_, vB); \
            it = it3; } } while (0)
__device__ __forceinline__ void late_weights(const Args& a, LAS unsigned char* lds, int first, int last, int widx, int nw, int lane, int wave) {
    unsigned char* ws = a.ws;
    LAS float* scr = (LAS float*)(lds + wave * 17408);
    TR_RUN(first + widx, nw, last);
}
constexpr int TR_N0 = 2 * (16 * 44), TR_N1 = TR_N0 + 16 * 12 + 44 * 16, TR_N = TR_N1 + 2 * (16 * 44) + 44 * 16 + 16 * 16;
__device__ __forceinline__ void p0_prologue(const Args& a, LAS unsigned char* lds, int tid, int lane, int wave) {
    unsigned char* ws = a.ws;
    LAS float* scr = (LAS float*)(lds + wave * 17408);
    const int gw = blockIdx.x * NWAVES + wave, NGW = gridDim.x * NWAVES;
    TR_RUN(gw, NGW, TR_N0);
    for (int it = gw; it < 2048; it += NGW) wg_item(a.in[7], a.in[6], (bf16*)(ws + WS_WG), it >> 8, it & 255, lane);
    {
        bf16* A1 = (bf16*)(ws + WS_A1); bf16* A3 = (bf16*)(ws + WS_A3);
        const int gt = gw * 64 + lane, NGT = NGW * 64;
        for (int e = gt; e < 256 * 256 + 256 * 384; e += NGT) {
            if (e < 65536) {
                const int rr = e >> 8, kk = e & 255, ai = rr >> 7, beta = rr & 127, part = kk >> 7, b = kk & 127; float v = 0.f;
                if (beta < 100 && b < 100) { const float ph = (float)((beta * b) % 100) * 0.01f; const float c = __builtin_amdgcn_cosf(ph) * 0.1f, s = __builtin_amdgcn_sinf(ph) * 0.1f;
                    v = ai == 0 ? (part == 0 ? c : s) : (part == 0 ? -s : c); }
                A1[e] = (bf16)f2bf(v);
            } else {
                const int e3 = e - 65536, al = e3 / 384, kk = e3 - al * 384, part = kk >= 192 ? 1 : 0, aa = kk - 192 * part; float v = 0.f;
                if (al < 164 && aa < 164) { const float ph = (float)((al * aa) % 164) * (1.0f / 164.0f); const float sc = 0.07808688094430304f;
                    v = (part == 0 ? __builtin_amdgcn_cosf(ph) : __builtin_amdgcn_sinf(ph)) * sc; }
                A3[e3] = (bf16)f2bf(v);
            }
        }
        v4u* pz = (v4u*)((bf16*)(ws + WS_PERM) + (size_t)LTOK * DM);
        for (int e = gt; e < (LP - LTOK) * DM / 8; e += NGT) pz[e] = (v4u){0u, 0u, 0u, 0u};
        v4u* ps_ = (v4u*)(ws + WS_SLOT);
        for (int e = gt; e < 256 * 1024 / 16; e += NGT) ps_[e] = (v4u){0u, 0u, 0u, 0u};
    }
    {
        bf16* xb = (bf16*)(ws + WS_XB); float* ss0 = (float*)(ws + WS_SS0);
#define XB_LOAD(V, T0) do { _Pragma("unroll") for (int r = 0; r < 4; ++r) { const int t = (T0) + r; \
            const float* src = t < NMETA ? a.in[1] + (size_t)t * DM : a.in[0] + (size_t)(t - NMETA) * DM; \
            _Pragma("unroll") for (int j = 0; j < 4; ++j) V[r][j] = t < LTOK ? __builtin_nontemporal_load((const f32x4*)src + lane + 64 * j) : (f32x4){0.f, 0.f, 0.f, 0.f}; } } while (0)
#define XB_FINISH(V, T0) do { float q[4]; \
            _Pragma("unroll") for (int r = 0; r < 4; ++r) { float s_ = 0.f; \
                _Pragma("unroll") for (int j = 0; j < 4; ++j) s_ += (V[r][j].x * V[r][j].x + V[r][j].y * V[r][j].y) + (V[r][j].z * V[r][j].z + V[r][j].w * V[r][j].w); q[r] = s_; } \
            _Pragma("unroll") for (int o = 1; o < 64; o <<= 1) { _Pragma("unroll") for (int r = 0; r < 4; ++r) q[r] += __shfl_xor(q[r], o); } \
            _Pragma("unroll") for (int r = 0; r < 4; ++r) { const int t = (T0) + r; if (lane == 0) ss0[t] = q[r]; \
                v2u* o8 = (v2u*)(xb + (size_t)t * DM) + lane; \
                _Pragma("unroll") for (int j = 0; j < 4; ++j) o8[64 * j] = (v2u){pk2(V[r][j].x, V[r][j].y), pk2(V[r][j].z, V[r][j].w)}; } } while (0)
        f32x4 va[4][4], vb4[4][4];
        int t0 = 4 * gw;
        if (t0 < LP) XB_LOAD(va, t0);
        while (t0 < LP) {
            const int t1 = t0 + 4 * NGW;
            if (t1 < LP) XB_LOAD(vb4, t1);
            XB_FINISH(va, t0);
            if (t1 >= LP) break;
            const int t2 = t1 + 4 * NGW;
            if (t2 < LP) XB_LOAD(va, t2);
            XB_FINISH(vb4, t1);
            t0 = t2;
        }
#undef XB_LOAD
#undef XB_FINISH
    }
}

__device__ __forceinline__ void meta_down(const Args& a, LAS unsigned char* lds, int tid, int lane, int wave) {
    unsigned char* ws = a.ws;
    const int cgp = blockIdx.x & 15, kq = (blockIdx.x >> 4) & 15, n0 = 64 * cgp, kbase = 176 * kq;
    LAS float* hk = (LAS float*)lds; LAS float* red = (LAS float*)(lds + 16384); LAS unsigned* flag = (LAS unsigned*)(lds + 16384 + 32768);
    const bf16* HID = (const bf16*)(ws + WS_HID);
    float* macc = (float*)(ws + WS_CTL + CT_MACC); unsigned* mcnt = (unsigned*)(ws + WS_CTL + CT_MCNT); float* ss1 = (float*)(ws + WS_CTL + CT_SS1);
    if (tid < 16 * 22) { const int r = tid / 22, k8 = (tid - r * 22) * 8; const v4u w = *(const v4u*)(HID + (size_t)r * FF + kbase + k8);
        hk[(k8 + 0) * 16 + r] = bf2f(w.x & 0xffffu); hk[(k8 + 1) * 16 + r] = bf2f(w.x >> 16); hk[(k8 + 2) * 16 + r] = bf2f(w.y & 0xffffu); hk[(k8 + 3) * 16 + r] = bf2f(w.y >> 16);
        hk[(k8 + 4) * 16 + r] = bf2f(w.z & 0xffffu); hk[(k8 + 5) * 16 + r] = bf2f(w.z >> 16); hk[(k8 + 6) * 16 + r] = bf2f(w.w & 0xffffu); hk[(k8 + 7) * 16 + r] = bf2f(w.w >> 16); }
    const float* wp = a.in[5] + (size_t)(kbase + 22 * wave) * DM + n0 + lane;
    float wv[22];
#pragma unroll
    for (int k = 0; k < 22; ++k) wv[k] = wp[(size_t)k * DM];
    __syncthreads();
    float acc[16];
#pragma unroll
    for (int r = 0; r < 16; ++r) acc[r] = 0.f;
#pragma unroll
    for (int k = 0; k < 22; ++k) {
        const float w = wv[k]; const LAS f32x4* h = (const LAS f32x4*)(hk + (22 * wave + k) * 16);
        const f32x4 h0 = h[0], h1 = h[1], h2 = h[2], h3 = h[3];
        acc[0] += w * h0.x; acc[1] += w * h0.y; acc[2] += w * h0.z; acc[3] += w * h0.w; acc[4] += w * h1.x; acc[5] += w * h1.y; acc[6] += w * h1.z; acc[7] += w * h1.w;
        acc[8] += w * h2.x; acc[9] += w * h2.y; acc[10] += w * h2.z; acc[11] += w * h2.w; acc[12] += w * h3.x; acc[13] += w * h3.y; acc[14] += w * h3.z; acc[15] += w * h3.w;
        if ((k & 3) == 3) asm volatile("" ::: "memory");
    }
#pragma unroll
    for (int r = 0; r < 16; ++r) red[(wave * 16 + r) * 64 + lane] = acc[r];
    __syncthreads();
    for (int o = tid; o < 1024; o += NWAVES * 64) { const int r = o >> 6, n = o & 63; float s = 0.f;
#pragma unroll
        for (int w = 0; w < 8; ++w) s += red[(w * 16 + r) * 64 + n];
        atomicAdd(macc + r * DM + n0 + n, s); }
    asm volatile("s_waitcnt vmcnt(0)" ::: "memory"); __syncthreads();
    if (tid == 0) { const unsigned old = atomicAdd(mcnt + cgp, 1u); flag[0] = (old == 15u) ? 1u : 0u; }
    __syncthreads();
    if (flag[0]) {
        const int r = tid >> 5, nn = (tid & 31) * 2;
        const float v0 = __hip_atomic_load(macc + r * DM + n0 + nn, __ATOMIC_RELAXED, __HIP_MEMORY_SCOPE_AGENT), v1 = __hip_atomic_load(macc + r * DM + n0 + nn + 1, __ATOMIC_RELAXED, __HIP_MEMORY_SCOPE_AGENT);
        const float h0 = a.in[1][r * DM + n0 + nn] + 0.5f * v0, h1 = a.in[1][r * DM + n0 + nn + 1] + 0.5f * v1;
        const unsigned w = pk2(h0, h1);
        *(unsigned*)((bf16*)(ws + WS_XB) + (size_t)r * DM + n0 + nn) = w;
        *(unsigned*)((bf16*)(ws + WS_PERM) + (size_t)(100 * r) * DM + n0 + nn) = w;
        float ps = h0 * h0 + h1 * h1;
#pragma unroll
        for (int o = 1; o < 32; o <<= 1) ps += __shfl_xor(ps, o);
        if ((tid & 31) == 0) atomicAdd(ss1 + r, ps);
    }
    __syncthreads();
}

#define ATT_LOAD(KF, VF, si) do { const int kk0_ = (si) == 0 ? 0 : ks + 32 * ((si) - 1); \
    _Pragma("unroll") for (int T = 0; T < 2; ++T) { const int krow = kk0_ + 8 * (i >> 2) + 4 * T + (i & 3); \
        _Pragma("unroll") for (int hf = 0; hf < 2; ++hf) KF[T][hf] = *(const bf16x8*)(Kb + (size_t)krow * 128 + kvh * 64 + hf * 32 + 8 * g); } \
    _Pragma("unroll") for (int dt = 0; dt < 4; ++dt) VF[dt] = *(const bf16x8*)(Vt + (size_t)(kvh * 64 + dt * 16 + i) * LP + kk0_ + 8 * g); } while (0)
#define ATT_COMPUTE(KF, VF, si) do { const bool metastep = (si) == 0; const int kk0_ = metastep ? 0 : ks + 32 * ((si) - 1); \
    float fd[8]; bool vl[8]; \
    _Pragma("unroll") for (int e = 0; e < 8; ++e) { const int tk = kk0_ + 8 * g + e; int dist = tq - tk; dist = dist < 0 ? -dist : dist; \
        vl[e] = metastep ? (tk < NMETA) : (dist <= 128 && tk >= NMETA && tk < LTOK); fd[e] = (float)(dist > 128 ? 128 : dist); } \
    _Pragma("unroll") for (int h = 0; h < 4; ++h) { float p[8]; \
        _Pragma("unroll") for (int T = 0; T < 2; ++T) { f32x4 S = (f32x4){0.f, 0.f, 0.f, 0.f}; \
            S = __builtin_amdgcn_mfma_f32_16x16x32_bf16(KF[T][0], Qf[h][0], S, 0, 0, 0); \
            S = __builtin_amdgcn_mfma_f32_16x16x32_bf16(KF[T][1], Qf[h][1], S, 0, 0, 0); \
            _Pragma("unroll") for (int j = 0; j < 4; ++j) { const float ex = __builtin_amdgcn_exp2f(S[j] - slope[h] * fd[4 * T + j] - M0); p[4 * T + j] = vl[4 * T + j] ? ex : 0.f; } } \
        l[h] += ((p[0] + p[1]) + (p[2] + p[3])) + ((p[4] + p[5]) + (p[6] + p[7])); \
        v4u pw; pw.x = pg8::cvt_pk_bf16(p[0], p[1]); pw.y = pg8::cvt_pk_bf16(p[2], p[3]); pw.z = pg8::cvt_pk_bf16(p[4], p[5]); pw.w = pg8::cvt_pk_bf16(p[6], p[7]); \
        const bf16x8 P = __builtin_bit_cast(bf16x8, pw); \
        _Pragma("unroll") for (int dt = 0; dt < 4; ++dt) Oa[h][dt] = __builtin_amdgcn_mfma_f32_16x16x32_bf16(VF[dt], P, Oa[h][dt], 0, 0, 0); } } while (0)
__device__ __forceinline__ void attn_phase(const Args& a, int lane, int wave) {
    unsigned char* ws = a.ws;
    const bf16* Q = (const bf16*)(ws + WS_Q); const bf16* Kb = (const bf16*)(ws + WS_K); const bf16* Vt = (const bf16*)(ws + WS_VT); bf16* O = (bf16*)(ws + WS_PERM); float* ssA = (float*)(ws + WS_CTL + CT_SSA);
    const int i = lane & 15, g = lane >> 4;
    constexpr float L2E = 1.4426950408889634f;
    const float gq = wave_max(fabsf(a.in[8][lane])), gk = wave_max(fabsf(a.in[9][lane]));
    const float M0 = fminf(8.0f * gq * gk, 80.0f) * L2E;
    const int gw = blockIdx.x * NWAVES + wave, NGW = gridDim.x * NWAVES;
    for (int unit = gw; unit < 2048; unit += NGW) {
        const int qt = unit >> 1, kvh = unit & 1;
        const int tq0 = NMETA + 16 * qt, tq = tq0 + i;
        bf16x8 Qf[4][2];
#pragma unroll
        for (int h = 0; h < 4; ++h)
#pragma unroll
            for (int hf = 0; hf < 2; ++hf) Qf[h][hf] = *(const bf16x8*)(Q + (size_t)tq * 512 + (kvh * 4 + h) * 64 + hf * 32 + 8 * g);
        f32x4 Oa[4][4]; float l[4], slope[4];
#pragma unroll
        for (int h = 0; h < 4; ++h) { l[h] = 0.f; slope[h] = __builtin_amdgcn_exp2f(-(float)(kvh * 4 + h + 1)) * L2E;
#pragma unroll
            for (int dt = 0; dt < 4; ++dt) Oa[h][dt] = (f32x4){0.f, 0.f, 0.f, 0.f}; }
        const int ks = (tq0 - 128) < 0 ? 0 : ((tq0 - 128) & ~31), ke = (tq0 + 143) & ~31;
        const int nsteps = 2 + (ke - ks) / 32;
        bf16x8 KfA[2][2], VfA[4], KfB[2][2], VfB[4];
        ATT_LOAD(KfA, VfA, 0);
        for (int si = 0; si < nsteps; si += 2) {
            if (si + 1 < nsteps) ATT_LOAD(KfB, VfB, si + 1);
            ATT_COMPUTE(KfA, VfA, si);
            if (si + 1 < nsteps) {
                if (si + 2 < nsteps) ATT_LOAD(KfA, VfA, si + 2);
                ATT_COMPUTE(KfB, VfB, si + 1);
            }
        }
        float sq = 0.f;
#pragma unroll
        for (int h = 0; h < 4; ++h) {
            float lt = l[h]; lt += __shfl_xor(lt, 16); lt += __shfl_xor(lt, 32);
            lt += __builtin_amdgcn_exp2f(a.in[10][kvh * 4 + h] * L2E - M0);
            const float inv = 1.0f / lt;
#pragma unroll
            for (int dt = 0; dt < 4; ++dt) { const f32x4 o = Oa[h][dt] * inv;
                sq += (o[0] * o[0] + o[1] * o[1]) + (o[2] * o[2] + o[3] * o[3]);
                *(v2u*)(O + (size_t)(tq - NMETA) * DM + (kvh * 4 + h) * 64 + dt * 16 + 4 * g) = (v2u){pg8::cvt_pk_bf16(o[0], o[1]), pg8::cvt_pk_bf16(o[2], o[3])}; }
        }
        sq += __shfl_xor(sq, 16); sq += __shfl_xor(sq, 32);
        if (g == 0) atomicAdd(ssA + (tq - NMETA), sq);
    }
}

__device__ __forceinline__ void mixnorm_phase(const Args& a, int lane, int wave) {
    unsigned char* ws = a.ws;
    const bf16* O = (const bf16*)(ws + WS_O); const float* Y = (const float*)(ws + WS_Y); bf16* MX = (bf16*)(ws + WS_XB);
    const int gw = blockIdx.x * NWAVES + wave, NGW = gridDim.x * NWAVES;
    for (int s0 = 4 * gw; s0 < SEQ; s0 += 4 * NGW) {
        v4u ov[4]; f32x4 y0[4], y1[4]; float sa[4], sf[4];
#pragma unroll
        for (int r = 0; r < 4; ++r) { const int s = s0 + r; ov[r] = *(const v4u*)(O + (size_t)s * 512 + 8 * lane);
            y0[r] = *(const f32x4*)(Y + (size_t)(NMETA + s) * 512 + 8 * lane); y1[r] = *(const f32x4*)(Y + (size_t)(NMETA + s) * 512 + 8 * lane + 4); }
        float of[4][8];
#pragma unroll
        for (int r = 0; r < 4; ++r) {
            of[r][0] = bf2f(ov[r].x & 0xffffu); of[r][1] = bf2f(ov[r].x >> 16); of[r][2] = bf2f(ov[r].y & 0xffffu); of[r][3] = bf2f(ov[r].y >> 16);
            of[r][4] = bf2f(ov[r].z & 0xffffu); of[r][5] = bf2f(ov[r].z >> 16); of[r][6] = bf2f(ov[r].w & 0xffffu); of[r][7] = bf2f(ov[r].w >> 16);
            float t = 0.f;
#pragma unroll
            for (int j = 0; j < 8; ++j) t += of[r][j] * of[r][j];
            sa[r] = t;
            sf[r] = (y0[r].x * y0[r].x + y0[r].y * y0[r].y) + (y0[r].z * y0[r].z + y0[r].w * y0[r].w) + (y1[r].x * y1[r].x + y1[r].y * y1[r].y) + (y1[r].z * y1[r].z + y1[r].w * y1[r].w);
        }
#pragma unroll
        for (int o = 1; o < 64; o <<= 1) {
#pragma unroll
            for (int r = 0; r < 4; ++r) { sa[r] += __shfl_xor(sa[r], o); sf[r] += __shfl_xor(sf[r], o); } }
#pragma unroll
        for (int r = 0; r < 4; ++r) { const int s = s0 + r;
            const float ra = pg8::rstd_of(sa[r], 1.0f / 512.0f), rf = pg8::rstd_of(sf[r], 1.0f / 512.0f);
            *(v4u*)(MX + (size_t)s * DM + 8 * lane) = (v4u){pk2(of[r][0] * ra, of[r][1] * ra), pk2(of[r][2] * ra, of[r][3] * ra), pk2(of[r][4] * ra, of[r][5] * ra), pk2(of[r][6] * ra, of[r][7] * ra)};
            *(v4u*)(MX + (size_t)s * DM + 512 + 8 * lane) = (v4u){pk2(y0[r].x * rf, y0[r].y * rf), pk2(y0[r].z * rf, y0[r].w * rf), pk2(y1[r].x * rf, y1[r].y * rf), pk2(y1[r].z * rf, y1[r].w * rf)};
        }
    }
}
__device__ __forceinline__ void finalnorm_phase(const Args& a, float* dst, int lane, int wave) {
    const int gw = blockIdx.x * NWAVES + wave, NGW = gridDim.x * NWAVES;
    const f32x4* gp = (const f32x4*)a.in[18];
    f32x4 gv[4];
#pragma unroll
    for (int j = 0; j < 4; ++j) gv[j] = gp[lane + 64 * j];
    for (int s0 = 4 * gw; s0 < SEQ; s0 += 4 * NGW) {
        f32x4 v[4][4]; float q[4];
#pragma unroll
        for (int r = 0; r < 4; ++r) { const f32x4* row = (const f32x4*)(a.out + (size_t)(s0 + r) * DM);
#pragma unroll
            for (int j = 0; j < 4; ++j) v[r][j] = row[lane + 64 * j]; }
#pragma unroll
        for (int r = 0; r < 4; ++r) { float t = 0.f;
#pragma unroll
            for (int j = 0; j < 4; ++j) t += (v[r][j].x * v[r][j].x + v[r][j].y * v[r][j].y) + (v[r][j].z * v[r][j].z + v[r][j].w * v[r][j].w);
            q[r] = t; }
#pragma unroll
        for (int o = 1; o < 64; o <<= 1) {
#pragma unroll
            for (int r = 0; r < 4; ++r) q[r] += __shfl_xor(q[r], o); }
#pragma unroll
        for (int r = 0; r < 4; ++r) { const float rs = pg8::rstd_of(q[r], 1.0f / 1024.0f); f32x4* orow = (f32x4*)(dst + (size_t)(s0 + r) * DM);
#pragma unroll
            for (int j = 0; j < 4; ++j) orow[lane + 64 * j] = v[r][j] * rs * gv[j]; }
    }
}

#ifndef PROBE_DUP
#define PROBE_DUP 0
#endif
#ifndef PHASE_MASK
#define PHASE_MASK 0xFFFF
#endif
constexpr int PM = PHASE_MASK;
#ifndef PG8_SP2
#define PG8_SP2 true
#endif
#ifndef PG8_ALIGN
#define PG8_ALIGN true
#endif

__global__ void __launch_bounds__(NWAVES * 64, 2) mega_fwd(Args args) {
    extern __shared__ __attribute__((aligned(16))) unsigned char lds_raw[];
    cg::grid_group grid = cg::this_grid();
    LAS unsigned char* lds = (LAS unsigned char*)lds_raw;
    const int tid = threadIdx.x, lane = tid & 63, wave = __builtin_amdgcn_readfirstlane(tid >> 6);
    const int G = gridDim.x, bx = blockIdx.x;
    unsigned char* ws = args.ws;
    float* ss0 = (float*)(ws + WS_SS0); float* ss1 = (float*)(ws + WS_CTL + CT_SS1); float* ss2 = (float*)(ws + WS_CTL + CT_SS2);
    bf16* XB = (bf16*)(ws + WS_XB); bf16* HID = (bf16*)(ws + WS_HID);

    if (tid < 16) ((LAS unsigned*)(lds + MISC_OFF))[tid] = 0u;
    __syncthreads();
    XcdBarrier bar = xcd_barrier_post((unsigned*)(ws + WS_CTL + CT_BAR), (volatile LAS unsigned*)(lds + MISC_OFF));
    if (tid == 0) { const unsigned r = xb_add((unsigned*)(ws + WS_CTL + CT_TIX) + 64 * bar.x, 1u); ((volatile LAS unsigned*)(lds + MISC_OFF))[4] = r * 8u + bar.x; }
    if (args.out == nullptr) grid.sync();
#if PROBE_DUP & 1
    p0_prologue(args, lds, tid, lane, wave); xcd_barrier(bar);
#endif
    if (PM & 1) p0_prologue(args, lds, tid, lane, wave);
    xcd_barrier(bar);
    int vb = bx;
    { bool ok = (G == 256);
      for (int j = 0; j < 8; ++j) ok = ok && (xb_ld((unsigned*)(ws + WS_CTL + CT_BAR) + XB_XCNT(j)) == 32u);
      if (ok) vb = (int)((volatile LAS unsigned*)(lds + MISC_OFF))[4]; vb = __builtin_amdgcn_readfirstlane(vb); }
    if (PM & 2) {
        pg8::Gemm g{XB, (const bf16*)(ws + WS_WGU1), LP, 2 * FF, DM}; pg8::StaticOrder S; S.init(LP, 2 * FF, G, vb);
        pg8::EpiSwiglu E{HID, ss0, FF};
        pg8::gemm_phase<pg8::EpiSwiglu, pg8::StaticOrder, PG8_ALIGN, PG8_SP2>(lds, g, S, E);
        if (vb >= 150) late_weights(args, lds, TR_N0, TR_N1, (vb - 150) * NWAVES + wave, (256 - 150) * NWAVES, lane, wave);
    }
    xcd_barrier(bar);
    if (PM & 4) {
        meta_down(args, lds, tid, lane, wave);
        pg8::Gemm g{HID + (size_t)NMETA * FF, (const bf16*)(ws + WS_WD1), SEQ, DM, FF}; pg8::StaticOrder S; S.init(SEQ, DM, G, vb);
        pg8::EpiRes E{XB + (size_t)NMETA * DM, XB + (size_t)NMETA * DM, (bf16*)(ws + WS_PERM), ss1 + NMETA, 0.5f};
        pg8::gemm_phase<pg8::EpiRes, pg8::StaticOrder, false, PG8_SP2>(lds, g, S, E);
    }
    xcd_barrier(bar);
    if (PM & 8) {
        pg8::Gemm g{XB, (const bf16*)(ws + WS_WQKV), LP, 768, DM}; pg8::StaticOrder S; S.init(LP, 768, G, vb);
        pg8::EpiQKV E{(bf16*)(ws + WS_Q), (bf16*)(ws + WS_K), (bf16*)(ws + WS_VT), ss1, args.in[8], args.in[9], LP};
        pg8::gemm_phase<pg8::EpiQKV, pg8::StaticOrder, PG8_ALIGN, PG8_SP2>(lds, g, S, E);
        pg8::Gemm g0{(const bf16*)(ws + WS_WG), (const bf16*)(ws + WS_PERM), 1024, LP, DM}; pg8::StaticOrder S0; S0.init(1024, LP, G, (vb + 61) & 255);
        pg8::EpiG0 E0{(bf16*)(ws + WS_X), ss1};
        pg8::gemm_phase<pg8::EpiG0, pg8::StaticOrder, PG8_ALIGN, PG8_SP2>(lds, g0, S0, E0);
    }
    xcd_barrier(bar);
    if (PM & 16) {
        int kdim = 256; asm volatile("" : "+s"(kdim));
        pg8::Gemm g{(const bf16*)(ws + WS_A1), (const bf16*)(ws + WS_X), 256, 512 * 164, kdim}; pg8::StaticOrder S; S.init(256, 512 * 164, G, vb);
        pg8::EpiG1 E{(bf16*)(ws + WS_X1)};
        pg8::gemm_phase<pg8::EpiG1, pg8::StaticOrder, PG8_ALIGN, PG8_SP2>(lds, g, S, E);
        attn_phase(args, lane, wave);
        if (vb >= 72) late_weights(args, lds, TR_N1, TR_N1 + 1408, (vb - 72) * NWAVES + wave, (256 - 72) * NWAVES, lane, wave);
    }
    xcd_barrier(bar);
#if PROBE_DUP & 2
    attn_phase(args, lane, wave); xcd_barrier(bar);
#endif
    if (PM & 32) {
        int kdim = 384; asm volatile("" : "+s"(kdim));
        pg8::Gemm g{(const bf16*)(ws + WS_A3), (const bf16*)(ws + WS_X1), 256, 100 * 512, kdim}; pg8::StaticOrder S; S.init(256, 100 * 512, G, vb);
        pg8::EpiG3 E{(bf16*)(ws + WS_PERM), (float*)(ws + WS_CTL + CT_SSF)};
        pg8::gemm_phase<pg8::EpiG3, pg8::StaticOrder, PG8_ALIGN, PG8_SP2>(lds, g, S, E);
        if (vb >= 200) late_weights(args, lds, TR_N1 + 2112, TR_N, (vb - 200) * NWAVES + wave, (256 - 200) * NWAVES, lane, wave);
    }
    xcd_barrier(bar);
    if (PM & 128) {
        pg8::Gemm g{(const bf16*)(ws + WS_PERM), (const bf16*)(ws + WS_WOUT), SEQ, DM, DM}; pg8::StaticOrder S; S.init(SEQ, DM, G, vb);
        pg8::EpiResMix E{XB + (size_t)NMETA * DM, (bf16*)(ws + WS_H2B), ss2, (const float*)(ws + WS_CTL + CT_SSA), (const float*)(ws + WS_CTL + CT_SSF)};
        pg8::gemm_phase<pg8::EpiResMix, pg8::StaticOrder, false, PG8_SP2>(lds, g, S, E);
    }
    xcd_barrier(bar);
    if (PM & 256) {
        pg8::Gemm g{(const bf16*)(ws + WS_H2B), (const bf16*)(ws + WS_WGU2), SEQ, 2 * FF, DM}; pg8::StaticOrder S; S.init(SEQ, 2 * FF, G, vb);
        pg8::EpiSwiglu E{HID, ss2, FF};
        pg8::gemm_phase<pg8::EpiSwiglu, pg8::StaticOrder, PG8_ALIGN, PG8_SP2>(lds, g, S, E);
        if (vb >= 128) late_weights(args, lds, TR_N1 + 1408, TR_N1 + 2112, (vb - 128) * NWAVES + wave, 128 * NWAVES, lane, wave);
    }
    xcd_barrier(bar);
    if (PM & 512) {
        pg8::Gemm g{HID, (const bf16*)(ws + WS_WD2), SEQ, DM, FF}; pg8::StaticOrder S; S.init(SEQ, DM, G, vb);
        pg8::EpiResFinal E{(const bf16*)(ws + WS_H2B), args.out, (float*)(ws + WS_SLOT), (unsigned*)(ws + WS_CTL + CT_PCNT), args.in[18], 0.5f};
        pg8::gemm_phase<pg8::EpiResFinal, pg8::StaticOrder, false, PG8_SP2>(lds, g, S, E);
    }
}

extern "C" void kernel_launch(void* const* d_in, const int* in_sizes, int n_in, void* d_out, int out_size, void* d_ws, size_t ws_size, hipStream_t stream) {
    static int grid = 0;
    if (grid == 0) {
        if (n_in != 19 || out_size != SEQ * DM || ws_size < WS_END) { fprintf(stderr, "kernel_launch: unexpected shapes (n_in %d out %d ws %zu)\n", n_in, out_size, ws_size); grid = -1; return; }
        int dev = 0, cus = 0, per_cu = 0;
        hipGetDevice(&dev); hipDeviceGetAttribute(&cus, hipDeviceAttributeMultiprocessorCount, dev);
        hipFuncSetAttribute((const void*)mega_fwd, hipFuncAttributeMaxDynamicSharedMemorySize, LDS_BYTES);
        hipOccupancyMaxActiveBlocksPerMultiprocessor(&per_cu, (const void*)mega_fwd, NWAVES * 64, LDS_BYTES);
        (void)hipGetLastError();
        if (per_cu < 1) per_cu = 1;
        grid = cus;
        if (grid != 256) fprintf(stderr, "kernel_launch: %d CUs (expected 256)\n", cus);
    }
    if (grid < 0) return;
    hipMemsetAsync((char*)d_ws + WS_CTL, 0, CTL_BYTES, stream);
    Args a{};
    for (int i = 0; i < 19; ++i) a.in[i] = (const float*)d_in[i];
    a.out = (float*)d_out; a.ws = (unsigned char*)d_ws;
    void* kargs[] = {&a};
    hipError_t e = hipLaunchCooperativeKernel((const void*)mega_fwd, dim3(grid), dim3(NWAVES * 64), kargs, LDS_BYTES, stream);
    if (e != hipSuccess) fprintf(stderr, "cooperative launch failed: %s (grid %d)\n", hipGetErrorString(e), grid);
}
```

```cpp
#include <hip/hip_runtime.h>
#include <hip/hip_cooperative_groups.h>
#include <cstdio>
#include <cstdint>
namespace cg = cooperative_groups;
namespace pg8 {
#define PG8_LAS __attribute__((address_space(3)))
typedef unsigned short bf16_t;
typedef short bf16x8 __attribute__((ext_vector_type(8)));
typedef float f32x4 __attribute__((ext_vector_type(4)));
typedef unsigned u32x4 __attribute__((ext_vector_type(4)));
constexpr int BM = 256, BK = 64, HALF = 128, HTB = HALF * BK * 2  , STAGE_BYTES = 8 * HTB, NXCD = 8, WGM = 8;

__host__ __device__ __forceinline__ int lds_byte(int r, int c) { const int st = (r >> 4) * 2 + (c >> 5), rr = r & 15, cc = c & 31, ob = rr * 64 + cc * 2; return st * 1024 + (ob ^ (((ob >> 9) & 1) << 5)); }
__host__ __device__ __forceinline__ void stage_rc(int b, int& R, int& C) { const int st = b / 1024, sb = b % 1024, swz = sb ^ (((sb >> 9) & 1) << 5); R = (st >> 1) * 16 + swz / 64; C = (st & 1) * 32 + (swz % 64) / 2; }
__host__ __device__ __forceinline__ int perm32(int rho) { const int n = rho >> 4, i = rho & 15; return 8 * (i >> 2) + 4 * n + (i & 3); }

struct Unit { int pm, pn; };
struct Gemm { const bf16_t* A; const bf16_t* Bt; int M, N, K; };

struct StaticOrder {
    int nM, nN, nwg, G, c;
    __host__ __device__ void init(int M, int N, int G_, int c_) { nM = M / BM; nN = N / BM; nwg = nM * nN; G = G_; c = c_; }
    __host__ __device__ bool next(int i, Unit& u) const {
        const long L = (long)i * G + c; if (L >= nwg) return false;
        int wgid = (int)L; { const int q = nwg / NXCD, r = nwg % NXCD, xcd = wgid % NXCD, off = wgid / NXCD; wgid = (xcd < r ? xcd * (q + 1) : r * (q + 1) + (xcd - r) * q) + off; }
        const int nig = WGM * nN, gid = wgid / nig, fm = gid * WGM, gsz = (nM - fm) < WGM ? (nM - fm) : WGM;
        u.pm = fm + ((wgid % nig) % gsz); u.pn = (wgid % nig) / gsz; return true;
    }
    __device__ __forceinline__ void a_ready(const Unit&) const {}
    __device__ __forceinline__ void done(const Unit&) const {}
};
__device__ __forceinline__ unsigned cvt_pk_bf16(float lo, float hi) { unsigned r; asm volatile("v_cvt_pk_bf16_f32 %0, %1, %2" : "=v"(r) : "v"(lo), "v"(hi)); return r; }
typedef float f32x2 __attribute__((ext_vector_type(2)));
template <class Epi, class Sched, bool ALIGN_EPI = false, bool SP2 = false>
__device__ __forceinline__ void gemm_phase(PG8_LAS unsigned char* lds, const Gemm g, const Sched& S, const Epi& E) {
    int tid_ = threadIdx.x; asm volatile("" : "+v"(tid_));
    const int tid = tid_, wid = __builtin_amdgcn_readfirstlane(tid >> 6), lane = tid & 63, wr = wid >> 2, wc = wid & 3, fr = lane & 15, fq = lane >> 4;
    const int K = g.K, nt = K / BK;
    unsigned voffA[2], voffB[2];
#pragma unroll
    for (int i = 0; i < 2; ++i) { int R, C; stage_rc(tid * 16 + i * 8192, R, C); const int Rb = Epi::PERM ? ((R & ~31) + perm32(R & 31)) : R;
        voffA[i] = (unsigned)(R * K + C) * 2u; voffB[i] = (unsigned)(Rb * K + C) * 2u; }
    const size_t kstep = (size_t)(BK * 2);
    const size_t hstep = (size_t)HALF * K * 2;
    const size_t tstep = 2 * hstep;
    const unsigned ldsw = (unsigned)wid * 1024u;
    const int aoff = lds_byte(wr * 64 + fr, fq * 8), boff = lds_byte(wc * 32 + fr, fq * 8);
#define PG8_SA(b, h) (((b) * 2 + (h)) * HTB)
#define PG8_SB(b, h) ((4 + (b) * 2 + (h)) * HTB)
#define PG8_STAGE(bufoff, gbase, voff) do { _Pragma("unroll") for (int _i = 0; _i < 2; ++_i) \
        __builtin_amdgcn_global_load_lds((const unsigned*)((const char*)(gbase) + (voff)[_i]), (PG8_LAS unsigned*)(lds + (bufoff) + ldsw + _i * 8192), 16, 0, 0); } while (0)
#define PG8_LDA(dst, b, h) do { _Pragma("unroll") for (int m = 0; m < 4; ++m) _Pragma("unroll") for (int k = 0; k < 2; ++k) dst[m][k] = *(const PG8_LAS bf16x8*)(lds + PG8_SA(b, h) + aoff + m * 2048 + k * 1024); } while (0)
#define PG8_LDB(dst, b, h) do { _Pragma("unroll") for (int n = 0; n < 2; ++n) _Pragma("unroll") for (int k = 0; k < 2; ++k) dst[n][k] = *(const PG8_LAS bf16x8*)(lds + PG8_SB(b, h) + boff + n * 2048 + k * 1024); } while (0)
#define PG8_MMA(ai, bj, At, Bt) do { __builtin_amdgcn_s_setprio(1); _Pragma("unroll") for (int m = 0; m < 4; ++m) _Pragma("unroll") for (int n = 0; n < 2; ++n) _Pragma("unroll") for (int k = 0; k < 2; ++k) \
        acc[ai][bj][m][n] = __builtin_amdgcn_mfma_f32_16x16x32_bf16(Bt[n][k], At[m][k], acc[ai][bj][m][n], 0, 0, 0); __builtin_amdgcn_s_setprio(0); } while (0)
#define PG8_WAIT_V(n) asm volatile("s_waitcnt vmcnt(" #n ")" ::: "memory")
#define PG8_WAIT_L(n) asm volatile("s_waitcnt lgkmcnt(" #n ")" ::: "memory")
#define PG8_BAR __builtin_amdgcn_s_barrier()
#define PG8_SCHED __builtin_amdgcn_sched_barrier(0)
    Unit cur, nxt; int ui = 0;
    if (!S.next(0, cur)) return;
    f32x4 acc[2][2][4][2];
#pragma unroll
    for (int a = 0; a < 2; ++a)
#pragma unroll
        for (int b = 0; b < 2; ++b)
#pragma unroll
            for (int m = 0; m < 4; ++m)
#pragma unroll
                for (int n = 0; n < 2; ++n) acc[a][b][m][n] = (f32x4){0.f, 0.f, 0.f, 0.f};
    bf16x8 At[4][2], B0[2][2], B1[2][2];
    const char* cA = (const char*)g.A + (size_t)cur.pm * tstep; const char* cB = (const char*)g.Bt + (size_t)cur.pn * tstep;
    S.a_ready(cur);
    if constexpr (SP2) {
        PG8_STAGE(PG8_SB(0, 0), cB, voffB); PG8_STAGE(PG8_SB(0, 1), cB + hstep, voffB); PG8_STAGE(PG8_SA(0, 0), cA, voffA); PG8_STAGE(PG8_SA(0, 1), cA + hstep, voffA);
        if (wr == 1) PG8_BAR;
        PG8_WAIT_V(2); PG8_BAR;
        PG8_STAGE(PG8_SB(1, 0), cB + kstep, voffB); PG8_STAGE(PG8_SA(1, 0), cA + kstep, voffA); PG8_STAGE(PG8_SB(1, 1), cB + hstep + kstep, voffB);
        PG8_WAIT_V(6); PG8_BAR;
    } else {
        PG8_STAGE(PG8_SB(0, 0), cB, voffB); PG8_STAGE(PG8_SA(0, 0), cA, voffA); PG8_STAGE(PG8_SB(0, 1), cB + hstep, voffB); PG8_STAGE(PG8_SA(0, 1), cA + hstep, voffA);
        if (wr == 1) PG8_BAR;
        PG8_WAIT_V(4); PG8_BAR;
        PG8_STAGE(PG8_SB(1, 0), cB + kstep, voffB); PG8_STAGE(PG8_SA(1, 0), cA + kstep, voffA); PG8_STAGE(PG8_SB(1, 1), cB + hstep + kstep, voffB);
        PG8_WAIT_V(6); PG8_BAR;
    }
    for (;;) {
        const bool has_next = S.next(ui + 1, nxt);
        const char* nA = has_next ? (const char*)g.A + (size_t)nxt.pm * tstep : cA; const char* nB = has_next ? (const char*)g.Bt + (size_t)nxt.pn * tstep : cB;
        for (int t = 0; t < nt; t += 2) {
            const bool last = (t == nt - 2);
            const char* a1 = cA + (size_t)(t + 1) * kstep;
            const char* a2 = last ? nA : cA + (size_t)(t + 2) * kstep; const char* b2 = last ? nB : cB + (size_t)(t + 2) * kstep;
            const char* a3 = a2 + kstep; const char* b3 = b2 + kstep;
            if (last && has_next) S.a_ready(nxt);
            if constexpr (Epi::MIDSCALE) { if (t == (nt >> 1)) E.mid(acc, cur, wr, wc, fr, fq); }
            if constexpr (SP2) {
            PG8_LDB(B0, 0, 0); PG8_LDB(B1, 0, 1); PG8_SCHED; PG8_LDA(At, 0, 0); PG8_STAGE(PG8_SA(1, 1), a1 + hstep, voffA);
            PG8_WAIT_V(8); PG8_WAIT_L(0); PG8_BAR; PG8_MMA(0, 0, At, B0); PG8_MMA(0, 1, At, B1); PG8_BAR; PG8_SCHED;
            PG8_LDA(At, 0, 1); PG8_STAGE(PG8_SB(0, 0), b2, voffB); PG8_STAGE(PG8_SB(0, 1), b2 + hstep, voffB); PG8_STAGE(PG8_SA(0, 0), a2, voffA);
            PG8_WAIT_V(8); PG8_WAIT_L(0); PG8_BAR; PG8_MMA(1, 0, At, B0); PG8_MMA(1, 1, At, B1); PG8_BAR; PG8_SCHED;
            PG8_LDB(B0, 1, 0); PG8_LDB(B1, 1, 1); PG8_SCHED; PG8_LDA(At, 1, 0); PG8_STAGE(PG8_SA(0, 1), a2 + hstep, voffA);
            PG8_WAIT_V(8); PG8_WAIT_L(0); PG8_BAR; PG8_MMA(0, 0, At, B0); PG8_MMA(0, 1, At, B1); PG8_BAR; PG8_SCHED;
            PG8_LDA(At, 1, 1); PG8_STAGE(PG8_SB(1, 0), b3, voffB); PG8_STAGE(PG8_SB(1, 1), b3 + hstep, voffB); PG8_STAGE(PG8_SA(1, 0), a3, voffA);
            PG8_WAIT_V(8); PG8_WAIT_L(0); PG8_BAR; PG8_MMA(1, 0, At, B0); PG8_MMA(1, 1, At, B1); PG8_BAR; PG8_SCHED;
            } else {
            PG8_LDB(B0, 0, 0); PG8_SCHED; PG8_LDA(At, 0, 0); PG8_STAGE(PG8_SA(1, 1), a1 + hstep, voffA);
            PG8_WAIT_L(8); PG8_BAR; PG8_WAIT_L(0); PG8_MMA(0, 0, At, B0); PG8_BAR; PG8_SCHED;
            PG8_LDB(B1, 0, 1); PG8_STAGE(PG8_SB(0, 0), b2, voffB);
            PG8_BAR; PG8_WAIT_L(0); PG8_MMA(0, 1, At, B1); PG8_BAR;
            PG8_LDA(At, 0, 1); PG8_STAGE(PG8_SA(0, 0), a2, voffA);
            PG8_BAR; PG8_WAIT_L(0); PG8_MMA(1, 0, At, B0); PG8_BAR; PG8_SCHED;
            PG8_STAGE(PG8_SB(0, 1), b2 + hstep, voffB);
            PG8_WAIT_V(6); PG8_BAR; PG8_MMA(1, 1, At, B1); PG8_BAR;
            PG8_LDB(B0, 1, 0); PG8_SCHED; PG8_LDA(At, 1, 0); PG8_STAGE(PG8_SA(0, 1), a2 + hstep, voffA);
            PG8_WAIT_L(8); PG8_BAR; PG8_WAIT_L(0); PG8_MMA(0, 0, At, B0); PG8_BAR; PG8_SCHED;
            PG8_LDB(B1, 1, 1); PG8_STAGE(PG8_SB(1, 0), b3, voffB);
            PG8_BAR; PG8_WAIT_L(0); PG8_MMA(0, 1, At, B1); PG8_BAR;
            PG8_LDA(At, 1, 1); PG8_STAGE(PG8_SA(1, 0), a3, voffA);
            PG8_BAR; PG8_WAIT_L(0); PG8_MMA(1, 0, At, B0); PG8_BAR; PG8_SCHED;
            PG8_STAGE(PG8_SB(1, 1), b3 + hstep, voffB);
            PG8_WAIT_V(6); PG8_BAR; PG8_MMA(1, 1, At, B1); PG8_BAR;
            }
        }
        if constexpr (ALIGN_EPI) { if (wr == 0) PG8_BAR; }
        if constexpr (!Epi::AFTER_DRAIN) { E(acc, cur, wr, wc, fr, fq); S.done(cur); }
        if (!has_next) break;
#pragma unroll
        for (int a = 0; a < 2; ++a)
#pragma unroll
            for (int b = 0; b < 2; ++b)
#pragma unroll
                for (int m = 0; m < 4; ++m)
#pragma unroll
                    for (int n = 0; n < 2; ++n) acc[a][b][m][n] = (f32x4){0.f, 0.f, 0.f, 0.f};
        cur = nxt; cA = nA; cB = nB; ++ui;
        if constexpr (ALIGN_EPI) { if (wr == 1) PG8_BAR; }
    }
    PG8_WAIT_V(0);
    if constexpr (!ALIGN_EPI) { if (wr == 0) PG8_BAR; }
    PG8_BAR;
    if constexpr (Epi::AFTER_DRAIN) { E.fused(acc, cur, wr, wc, fr, fq, lds, wid, lane); S.done(cur); }
#undef PG8_SA
#undef PG8_SB
#undef PG8_STAGE
#undef PG8_LDA
#undef PG8_LDB
#undef PG8_MMA
#undef PG8_WAIT_V
#undef PG8_WAIT_L
#undef PG8_BAR
#undef PG8_SCHED
}

typedef unsigned u32x2 __attribute__((ext_vector_type(2)));
constexpr float RMS_EPS = 1e-6f;
__device__ __forceinline__ float rstd_of(float ss, float inv_n) { return __builtin_amdgcn_rsqf(ss * inv_n + RMS_EPS); }
__device__ __forceinline__ float silu_f(float x) { return x * __builtin_amdgcn_rcpf(1.0f + __builtin_amdgcn_exp2f(-1.4426950408889634f * x)); }

struct EpiSwiglu {
    static constexpr bool PERM = true, AFTER_DRAIN = false, MIDSCALE = false;
    bf16_t* H; const float* ss; int ldh;
    __device__ __forceinline__ void operator()(const f32x4 (&acc)[2][2][4][2], const Unit& u, int wr, int wc, int fr, int fq) const {
        asm volatile("" : "+v"(fr), "+v"(fq), "+s"(wr), "+s"(wc));
        const int row0 = u.pm * BM + wr * 64 + fr, col0 = u.pn * HALF + wc * 32 + 8 * fq;
        float rsv[8];
#pragma unroll
        for (int q = 0; q < 8; ++q) rsv[q] = ss[row0 + (q >> 2) * HALF + (q & 3) * 16];
#pragma unroll
        for (int ai = 0; ai < 2; ++ai)
#pragma unroll
            for (int m = 0; m < 4; ++m) {
                const int row = row0 + ai * HALF + m * 16;
                const float rs = rstd_of(rsv[ai * 4 + m], 1.0f / 1024.0f);
                float o[8];
#pragma unroll
                for (int n = 0; n < 2; ++n)
#pragma unroll
                    for (int j = 0; j < 4; ++j) { const float g = acc[ai][0][m][n][j] * rs, up = acc[ai][1][m][n][j] * rs; o[n * 4 + j] = silu_f(g) * up; }
                u32x4 w; w.x = cvt_pk_bf16(o[0], o[1]); w.y = cvt_pk_bf16(o[2], o[3]); w.z = cvt_pk_bf16(o[4], o[5]); w.w = cvt_pk_bf16(o[6], o[7]);
                *(u32x4*)(H + (size_t)row * ldh + col0) = w;
            }
    }
};

struct EpiRes {
    static constexpr bool PERM = true, AFTER_DRAIN = true, MIDSCALE = false;
    const bf16_t* residh; bf16_t* ob; bf16_t* operm; float* ss; float alpha;
    __device__ __forceinline__ void fused(f32x4 (&acc)[2][2][4][2], const Unit& u, int wr, int wc, int fr, int fq, PG8_LAS unsigned char* lds, int wid, int lane) const {
        PG8_LAS float* Pl = (PG8_LAS float*)lds;
        asm volatile("" : "+v"(fr), "+v"(fq), "+s"(wr), "+s"(wc));
        const int col0 = u.pn * BM + wc * 32 + 8 * fq, s0 = u.pm * BM + wr * 64 + fr;
        u32x4 rh[3][2];
#define EPI_LOADH(q) do { const size_t o_ = (size_t)(s0 + ((q) >> 2) * HALF + ((q) & 3) * 16) * 1024 + col0; \
        _Pragma("unroll") for (int x_ = 0; x_ < 2; ++x_) rh[(q) % 3][x_] = *(const u32x4*)(residh + o_ + x_ * HALF); } while (0)
#define EPI_UNLO(v_) ((f32x4){__builtin_bit_cast(float, (v_).x << 16), __builtin_bit_cast(float, (v_).x & 0xffff0000u), __builtin_bit_cast(float, (v_).y << 16), __builtin_bit_cast(float, (v_).y & 0xffff0000u)})
#define EPI_UNHI(v_) ((f32x4){__builtin_bit_cast(float, (v_).z << 16), __builtin_bit_cast(float, (v_).z & 0xffff0000u), __builtin_bit_cast(float, (v_).w << 16), __builtin_bit_cast(float, (v_).w & 0xffff0000u)})
        EPI_LOADH(0); EPI_LOADH(1);
#pragma unroll
        for (int q = 0; q < 8; ++q) {
            const int ai = q >> 2, m = q & 3;
            if (q + 2 < 8) EPI_LOADH(q + 2);
            const int s = s0 + ai * HALF + m * 16;
            const int t = s + 16, b = t / 164, a = t - b * 164; const size_t nperm = (size_t)(a * 100 + b);
            float ps = 0.f;
#pragma unroll
            for (int bj = 0; bj < 2; ++bj) {
                const int col = col0 + bj * HALF; const size_t off = (size_t)s * 1024 + col;
                const f32x4 o0 = EPI_UNLO(rh[q % 3][bj]) + acc[ai][bj][m][0] * alpha, o1 = EPI_UNHI(rh[q % 3][bj]) + acc[ai][bj][m][1] * alpha;
                ps += ((o0[0] * o0[0] + o0[1] * o0[1]) + (o0[2] * o0[2] + o0[3] * o0[3])) + ((o1[0] * o1[0] + o1[1] * o1[1]) + (o1[2] * o1[2] + o1[3] * o1[3]));
                u32x4 w; w.x = cvt_pk_bf16(o0[0], o0[1]); w.y = cvt_pk_bf16(o0[2], o0[3]); w.z = cvt_pk_bf16(o1[0], o1[1]); w.w = cvt_pk_bf16(o1[2], o1[3]);
                *(u32x4*)(ob + off) = w;
                *(u32x4*)(operm + nperm * 1024 + col) = w;
            }
            ps += __shfl_xor(ps, 16); ps += __shfl_xor(ps, 32); if (fq == 0) Pl[(ai * HALF + wr * 64 + m * 16 + fr) * 4 + wc] = ps;
        }
        asm volatile("s_waitcnt lgkmcnt(0)" ::: "memory"); __syncthreads();
        if (threadIdx.x < 256) { const int row = threadIdx.x; atomicAdd(ss + u.pm * BM + row, (Pl[row * 4 + 0] + Pl[row * 4 + 1]) + (Pl[row * 4 + 2] + Pl[row * 4 + 3])); }
    }
};

struct EpiQKV {
    static constexpr bool PERM = true, AFTER_DRAIN = false, MIDSCALE = false;
    bf16_t* Q; bf16_t* Kb; bf16_t* Vt; const float* ss; const float* qn; const float* kn; int LPv;
    __device__ __forceinline__ void operator()(const f32x4 (&acc)[2][2][4][2], const Unit& u, int wr, int wc, int fr, int fq) const {
        asm volatile("" : "+v"(fr), "+v"(fq), "+s"(wr), "+s"(wc));
        const int hs = 4 * u.pn + wc;
        f32x4 gn[2][2];
        const float* gp = hs < 8 ? qn : kn;
#pragma unroll
        for (int bj = 0; bj < 2; ++bj)
#pragma unroll
            for (int n = 0; n < 2; ++n) gn[bj][n] = *(const f32x4*)(gp + 32 * bj + 8 * fq + 4 * n);
        const float qs = hs < 8 ? 0.125f * 1.4426950408889634f : 1.0f;
        float rsv[8];
#pragma unroll
        for (int q = 0; q < 8; ++q) rsv[q] = ss[u.pm * BM + (q >> 2) * HALF + wr * 64 + (q & 3) * 16 + fr];
#pragma unroll
        for (int ai = 0; ai < 2; ++ai)
#pragma unroll
            for (int m = 0; m < 4; ++m) {
                const int t = u.pm * BM + ai * HALF + wr * 64 + m * 16 + fr;
                const float rs = rstd_of(rsv[ai * 4 + m], 1.0f / 1024.0f);
                f32x4 v[2][2]; float q = 0.f;
#pragma unroll
                for (int bj = 0; bj < 2; ++bj)
#pragma unroll
                    for (int n = 0; n < 2; ++n) { v[bj][n] = acc[ai][bj][m][n] * rs; const f32x4 x = v[bj][n]; q += (x[0] * x[0] + x[1] * x[1]) + (x[2] * x[2] + x[3] * x[3]); }
                q += __shfl_xor(q, 16); q += __shfl_xor(q, 32);
                if (hs < 10) { const float hr = rstd_of(q, 1.0f / 64.0f) * qs;
#pragma unroll
                    for (int bj = 0; bj < 2; ++bj)
#pragma unroll
                        for (int n = 0; n < 2; ++n) v[bj][n] = v[bj][n] * gn[bj][n] * hr; }
#pragma unroll
                for (int bj = 0; bj < 2; ++bj) {
                    const int d = 32 * bj + 8 * fq; const f32x4 x0 = v[bj][0], x1 = v[bj][1];
                    u32x4 w; w.x = cvt_pk_bf16(x0[0], x0[1]); w.y = cvt_pk_bf16(x0[2], x0[3]); w.z = cvt_pk_bf16(x1[0], x1[1]); w.w = cvt_pk_bf16(x1[2], x1[3]);
                    if (hs < 8) *(u32x4*)(Q + (size_t)t * 512 + hs * 64 + d) = w;
                    else if (hs < 10) *(u32x4*)(Kb + (size_t)t * 128 + (hs - 8) * 64 + d) = w;
                    else { bf16_t* vp = Vt + (size_t)((hs - 10) * 64 + d) * LPv + t; const size_t L_ = (size_t)LPv;
                        vp[0] = (bf16_t)(w.x & 0xffffu); vp[L_] = (bf16_t)(w.x >> 16); vp[2 * L_] = (bf16_t)(w.y & 0xffffu); vp[3 * L_] = (bf16_t)(w.y >> 16);
                        vp[4 * L_] = (bf16_t)(w.z & 0xffffu); vp[5 * L_] = (bf16_t)(w.z >> 16); vp[6 * L_] = (bf16_t)(w.w & 0xffffu); vp[7 * L_] = (bf16_t)(w.w >> 16); }
                }
            }
    }
};

struct EpiG0 {
    static constexpr bool PERM = true, AFTER_DRAIN = false, MIDSCALE = false;
    bf16_t* X; const float* ss;
    __device__ __forceinline__ void operator()(const f32x4 (&acc)[2][2][4][2], const Unit& u, int wr, int wc, int fr, int fq) const {
        asm volatile("" : "+v"(fr), "+v"(fq), "+s"(wr), "+s"(wc));
        const int part = u.pm >> 1;
#pragma unroll
        for (int bj = 0; bj < 2; ++bj) {
            const int nn = u.pn * BM + bj * HALF + wc * 32 + 8 * fq;
            if (nn >= 16400) continue;
            const int a = nn / 100, b = nn - a * 100;
            const bool cross = b == 96;
            const int a1 = cross ? a + 1 : a, b1 = cross ? 0 : b + 4;
            f32x4 rs0, rs1;
#pragma unroll
            for (int j = 0; j < 4; ++j) { rs0[j] = rstd_of(ss[a + 164 * (b + j)], 1.0f / 1024.0f); rs1[j] = rstd_of(ss[a1 + 164 * (b1 + j)], 1.0f / 1024.0f); }
#pragma unroll
            for (int ai = 0; ai < 2; ++ai)
#pragma unroll
                for (int m = 0; m < 4; ++m) {
                    const int c = ((u.pm & 1) * BM) + ai * HALF + wr * 64 + m * 16 + fr;
                    const f32x4 x0 = acc[ai][bj][m][0] * rs0, x1 = acc[ai][bj][m][1] * rs1;
                    const unsigned w0 = cvt_pk_bf16(x0[0], x0[1]), w1 = cvt_pk_bf16(x0[2], x0[3]), w2 = cvt_pk_bf16(x1[0], x1[1]), w3 = cvt_pk_bf16(x1[2], x1[3]);
                    bf16_t* p = X + ((size_t)(c * 164 + a) * 2 + part) * 128 + b;
                    if (!cross) *(u32x4*)p = (u32x4){w0, w1, w2, w3};
                    else {
                        *(u32x2*)p = (u32x2){w0, w1};
#pragma unroll
                        for (int z = 1; z < 8; ++z) *(u32x2*)(p + 4 * z) = (u32x2){0u, 0u};
                        *(u32x2*)(X + ((size_t)(c * 164 + a + 1) * 2 + part) * 128) = (u32x2){w2, w3};
                    }
                }
        }
    }
};

struct EpiG1 {
    static constexpr bool PERM = true, AFTER_DRAIN = false, MIDSCALE = false;
    bf16_t* X1;
    __device__ __forceinline__ void operator()(const f32x4 (&acc)[2][2][4][2], const Unit& u, int wr, int wc, int fr, int fq) const {
        asm volatile("" : "+v"(fr), "+v"(fq), "+s"(wr), "+s"(wc));
#pragma unroll
        for (int m = 0; m < 4; ++m) {
            const int beta = wr * 64 + m * 16 + fr;
            if (beta >= 100) continue;
            const float cd = __builtin_amdgcn_cosf((float)beta * (1.0f / 16400.0f)), sd = __builtin_amdgcn_sinf((float)beta * (1.0f / 16400.0f));
#pragma unroll
            for (int bj = 0; bj < 2; ++bj) {
                const int n1 = u.pn * BM + bj * HALF + wc * 32 + 8 * fq;
                const int c = n1 / 164, a0 = n1 - c * 164;
                const bool cross = a0 == 160;
                float cs = __builtin_amdgcn_cosf((float)(a0 * beta) * (1.0f / 16400.0f)), sn = __builtin_amdgcn_sinf((float)(a0 * beta) * (1.0f / 16400.0f));
                unsigned wre[4], wim[4];
#pragma unroll
                for (int n = 0; n < 2; ++n) {
                    const f32x4 re = acc[0][bj][m][n], im = acc[1][bj][m][n];
                    f32x4 ore, oim;
                    if (n == 1 && cross) { cs = 1.0f; sn = 0.0f; }
#pragma unroll
                    for (int j = 0; j < 4; ++j) {
                        ore[j] = re[j] * cs + im[j] * sn; oim[j] = im[j] * cs - re[j] * sn;
                        const float c2 = cs * cd - sn * sd; sn = sn * cd + cs * sd; cs = c2;
                    }
                    wre[2 * n] = cvt_pk_bf16(ore[0], ore[1]); wre[2 * n + 1] = cvt_pk_bf16(ore[2], ore[3]);
                    wim[2 * n] = cvt_pk_bf16(oim[0], oim[1]); wim[2 * n + 1] = cvt_pk_bf16(oim[2], oim[3]);
                }
                bf16_t* p = X1 + ((size_t)(beta * 512 + c) * 2) * 192 + a0;
                if (!cross) {
                    *(u32x4*)p = (u32x4){wre[0], wre[1], wre[2], wre[3]};
                    *(u32x4*)(p + 192) = (u32x4){wim[0], wim[1], wim[2], wim[3]};
                } else {
                    *(u32x2*)p = (u32x2){wre[0], wre[1]}; *(u32x2*)(p + 192) = (u32x2){wim[0], wim[1]};
#pragma unroll
                    for (int z = 1; z < 8; ++z) { *(u32x2*)(p + 4 * z) = (u32x2){0u, 0u}; *(u32x2*)(p + 192 + 4 * z) = (u32x2){0u, 0u}; }
                    bf16_t* p2 = X1 + ((size_t)(beta * 512 + c + 1) * 2) * 192;
                    *(u32x2*)p2 = (u32x2){wre[2], wre[3]}; *(u32x2*)(p2 + 192) = (u32x2){wim[2], wim[3]};
                }
            }
        }
    }
};

struct EpiG3 {
    static constexpr bool PERM = true, AFTER_DRAIN = false, MIDSCALE = false;
    bf16_t* MX; float* ssF;
    __device__ __forceinline__ void operator()(const f32x4 (&acc)[2][2][4][2], const Unit& u, int wr, int wc, int fr, int fq) const {
        asm volatile("" : "+v"(fr), "+v"(fq), "+s"(wr), "+s"(wc));
        const int beta = u.pn >> 1, cb = (u.pn & 1) * BM + wc * 32 + 8 * fq;
#pragma unroll
        for (int ai = 0; ai < 2; ++ai)
#pragma unroll
            for (int m = 0; m < 4; ++m) {
                const int alpha = ai * HALF + wr * 64 + m * 16 + fr;
                const int s = 100 * alpha + beta - 16;
                const bool ok = alpha < 164 && s >= 0;
                float ps = 0.f;
#pragma unroll
                for (int bj = 0; bj < 2; ++bj) {
                    const f32x4 x0 = acc[ai][bj][m][0], x1 = acc[ai][bj][m][1];
                    ps += ((x0[0] * x0[0] + x0[1] * x0[1]) + (x0[2] * x0[2] + x0[3] * x0[3])) + ((x1[0] * x1[0] + x1[1] * x1[1]) + (x1[2] * x1[2] + x1[3] * x1[3]));
                    if (ok) { u32x4 w; w.x = cvt_pk_bf16(x0[0], x0[1]); w.y = cvt_pk_bf16(x0[2], x0[3]); w.z = cvt_pk_bf16(x1[0], x1[1]); w.w = cvt_pk_bf16(x1[2], x1[3]);
                        *(u32x4*)(MX + (size_t)s * 1024 + 512 + cb + bj * HALF) = w; }
                }
                ps += __shfl_xor(ps, 16); ps += __shfl_xor(ps, 32);
                if (ok && fq == 0) atomicAdd(ssF + beta * 164 + alpha, ps);
            }
    }
};

struct EpiResMix {
    static constexpr bool PERM = true, AFTER_DRAIN = true, MIDSCALE = true;
    const bf16_t* residh; bf16_t* ob; float* ss; const float* ssA; const float* ssF;
    __device__ __forceinline__ void mid(f32x4 (&acc)[2][2][4][2], const Unit& u, int wr, int wc, int fr, int fq) const {
        asm volatile("" : "+v"(fr), "+s"(wr));
        const int s0 = u.pm * BM + wr * 64 + fr;
        float va[8], vf[8];
#pragma unroll
        for (int q = 0; q < 8; ++q) { const int s_ = s0 + (q >> 2) * HALF + (q & 3) * 16, al_ = (s_ + 16) / 100; va[q] = ssA[s_]; vf[q] = ssF[(s_ + 16 - 100 * al_) * 164 + al_]; }
#pragma unroll
        for (int q = 0; q < 8; ++q) {
            const float ratio = rstd_of(va[q], 1.0f / 512.0f) * __builtin_amdgcn_rcpf(rstd_of(vf[q], 1.0f / 512.0f));
#pragma unroll
            for (int bj = 0; bj < 2; ++bj)
#pragma unroll
                for (int n = 0; n < 2; ++n) acc[q >> 2][bj][q & 3][n] = acc[q >> 2][bj][q & 3][n] * ratio;
        }
    }
    __device__ __forceinline__ void fused(f32x4 (&acc)[2][2][4][2], const Unit& u, int wr, int wc, int fr, int fq, PG8_LAS unsigned char* lds, int wid, int lane) const {
        PG8_LAS float* Pl = (PG8_LAS float*)lds;
        asm volatile("" : "+v"(fr), "+v"(fq), "+s"(wr), "+s"(wc));
        const int col0 = u.pn * BM + wc * 32 + 8 * fq, s0 = u.pm * BM + wr * 64 + fr;
        float vf[8];
#pragma unroll
        for (int q = 0; q < 8; ++q) { const int s_ = s0 + (q >> 2) * HALF + (q & 3) * 16, al_ = (s_ + 16) / 100; vf[q] = ssF[(s_ + 16 - 100 * al_) * 164 + al_]; }
        u32x4 rh[3][2];
        EPI_LOADH(0); EPI_LOADH(1);
#pragma unroll
        for (int q = 0; q < 8; ++q) {
            const int ai = q >> 2, m = q & 3;
            if (q + 2 < 8) EPI_LOADH(q + 2);
            const int s = s0 + ai * HALF + m * 16;
            const float rf = rstd_of(vf[q], 1.0f / 512.0f);
            float ps = 0.f;
#pragma unroll
            for (int bj = 0; bj < 2; ++bj) {
                const size_t off = (size_t)s * 1024 + col0 + bj * HALF;
                const f32x4 o0 = EPI_UNLO(rh[q % 3][bj]) + acc[ai][bj][m][0] * rf, o1 = EPI_UNHI(rh[q % 3][bj]) + acc[ai][bj][m][1] * rf;
                ps += ((o0[0] * o0[0] + o0[1] * o0[1]) + (o0[2] * o0[2] + o0[3] * o0[3])) + ((o1[0] * o1[0] + o1[1] * o1[1]) + (o1[2] * o1[2] + o1[3] * o1[3]));
                u32x4 w; w.x = cvt_pk_bf16(o0[0], o0[1]); w.y = cvt_pk_bf16(o0[2], o0[3]); w.z = cvt_pk_bf16(o1[0], o1[1]); w.w = cvt_pk_bf16(o1[2], o1[3]);
                *(u32x4*)(ob + off) = w;
            }
            ps += __shfl_xor(ps, 16); ps += __shfl_xor(ps, 32); if (fq == 0) Pl[(ai * HALF + wr * 64 + m * 16 + fr) * 4 + wc] = ps;
        }
        asm volatile("s_waitcnt lgkmcnt(0)" ::: "memory"); __syncthreads();
        if (threadIdx.x < 256) { const int row = threadIdx.x; atomicAdd(ss + u.pm * BM + row, (Pl[row * 4 + 0] + Pl[row * 4 + 1]) + (Pl[row * 4 + 2] + Pl[row * 4 + 3])); }
    }
};


struct EpiResFinal {
    static constexpr bool PERM = true, AFTER_DRAIN = true, MIDSCALE = false;
    const bf16_t* residh; float* out; float* ss; unsigned* cnt; const float* gain; float alpha;
    __device__ __forceinline__ void fused(f32x4 (&acc)[2][2][4][2], const Unit& u, int wr, int wc, int fr, int fq, PG8_LAS unsigned char* lds, int wid, int lane) const {
        const int col0 = u.pn * BM + wc * 32 + 8 * fq, s0 = u.pm * BM + wr * 64 + fr;
        PG8_LAS float* Pl = (PG8_LAS float*)lds; PG8_LAS float* Tl = (PG8_LAS float*)(lds + 4096);
        u32x4 rh[3][2];
        EPI_LOADH(0); EPI_LOADH(1);
#pragma unroll
        for (int q = 0; q < 8; ++q) {
            const int ai = q >> 2, m = q & 3;
            if (q + 2 < 8) EPI_LOADH(q + 2);
            float ps = 0.f;
#pragma unroll
            for (int bj = 0; bj < 2; ++bj) {
                const f32x4 o0 = EPI_UNLO(rh[q % 3][bj]) + acc[ai][bj][m][0] * alpha, o1 = EPI_UNHI(rh[q % 3][bj]) + acc[ai][bj][m][1] * alpha;
                acc[ai][bj][m][0] = o0; acc[ai][bj][m][1] = o1;
                ps += ((o0[0] * o0[0] + o0[1] * o0[1]) + (o0[2] * o0[2] + o0[3] * o0[3])) + ((o1[0] * o1[0] + o1[1] * o1[1]) + (o1[2] * o1[2] + o1[3] * o1[3]));
            }
            ps += __shfl_xor(ps, 16); ps += __shfl_xor(ps, 32);
            if (fq == 0) Pl[(ai * HALF + wr * 64 + m * 16 + fr) * 4 + wc] = ps;
        }
        asm volatile("s_waitcnt lgkmcnt(0)" ::: "memory"); __syncthreads();
        if (threadIdx.x < 256) {
            const int row = threadIdx.x;
            const float part = (Pl[row * 4 + 0] + Pl[row * 4 + 1]) + (Pl[row * 4 + 2] + Pl[row * 4 + 3]);
            unsigned* sl = (unsigned*)ss + ((size_t)u.pm * 4) * 256 + row;
            __hip_atomic_store(sl + u.pn * 256, __builtin_bit_cast(unsigned, part) | 1u, __ATOMIC_RELAXED, __HIP_MEMORY_SCOPE_AGENT);
            float pv[4];
#pragma unroll
            for (int p2 = 0; p2 < 4; ++p2) { unsigned v = __builtin_bit_cast(unsigned, part) | 1u, spins = 0u;
                if (p2 != u.pn) { while ((v = __hip_atomic_load(sl + p2 * 256, __ATOMIC_RELAXED, __HIP_MEMORY_SCOPE_AGENT)) == 0u && ++spins < (1u << 20)) __builtin_amdgcn_s_sleep(1); }
                pv[p2] = __builtin_bit_cast(float, v); }
            const float tot = (pv[0] + pv[1]) + (pv[2] + pv[3]);
            Tl[row] = rstd_of(tot, 1.0f / 1024.0f);
        }
        asm volatile("s_waitcnt vmcnt(0) lgkmcnt(0)" ::: "memory"); __syncthreads();
        f32x4 gv[2][2];
#pragma unroll
        for (int bj = 0; bj < 2; ++bj)
#pragma unroll
            for (int n = 0; n < 2; ++n) gv[bj][n] = *(const f32x4*)(gain + col0 + bj * HALF + 4 * n);
#pragma unroll
        for (int q = 0; q < 8; ++q) {
            const int ai = q >> 2, m = q & 3; const int s = s0 + ai * HALF + m * 16;
            const float rs = Tl[ai * HALF + wr * 64 + m * 16 + fr];
#pragma unroll
            for (int bj = 0; bj < 2; ++bj)
#pragma unroll
                for (int n = 0; n < 2; ++n) *(f32x4*)(out + (size_t)s * 1024 + col0 + bj * HALF + 4 * n) = acc[ai][bj][m][n] * rs * gv[bj][n];
        }
    }
};
#undef EPI_LOADH
#undef EPI_UNLO
#undef EPI_UNHI
}

constexpr int NWAVES = 8;
constexpr int DM = 1024, LTOK = 16400, LP = 16640, SEQ = 16384, NMETA = 16, FF = 2816;
constexpr size_t MiB = 1u << 20;
constexpr size_t WS_CTL = 0, CTL_BYTES = MiB;
constexpr size_t CT_SS1 = 0, CT_SS2 = 128 * 1024, CT_MACC = 256 * 1024, CT_MCNT = 384 * 1024, CT_BAR = 512 * 1024, CT_TIX = 640 * 1024, CT_SSA = 768 * 1024, CT_SSF = 832 * 1024, CT_PCNT = 900 * 1024, CT_SS3 = 920 * 1024;
constexpr int MISC_OFF = 147456 - 256;
constexpr size_t WS_SS0 = 1 * MiB, WS_A1 = 1 * MiB + 128 * 1024, WS_A3 = 1 * MiB + 256 * 1024, WS_SLOT = 1 * MiB + 512 * 1024;
constexpr size_t WS_WGU1 = 2 * MiB, WS_WD1 = 13 * MiB, WS_WQKV = 19 * MiB, WS_WG = 21 * MiB, WS_WOUT = 23 * MiB, WS_WGU2 = 25 * MiB, WS_WD2 = 36 * MiB;
constexpr size_t WS_HID = 48 * MiB, WS_X = 48 * MiB, WS_X1 = 92 * MiB;
constexpr size_t WS_XB = 144 * MiB;
constexpr size_t WS_Q = 178 * MiB, WS_K = 195 * MiB, WS_VT = 200 * MiB;
constexpr size_t WS_Y = 178 * MiB, WS_H2B = 178 * MiB;
constexpr size_t WS_PERM = 212 * MiB, WS_O = 212 * MiB;
constexpr size_t WS_END = 246 * MiB;
constexpr int LDS_BYTES = 147456;

#define LAS __attribute__((address_space(3)))
typedef unsigned short bf16;
typedef unsigned v4u __attribute__((ext_vector_type(4)));
typedef unsigned v2u __attribute__((ext_vector_type(2)));
typedef float f32x4 __attribute__((ext_vector_type(4)));
typedef short bf16x8 __attribute__((ext_vector_type(8)));
#define LDS_WAIT() asm volatile("s_waitcnt lgkmcnt(0)" ::: "memory")
__device__ __forceinline__ unsigned f2bf(float f) { unsigned u = __builtin_bit_cast(unsigned, f); return (u + 0x7fffu + ((u >> 16) & 1u)) >> 16; }
__device__ __forceinline__ unsigned pk2(float lo, float hi) { return f2bf(lo) | (f2bf(hi) << 16); }
__device__ __forceinline__ float bf2f(unsigned h) { return __builtin_bit_cast(float, h << 16); }
__device__ __forceinline__ float wave_sum(float v) {
#pragma unroll
    for (int o = 1; o < 64; o <<= 1) v += __shfl_xor(v, o);
    return v;
}
__device__ __forceinline__ float wave_max(float v) {
#pragma unroll
    for (int o = 1; o < 64; o <<= 1) v = fmaxf(v, __shfl_xor(v, o));
    return v;
}

struct Args { const float* in[19]; float* out; unsigned char* ws; };

#define XB_TMO      128
#define XB_XCNT(j)  (256  + 64 * (j))
#define XB_XSUB(j)  (1280 + 64 * (j))
#define XB_XGEN(j)  (2304 + 64 * (j))
#define XB_TOP      3328
#define XB_TOPGEN   3392
#define XCD_BAR_WORDS 3456
#define XB_SPIN_CAP (1u << 18)

__device__ __forceinline__ unsigned xb_ld(unsigned* p)              { return __hip_atomic_load(p, __ATOMIC_RELAXED, __HIP_MEMORY_SCOPE_AGENT); }
__device__ __forceinline__ unsigned xb_add(unsigned* p, unsigned v) { return __hip_atomic_fetch_add(p, v, __ATOMIC_RELAXED, __HIP_MEMORY_SCOPE_AGENT); }
__device__ __forceinline__ unsigned xb_xcc_id() { return (unsigned)__builtin_amdgcn_s_getreg((3 << 11) | 20) & 0xFu; }
#define XB_SPIN(cond, bar) do { unsigned _sp = 0; while (cond) { __builtin_amdgcn_s_sleep(1); \
    if ((++_sp & 255u) == 0u) { if (xb_ld(&(bar)[XB_TMO])) break; if (_sp > XB_SPIN_CAP) { atomicAdd(&(bar)[XB_TMO], 1u); break; } } } } while (0)

struct XcdBarrier {
    unsigned* bar; unsigned x;
    volatile LAS unsigned* st;
};

__device__ __forceinline__ XcdBarrier xcd_barrier_post(unsigned* bar, volatile LAS unsigned* st) {
    XcdBarrier b; b.bar = bar; b.x = xb_xcc_id(); b.st = st;
    if (threadIdx.x == 0) (void)xb_add(&bar[XB_XCNT(b.x)], 1u);
    return b;
}
__device__ __forceinline__ void xcd_barrier_complete(unsigned* bar, unsigned x, unsigned& nloc, unsigned& nx) {
    const unsigned G = gridDim.x * gridDim.y * gridDim.z;
    unsigned sum, cnt, mine, sp = 0u;
    for (;;) {
        sum = 0u; cnt = 0u; mine = 0u;
#pragma unroll
        for (unsigned j = 0; j < 16; ++j) { const unsigned c = xb_ld(&bar[XB_XCNT(j)]); sum += c; cnt += (c > 0u) ? 1u : 0u; mine = (j == x) ? c : mine; }
        if (sum == G) break;
        __builtin_amdgcn_s_sleep(1);
        if ((++sp & 255u) == 0u) { if (xb_ld(&bar[XB_TMO])) break; if (sp > XB_SPIN_CAP) { atomicAdd(&bar[XB_TMO], 1u); break; } }
    }
    nloc = mine > 0u ? mine : 1u; nx = cnt > 0u ? cnt : 1u;
}

__device__ __forceinline__ void xcd_barrier(const XcdBarrier& b) {
    asm volatile("s_waitcnt vmcnt(0)" ::: "memory");
    __syncthreads();
    if (threadIdx.x == 0) {
        unsigned* bar = b.bar;
        __builtin_amdgcn_s_waitcnt(0);
        unsigned nloc = b.st[0], nx = b.st[1];
        if (nloc == 0u) { xcd_barrier_complete(bar, b.x, nloc, nx); b.st[0] = nloc; b.st[1] = nx; }
        const unsigned old = xb_add(&bar[XB_XSUB(b.x)], 1u);
        const unsigned gen = old / nloc;
        if (old + 1u == (gen + 1u) * nloc) {
            __builtin_amdgcn_fence(__ATOMIC_RELEASE, "agent");
            asm volatile("s_waitcnt vmcnt(0)" ::: "memory");
            const unsigned og = xb_add(&bar[XB_TOP], 1u);
            const unsigned tg = og / nx;
            if (og + 1u == (tg + 1u) * nx) xb_add(&bar[XB_TOPGEN], 1u);
            else XB_SPIN(xb_ld(&bar[XB_TOPGEN]) == tg, bar);
            __builtin_amdgcn_fence(__ATOMIC_ACQUIRE, "agent");
            xb_add(&bar[XB_XGEN(b.x)], 1u);
            asm volatile("s_waitcnt vmcnt(0)" ::: "memory");
        } else {
            XB_SPIN(xb_ld(&bar[XB_XGEN(b.x)]) == gen, bar);
            __builtin_amdgcn_fence(__ATOMIC_ACQUIRE, "agent");
            asm volatile("s_waitcnt vmcnt(0)" ::: "memory");
        }
    }
    __syncthreads();
}


__device__ __forceinline__ int dest_row(int mode, int n, int bj) {
    if (mode == 1) return 256 * (n >> 7) + 128 * bj + (n & 127);
    if (mode == 2) { const int hs = n >> 6, dd = n & 63; return 256 * (hs >> 2) + 128 * (dd >> 5) + 32 * (hs & 3) + (dd & 31); }
    return n;
}
#define TR_VARS(P) const float* P##W = nullptr; const float* P##gain = nullptr; bf16* P##WT = nullptr; int P##ldw = 0, P##K = 0, P##mode = 0, P##bj = 0, P##k0 = 0, P##n0 = 0
#define TR_SET(P, w_, g_, wt_, ldw_, K_, mode_, bj_, kb_, nb_) do { P##W = (w_); P##gain = (g_); P##WT = (bf16*)(wt_); P##ldw = (ldw_); P##K = (K_); P##mode = (mode_); P##bj = (bj_); P##k0 = 64 * (kb_); P##n0 = 64 * (nb_); } while (0)
#define TR_DECODE(P, it_) do { constexpr int I_GU = 16 * 44, I_DN = 44 * 16, I_QKV = 16 * 12; int r = (it_); \
    if (r < I_GU) { TR_SET(P, a.in[3], a.in[2], ws + WS_WGU1, FF, DM, 1, 0, r / 44, r % 44); break; } r -= I_GU; \
    if (r < I_GU) { TR_SET(P, a.in[4], a.in[2], ws + WS_WGU1, FF, DM, 1, 1, r / 44, r % 44); break; } r -= I_GU; \
    if (r < I_QKV) { TR_SET(P, a.in[7], a.in[6], ws + WS_WQKV, 1280, DM, 2, 0, r / 12, r % 12); break; } r -= I_QKV; \
    if (r < I_DN) { TR_SET(P, a.in[5], (const float*)nullptr, ws + WS_WD1, DM, FF, 0, 0, r / 16, r % 16); break; } r -= I_DN; \
    if (r < I_GU) { TR_SET(P, a.in[15], a.in[14], ws + WS_WGU2, FF, DM, 1, 0, r / 44, r % 44); break; } r -= I_GU; \
    if (r < I_GU) { TR_SET(P, a.in[16], a.in[14], ws + WS_WGU2, FF, DM, 1, 1, r / 44, r % 44); break; } r -= I_GU; \
    if (r < I_DN) { TR_SET(P, a.in[17], (const float*)nullptr, ws + WS_WD2, DM, FF, 0, 0, r / 16, r % 16); break; } r -= I_DN; \
    TR_SET(P, a.in[13], (r / 16) < 8 ? a.in[11] : a.in[12] - 512, ws + WS_WOUT, DM, DM, 0, 0, r / 16, r % 16); } while (0)
#define TR_LOAD(P, v) do { _Pragma("unroll") for (int i = 0; i < 16; ++i) { const int kk = 4 * i + (lane >> 4); \
        f32x4 x = __builtin_nontemporal_load((const f32x4*)(P##W + (size_t)(P##k0 + kk) * P##ldw + P##n0 + 4 * (lane & 15))); if (P##gain) x = x * P##gain[P##k0 + kk]; v[i] = x; } } while (0)
#define TR_FINISH(P, v) do { _Pragma("unroll") for (int i = 0; i < 16; ++i) { LAS float* w_ = scr + (4 * i + (lane >> 4)) * 65 + 4 * (lane & 15); w_[0] = v[i].x; w_[1] = v[i].y; w_[2] = v[i].z; w_[3] = v[i].w; } \
    LDS_WAIT(); asm volatile("" ::: "memory"); \
    _Pragma("unroll") for (int j = 0; j < 8; ++j) { const int n = (lane >> 3) + 8 * j; const LAS float* s_ = scr + (8 * (lane & 7)) * 65 + n; \
        v4u o; o.x = pk2(s_[0 * 65], s_[1 * 65]); o.y = pk2(s_[2 * 65], s_[3 * 65]); o.z = pk2(s_[4 * 65], s_[5 * 65]); o.w = pk2(s_[6 * 65], s_[7 * 65]); \
        *(v4u*)(P##WT + (size_t)dest_row(P##mode, P##n0 + n, P##bj) * P##K + P##k0 + 8 * (lane & 7)) = o; } \
    LDS_WAIT(); asm volatile("" ::: "memory"); } while (0)
__device__ __forceinline__ void wg_item(const float* Win, const float* gmix, bf16* WG, int g, int dq, int lane) {
    float re[4], im[4], gm[4];
#pragma unroll
    for (int dd = 0; dd < 4; ++dd) { re[dd] = 0.f; im[dd] = 0.f; gm[dd] = gmix[4 * dq + dd] * 0.125f; }
    const float* wrow = Win + (size_t)(4 * dq) * 1280 + 768 + 64 * g;
#pragma unroll 16
    for (int j = 0; j < 64; ++j) {
        const float ph = (float)((j * lane) & 63) * (1.0f / 64.0f);
        const float c = __builtin_amdgcn_cosf(ph), sn = __builtin_amdgcn_sinf(ph);
#pragma unroll
        for (int dd = 0; dd < 4; ++dd) { const float w = wrow[dd * 1280 + j]; re[dd] += w * c; im[dd] -= w * sn; }
    }
    *(v2u*)(WG + (size_t)(64 * g + lane) * 1024 + 4 * dq) = (v2u){pk2(re[0] * gm[0], re[1] * gm[1]), pk2(re[2] * gm[2], re[3] * gm[3])};
    *(v2u*)(WG + (size_t)(512 + 64 * g + lane) * 1024 + 4 * dq) = (v2u){pk2(im[0] * gm[0], im[1] * gm[1]), pk2(im[2] * gm[2], im[3] * gm[3])};
}

#define TR_RUN(it0_, stride_, itend_) do { f32x4 vA[16], vB[16]; TR_VARS(A_); TR_VARS(B_); \
        int it = (it0_); \
        if (it < (itend_)) { TR_DECODE(A_, it); TR_LOAD(A_, vA); } \
        while (it < (itend_)) { \
            const int it2 = it + (stride_); \
            if (it2 < (itend_)) { TR_DECODE(B_, it2); TR_LOAD(B_, vB); } \
            TR_FINISH(A_, vA); \
            if (it2 >= (itend_)) break; \
            const int it3 = it2 + (stride_); \
            if (it3 < (itend_)) { TR_DECODE(A_, it3); TR_LOAD(A_, vA); } \
            TR_FINISH(B_, vB); \
            it = it3; } } while (0)
__device__ __forceinline__ void late_weights(const Args& a, LAS unsigned char* lds, int first, int last, int widx, int nw, int lane, int wave) {
    unsigned char* ws = a.ws;
    LAS float* scr = (LAS float*)(lds + wave * 17408);
    TR_RUN(first + widx, nw, last);
}
constexpr int TR_N0 = 2 * (16 * 44), TR_N1 = TR_N0 + 16 * 12 + 44 * 16, TR_N = TR_N1 + 2 * (16 * 44) + 44 * 16 + 16 * 16;
__device__ __forceinline__ void p0_prologue(const Args& a, LAS unsigned char* lds, int tid, int lane, int wave) {
    unsigned char* ws = a.ws;
    LAS float* scr = (LAS float*)(lds + wave * 17408);
    const int gw = blockIdx.x * NWAVES + wave, NGW = gridDim.x * NWAVES;
    TR_RUN(gw, NGW, TR_N0);
    for (int it = gw; it < 2048; it += NGW) wg_item(a.in[7], a.in[6], (bf16*)(ws + WS_WG), it >> 8, it & 255, lane);
    {
        bf16* A1 = (bf16*)(ws + WS_A1); bf16* A3 = (bf16*)(ws + WS_A3);
        const int gt = gw * 64 + lane, NGT = NGW * 64;
        for (int e = gt; e < 256 * 256 + 256 * 384; e += NGT) {
            if (e < 65536) {
                const int rr = e >> 8, kk = e & 255, ai = rr >> 7, beta = rr & 127, part = kk >> 7, b = kk & 127; float v = 0.f;
                if (beta < 100 && b < 100) { const float ph = (float)((beta * b) % 100) * 0.01f; const float c = __builtin_amdgcn_cosf(ph) * 0.1f, s = __builtin_amdgcn_sinf(ph) * 0.1f;
                    v = ai == 0 ? (part == 0 ? c : s) : (part == 0 ? -s : c); }
                A1[e] = (bf16)f2bf(v);
            } else {
                const int e3 = e - 65536, al = e3 / 384, kk = e3 - al * 384, part = kk >= 192 ? 1 : 0, aa = kk - 192 * part; float v = 0.f;
                if (al < 164 && aa < 164) { const float ph = (float)((al * aa) % 164) * (1.0f / 164.0f); const float sc = 0.07808688094430304f;
                    v = (part == 0 ? __builtin_amdgcn_cosf(ph) : __builtin_amdgcn_sinf(ph)) * sc; }
                A3[e3] = (bf16)f2bf(v);
            }
        }
        v4u* pz = (v4u*)((bf16*)(ws + WS_PERM) + (size_t)LTOK * DM);
        for (int e = gt; e < (LP - LTOK) * DM / 8; e += NGT) pz[e] = (v4u){0u, 0u, 0u, 0u};
        v4u* ps_ = (v4u*)(ws + WS_SLOT);
        for (int e = gt; e < 256 * 1024 / 16; e += NGT) ps_[e] = (v4u){0u, 0u, 0u, 0u};
    }
    {
        bf16* xb = (bf16*)(ws + WS_XB); float* ss0 = (float*)(ws + WS_SS0);
#define XB_LOAD(V, T0) do { _Pragma("unroll") for (int r = 0; r < 4; ++r) { const int t = (T0) + r; \
            const float* src = t < NMETA ? a.in[1] + (size_t)t * DM : a.in[0] + (size_t)(t - NMETA) * DM; \
            _Pragma("unroll") for (int j = 0; j < 4; ++j) V[r][j] = t < LTOK ? __builtin_nontemporal_load((const f32x4*)src + lane + 64 * j) : (f32x4){0.f, 0.f, 0.f, 0.f}; } } while (0)
#define XB_FINISH(V, T0) do { float q[4]; \
            _Pragma("unroll") for (int r = 0; r < 4; ++r) { float s_ = 0.f; \
                _Pragma("unroll") for (int j = 0; j < 4; ++j) s_ += (V[r][j].x * V[r][j].x + V[r][j].y * V[r][j].y) + (V[r][j].z * V[r][j].z + V[r][j].w * V[r][j].w); q[r] = s_; } \
            _Pragma("unroll") for (int o = 1; o < 64; o <<= 1) { _Pragma("unroll") for (int r = 0; r < 4; ++r) q[r] += __shfl_xor(q[r], o); } \
            _Pragma("unroll") for (int r = 0; r < 4; ++r) { const int t = (T0) + r; if (lane == 0) ss0[t] = q[r]; \
                v2u* o8 = (v2u*)(xb + (size_t)t * DM) + lane; \
                _Pragma("unroll") for (int j = 0; j < 4; ++j) o8[64 * j] = (v2u){pk2(V[r][j].x, V[r][j].y), pk2(V[r][j].z, V[r][j].w)}; } } while (0)
        f32x4 va[4][4], vb4[4][4];
        int t0 = 4 * gw;
        if (t0 < LP) XB_LOAD(va, t0);
        while (t0 < LP) {
            const int t1 = t0 + 4 * NGW;
            if (t1 < LP) XB_LOAD(vb4, t1);
            XB_FINISH(va, t0);
            if (t1 >= LP) break;
            const int t2 = t1 + 4 * NGW;
            if (t2 < LP) XB_LOAD(va, t2);
            XB_FINISH(vb4, t1);
            t0 = t2;
        }
#undef XB_LOAD
#undef XB_FINISH
    }
}

__device__ __forceinline__ void meta_down(const Args& a, LAS unsigned char* lds, int tid, int lane, int wave) {
    unsigned char* ws = a.ws;
    const int cgp = blockIdx.x & 15, kq = (blockIdx.x >> 4) & 15, n0 = 64 * cgp, kbase = 176 * kq;
    LAS float* hk = (LAS float*)lds; LAS float* red = (LAS float*)(lds + 16384); LAS unsigned* flag = (LAS unsigned*)(lds + 16384 + 32768);
    const bf16* HID = (const bf16*)(ws + WS_HID);
    float* macc = (float*)(ws + WS_CTL + CT_MACC); unsigned* mcnt = (unsigned*)(ws + WS_CTL + CT_MCNT); float* ss1 = (float*)(ws + WS_CTL + CT_SS1);
    if (tid < 16 * 22) { const int r = tid / 22, k8 = (tid - r * 22) * 8; const v4u w = *(const v4u*)(HID + (size_t)r * FF + kbase + k8);
        hk[(k8 + 0) * 16 + r] = bf2f(w.x & 0xffffu); hk[(k8 + 1) * 16 + r] = bf2f(w.x >> 16); hk[(k8 + 2) * 16 + r] = bf2f(w.y & 0xffffu); hk[(k8 + 3) * 16 + r] = bf2f(w.y >> 16);
        hk[(k8 + 4) * 16 + r] = bf2f(w.z & 0xffffu); hk[(k8 + 5) * 16 + r] = bf2f(w.z >> 16); hk[(k8 + 6) * 16 + r] = bf2f(w.w & 0xffffu); hk[(k8 + 7) * 16 + r] = bf2f(w.w >> 16); }
    const float* wp = a.in[5] + (size_t)(kbase + 22 * wave) * DM + n0 + lane;
    float wv[22];
#pragma unroll
    for (int k = 0; k < 22; ++k) wv[k] = wp[(size_t)k * DM];
    __syncthreads();
    float acc[16];
#pragma unroll
    for (int r = 0; r < 16; ++r) acc[r] = 0.f;
#pragma unroll
    for (int k = 0; k < 22; ++k) {
        const float w = wv[k]; const LAS f32x4* h = (const LAS f32x4*)(hk + (22 * wave + k) * 16);
        const f32x4 h0 = h[0], h1 = h[1], h2 = h[2], h3 = h[3];
        acc[0] += w * h0.x; acc[1] += w * h0.y; acc[2] += w * h0.z; acc[3] += w * h0.w; acc[4] += w * h1.x; acc[5] += w * h1.y; acc[6] += w * h1.z; acc[7] += w * h1.w;
        acc[8] += w * h2.x; acc[9] += w * h2.y; acc[10] += w * h2.z; acc[11] += w * h2.w; acc[12] += w * h3.x; acc[13] += w * h3.y; acc[14] += w * h3.z; acc[15] += w * h3.w;
        if ((k & 3) == 3) asm volatile("" ::: "memory");
    }
#pragma unroll
    for (int r = 0; r < 16; ++r) red[(wave * 16 + r) * 64 + lane] = acc[r];
    __syncthreads();
    for (int o = tid; o < 1024; o += NWAVES * 64) { const int r = o >> 6, n = o & 63; float s = 0.f;
#pragma unroll
        for (int w = 0; w < 8; ++w) s += red[(w * 16 + r) * 64 + n];
        atomicAdd(macc + r * DM + n0 + n, s); }
    asm volatile("s_waitcnt vmcnt(0)" ::: "memory"); __syncthreads();
    if (tid == 0) { const unsigned old = atomicAdd(mcnt + cgp, 1u); flag[0] = (old == 15u) ? 1u : 0u; }
    __syncthreads();
    if (flag[0]) {
        const int r = tid >> 5, nn = (tid & 31) * 2;
        const float v0 = __hip_atomic_load(macc + r * DM + n0 + nn, __ATOMIC_RELAXED, __HIP_MEMORY_SCOPE_AGENT), v1 = __hip_atomic_load(macc + r * DM + n0 + nn + 1, __ATOMIC_RELAXED, __HIP_MEMORY_SCOPE_AGENT);
        const float h0 = a.in[1][r * DM + n0 + nn] + 0.5f * v0, h1 = a.in[1][r * DM + n0 + nn + 1] + 0.5f * v1;
        const unsigned w = pk2(h0, h1);
        *(unsigned*)((bf16*)(ws + WS_XB) + (size_t)r * DM + n0 + nn) = w;
        *(unsigned*)((bf16*)(ws + WS_PERM) + (size_t)(100 * r) * DM + n0 + nn) = w;
        float ps = h0 * h0 + h1 * h1;
#pragma unroll
        for (int o = 1; o < 32; o <<= 1) ps += __shfl_xor(ps, o);
        if ((tid & 31) == 0) atomicAdd(ss1 + r, ps);
    }
    __syncthreads();
}

#define ATT_LOAD(KF, VF, si) do { const int kk0_ = (si) == 0 ? 0 : ks + 32 * ((si) - 1); \
    _Pragma("unroll") for (int T = 0; T < 2; ++T) { const int krow = kk0_ + 8 * (i >> 2) + 4 * T + (i & 3); \
        _Pragma("unroll") for (int hf = 0; hf < 2; ++hf) KF[T][hf] = *(const bf16x8*)(Kb + (size_t)krow * 128 + kvh * 64 + hf * 32 + 8 * g); } \
    _Pragma("unroll") for (int dt = 0; dt < 4; ++dt) VF[dt] = *(const bf16x8*)(Vt + (size_t)(kvh * 64 + dt * 16 + i) * LP + kk0_ + 8 * g); } while (0)
#define ATT_COMPUTE(KF, VF, si) do { const bool metastep = (si) == 0; const int kk0_ = metastep ? 0 : ks + 32 * ((si) - 1); \
    float fd[8]; bool vl[8]; \
    _Pragma("unroll") for (int e = 0; e < 8; ++e) { const int tk = kk0_ + 8 * g + e; int dist = tq - tk; dist = dist < 0 ? -dist : dist; \
        vl[e] = metastep ? (tk < NMETA) : (dist <= 128 && tk >= NMETA && tk < LTOK); fd[e] = (float)(dist > 128 ? 128 : dist); } \
    _Pragma("unroll") for (int h = 0; h < 4; ++h) { float p[8]; \
        _Pragma("unroll") for (int T = 0; T < 2; ++T) { f32x4 S = (f32x4){0.f, 0.f, 0.f, 0.f}; \
            S = __builtin_amdgcn_mfma_f32_16x16x32_bf16(KF[T][0], Qf[h][0], S, 0, 0, 0); \
            S = __builtin_amdgcn_mfma_f32_16x16x32_bf16(KF[T][1], Qf[h][1], S, 0, 0, 0); \
            _Pragma("unroll") for (int j = 0; j < 4; ++j) { const float ex = __builtin_amdgcn_exp2f(S[j] - slope[h] * fd[4 * T + j] - M0); p[4 * T + j] = vl[4 * T + j] ? ex : 0.f; } } \
        l[h] += ((p[0] + p[1]) + (p[2] + p[3])) + ((p[4] + p[5]) + (p[6] + p[7])); \
        v4u pw; pw.x = pg8::cvt_pk_bf16(p[0], p[1]); pw.y = pg8::cvt_pk_bf16(p[2], p[3]); pw.z = pg8::cvt_pk_bf16(p[4], p[5]); pw.w = pg8::cvt_pk_bf16(p[6], p[7]); \
        const bf16x8 P = __builtin_bit_cast(bf16x8, pw); \
        _Pragma("unroll") for (int dt = 0; dt < 4; ++dt) Oa[h][dt] = __builtin_amdgcn_mfma_f32_16x16x32_bf16(VF[dt], P, Oa[h][dt], 0, 0, 0); } } while (0)
__device__ __forceinline__ void attn_phase(const Args& a, int lane, int wave) {
    unsigned char* ws = a.ws;
    const bf16* Q = (const bf16*)(ws + WS_Q); const bf16* Kb = (const bf16*)(ws + WS_K); const bf16* Vt = (const bf16*)(ws + WS_VT); bf16* O = (bf16*)(ws + WS_PERM); float* ssA = (float*)(ws + WS_CTL + CT_SSA);
    const int i = lane & 15, g = lane >> 4;
    constexpr float L2E = 1.4426950408889634f;
    const float gq = wave_max(fabsf(a.in[8][lane])), gk = wave_max(fabsf(a.in[9][lane]));
    const float M0 = fminf(8.0f * gq * gk, 80.0f) * L2E;
    const int gw = blockIdx.x * NWAVES + wave, NGW = gridDim.x * NWAVES;
    for (int unit = gw; unit < 2048; unit += NGW) {
        const int qt = unit >> 1, kvh = unit & 1;
        const int tq0 = NMETA + 16 * qt, tq = tq0 + i;
        bf16x8 Qf[4][2];
#pragma unroll
        for (int h = 0; h < 4; ++h)
#pragma unroll
            for (int hf = 0; hf < 2; ++hf) Qf[h][hf] = *(const bf16x8*)(Q + (size_t)tq * 512 + (kvh * 4 + h) * 64 + hf * 32 + 8 * g);
        f32x4 Oa[4][4]; float l[4], slope[4];
#pragma unroll
        for (int h = 0; h < 4; ++h) { l[h] = 0.f; slope[h] = __builtin_amdgcn_exp2f(-(float)(kvh * 4 + h + 1)) * L2E;
#pragma unroll
            for (int dt = 0; dt < 4; ++dt) Oa[h][dt] = (f32x4){0.f, 0.f, 0.f, 0.f}; }
        const int ks = (tq0 - 128) < 0 ? 0 : ((tq0 - 128) & ~31), ke = (tq0 + 143) & ~31;
        const int nsteps = 2 + (ke - ks) / 32;
        bf16x8 KfA[2][2], VfA[4], KfB[2][2], VfB[4];
        ATT_LOAD(KfA, VfA, 0);
        for (int si = 0; si < nsteps; si += 2) {
            if (si + 1 < nsteps) ATT_LOAD(KfB, VfB, si + 1);
            ATT_COMPUTE(KfA, VfA, si);
            if (si + 1 < nsteps) {
                if (si + 2 < nsteps) ATT_LOAD(KfA, VfA, si + 2);
                ATT_COMPUTE(KfB, VfB, si + 1);
            }
        }
        float sq = 0.f;
#pragma unroll
        for (int h = 0; h < 4; ++h) {
            float lt = l[h]; lt += __shfl_xor(lt, 16); lt += __shfl_xor(lt, 32);
            lt += __builtin_amdgcn_exp2f(a.in[10][kvh * 4 + h] * L2E - M0);
            const float inv = 1.0f / lt;
#pragma unroll
            for (int dt = 0; dt < 4; ++dt) { const f32x4 o = Oa[h][dt] * inv;
                sq += (o[0] * o[0] + o[1] * o[1]) + (o[2] * o[2] + o[3] * o[3]);
                *(v2u*)(O + (size_t)(tq - NMETA) * DM + (kvh * 4 + h) * 64 + dt * 16 + 4 * g) = (v2u){pg8::cvt_pk_bf16(o[0], o[1]), pg8::cvt_pk_bf16(o[2], o[3])}; }
        }
        sq += __shfl_xor(sq, 16); sq += __shfl_xor(sq, 32);
        if (g == 0) atomicAdd(ssA + (tq - NMETA), sq);
    }
}

__device__ __forceinline__ void mixnorm_phase(const Args& a, int lane, int wave) {
    unsigned char* ws = a.ws;
    const bf16* O = (const bf16*)(ws + WS_O); const float* Y = (const float*)(ws + WS_Y); bf16* MX = (bf16*)(ws + WS_XB);
    const int gw = blockIdx.x * NWAVES + wave, NGW = gridDim.x * NWAVES;
    for (int s0 = 4 * gw; s0 < SEQ; s0 += 4 * NGW) {
        v4u ov[4]; f32x4 y0[4], y1[4]; float sa[4], sf[4];
#pragma unroll
        for (int r = 0; r < 4; ++r) { const int s = s0 + r; ov[r] = *(const v4u*)(O + (size_t)s * 512 + 8 * lane);
            y0[r] = *(const f32x4*)(Y + (size_t)(NMETA + s) * 512 + 8 * lane); y1[r] = *(const f32x4*)(Y + (size_t)(NMETA + s) * 512 + 8 * lane + 4); }
        float of[4][8];
#pragma unroll
        for (int r = 0; r < 4; ++r) {
            of[r][0] = bf2f(ov[r].x & 0xffffu); of[r][1] = bf2f(ov[r].x >> 16); of[r][2] = bf2f(ov[r].y & 0xffffu); of[r][3] = bf2f(ov[r].y >> 16);
            of[r][4] = bf2f(ov[r].z & 0xffffu); of[r][5] = bf2f(ov[r].z >> 16); of[r][6] = bf2f(ov[r].w & 0xffffu); of[r][7] = bf2f(ov[r].w >> 16);
            float t = 0.f;
#pragma unroll
            for (int j = 0; j < 8; ++j) t += of[r][j] * of[r][j];
            sa[r] = t;
            sf[r] = (y0[r].x * y0[r].x + y0[r].y * y0[r].y) + (y0[r].z * y0[r].z + y0[r].w * y0[r].w) + (y1[r].x * y1[r].x + y1[r].y * y1[r].y) + (y1[r].z * y1[r].z + y1[r].w * y1[r].w);
        }
#pragma unroll
        for (int o = 1; o < 64; o <<= 1) {
#pragma unroll
            for (int r = 0; r < 4; ++r) { sa[r] += __shfl_xor(sa[r], o); sf[r] += __shfl_xor(sf[r], o); } }
#pragma unroll
        for (int r = 0; r < 4; ++r) { const int s = s0 + r;
            const float ra = pg8::rstd_of(sa[r], 1.0f / 512.0f), rf = pg8::rstd_of(sf[r], 1.0f / 512.0f);
            *(v4u*)(MX + (size_t)s * DM + 8 * lane) = (v4u){pk2(of[r][0] * ra, of[r][1] * ra), pk2(of[r][2] * ra, of[r][3] * ra), pk2(of[r][4] * ra, of[r][5] * ra), pk2(of[r][6] * ra, of[r][7] * ra)};
            *(v4u*)(MX + (size_t)s * DM + 512 + 8 * lane) = (v4u){pk2(y0[r].x * rf, y0[r].y * rf), pk2(y0[r].z * rf, y0[r].w * rf), pk2(y1[r].x * rf, y1[r].y * rf), pk2(y1[r].z * rf, y1[r].w * rf)};
        }
    }
}
__device__ __forceinline__ void finalnorm_phase(const Args& a, float* dst, int lane, int wave) {
    const int gw = blockIdx.x * NWAVES + wave, NGW = gridDim.x * NWAVES;
    const f32x4* gp = (const f32x4*)a.in[18];
    f32x4 gv[4];
#pragma unroll
    for (int j = 0; j < 4; ++j) gv[j] = gp[lane + 64 * j];
    for (int s0 = 4 * gw; s0 < SEQ; s0 += 4 * NGW) {
        f32x4 v[4][4]; float q[4];
#pragma unroll
        for (int r = 0; r < 4; ++r) { const f32x4* row = (const f32x4*)(a.out + (size_t)(s0 + r) * DM);
#pragma unroll
            for (int j = 0; j < 4; ++j) v[r][j] = row[lane + 64 * j]; }
#pragma unroll
        for (int r = 0; r < 4; ++r) { float t = 0.f;
#pragma unroll
            for (int j = 0; j < 4; ++j) t += (v[r][j].x * v[r][j].x + v[r][j].y * v[r][j].y) + (v[r][j].z * v[r][j].z + v[r][j].w * v[r][j].w);
            q[r] = t; }
#pragma unroll
        for (int o = 1; o < 64; o <<= 1) {
#pragma unroll
            for (int r = 0; r < 4; ++r) q[r] += __shfl_xor(q[r], o); }
#pragma unroll
        for (int r = 0; r < 4; ++r) { const float rs = pg8::rstd_of(q[r], 1.0f / 1024.0f); f32x4* orow = (f32x4*)(dst + (size_t)(s0 + r) * DM);
#pragma unroll
            for (int j = 0; j < 4; ++j) orow[lane + 64 * j] = v[r][j] * rs * gv[j]; }
    }
}

#ifndef PROBE_DUP
#define PROBE_DUP 0
#endif
#ifndef PHASE_MASK
#define PHASE_MASK 0xFFFF
#endif
constexpr int PM = PHASE_MASK;
#ifndef PG8_SP2
#define PG8_SP2 true
#endif
#ifndef PG8_ALIGN
#define PG8_ALIGN true
#endif

__global__ void __launch_bounds__(NWAVES * 64, 2) mega_fwd(Args args) {
    extern __shared__ __attribute__((aligned(16))) unsigned char lds_raw[];
    cg::grid_group grid = cg::this_grid();
    LAS unsigned char* lds = (LAS unsigned char*)lds_raw;
    const int tid = threadIdx.x, lane = tid & 63, wave = __builtin_amdgcn_readfirstlane(tid >> 6);
    const int G = gridDim.x, bx = blockIdx.x;
    unsigned char* ws = args.ws;
    float* ss0 = (float*)(ws + WS_SS0); float* ss1 = (float*)(ws + WS_CTL + CT_SS1); float* ss2 = (float*)(ws + WS_CTL + CT_SS2);
    bf16* XB = (bf16*)(ws + WS_XB); bf16* HID = (bf16*)(ws + WS_HID);

    if (tid < 16) ((LAS unsigned*)(lds + MISC_OFF))[tid] = 0u;
    __syncthreads();
    XcdBarrier bar = xcd_barrier_post((unsigned*)(ws + WS_CTL + CT_BAR), (volatile LAS unsigned*)(lds + MISC_OFF));
    if (tid == 0) { const unsigned r = xb_add((unsigned*)(ws + WS_CTL + CT_TIX) + 64 * bar.x, 1u); ((volatile LAS unsigned*)(lds + MISC_OFF))[4] = r * 8u + bar.x; }
    if (args.out == nullptr) grid.sync();
#if PROBE_DUP & 1
    p0_prologue(args, lds, tid, lane, wave); xcd_barrier(bar);
#endif
    if (PM & 1) p0_prologue(args, lds, tid, lane, wave);
    xcd_barrier(bar);
    int vb = bx;
    { bool ok = (G == 256);
      for (int j = 0; j < 8; ++j) ok = ok && (xb_ld((unsigned*)(ws + WS_CTL + CT_BAR) + XB_XCNT(j)) == 32u);
      if (ok) vb = (int)((volatile LAS unsigned*)(lds + MISC_OFF))[4]; vb = __builtin_amdgcn_readfirstlane(vb); }
    if (PM & 2) {
        pg8::Gemm g{XB, (const bf16*)(ws + WS_WGU1), LP, 2 * FF, DM}; pg8::StaticOrder S; S.init(LP, 2 * FF, G, vb);
        pg8::EpiSwiglu E{HID, ss0, FF};
        pg8::gemm_phase<pg8::EpiSwiglu, pg8::StaticOrder, PG8_ALIGN, PG8_SP2>(lds, g, S, E);
        if (vb >= 150) late_weights(args, lds, TR_N0, TR_N1, (vb - 150) * NWAVES + wave, (256 - 150) * NWAVES, lane, wave);
    }
    xcd_barrier(bar);
    if (PM & 4) {
        meta_down(args, lds, tid, lane, wave);
        pg8::Gemm g{HID + (size_t)NMETA * FF, (const bf16*)(ws + WS_WD1), SEQ, DM, FF}; pg8::StaticOrder S; S.init(SEQ, DM, G, vb);
        pg8::EpiRes E{XB + (size_t)NMETA * DM, XB + (size_t)NMETA * DM, (bf16*)(ws + WS_PERM), ss1 + NMETA, 0.5f};
        pg8::gemm_phase<pg8::EpiRes, pg8::StaticOrder, false, PG8_SP2>(lds, g, S, E);
    }
    xcd_barrier(bar);
    if (PM & 8) {
        pg8::Gemm g{XB, (const bf16*)(ws + WS_WQKV), LP, 768, DM}; pg8::StaticOrder S; S.init(LP, 768, G, vb);
        pg8::EpiQKV E{(bf16*)(ws + WS_Q), (bf16*)(ws + WS_K), (bf16*)(ws + WS_VT), ss1, args.in[8], args.in[9], LP};
        pg8::gemm_phase<pg8::EpiQKV, pg8::StaticOrder, PG8_ALIGN, PG8_SP2>(lds, g, S, E);
        pg8::Gemm g0{(const bf16*)(ws + WS_WG), (const bf16*)(ws + WS_PERM), 1024, LP, DM}; pg8::StaticOrder S0; S0.init(1024, LP, G, (vb + 61) & 255);
        pg8::EpiG0 E0{(bf16*)(ws + WS_X), ss1};
        pg8::gemm_phase<pg8::EpiG0, pg8::StaticOrder, PG8_ALIGN, PG8_SP2>(lds, g0, S0, E0);
    }
    xcd_barrier(bar);
    if (PM & 16) {
        int kdim = 256; asm volatile("" : "+s"(kdim));
        pg8::Gemm g{(const bf16*)(ws + WS_A1), (const bf16*)(ws + WS_X), 256, 512 * 164, kdim}; pg8::StaticOrder S; S.init(256, 512 * 164, G, vb);
        pg8::EpiG1 E{(bf16*)(ws + WS_X1)};
        pg8::gemm_phase<pg8::EpiG1, pg8::StaticOrder, PG8_ALIGN, PG8_SP2>(lds, g, S, E);
        attn_phase(args, lane, wave);
        if (vb >= 72) late_weights(args, lds, TR_N1, TR_N1 + 1408, (vb - 72) * NWAVES + wave, (256 - 72) * NWAVES, lane, wave);
    }
    xcd_barrier(bar);
#if PROBE_DUP & 2
    attn_phase(args, lane, wave); xcd_barrier(bar);
#endif
    if (PM & 32) {
        int kdim = 384; asm volatile("" : "+s"(kdim));
        pg8::Gemm g{(const bf16*)(ws + WS_A3), (const bf16*)(ws + WS_X1), 256, 100 * 512, kdim}; pg8::StaticOrder S; S.init(256, 100 * 512, G, vb);
        pg8::EpiG3 E{(bf16*)(ws + WS_PERM), (float*)(ws + WS_CTL + CT_SSF)};
        pg8::gemm_phase<pg8::EpiG3, pg8::StaticOrder, PG8_ALIGN, PG8_SP2>(lds, g, S, E);
        if (vb >= 200) late_weights(args, lds, TR_N1 + 2112, TR_N, (vb - 200) * NWAVES + wave, (256 - 200) * NWAVES, lane, wave);
    }
    xcd_barrier(bar);
    if (PM & 128) {
        pg8::Gemm g{(const bf16*)(ws + WS_PERM), (const bf16*)(ws + WS_WOUT), SEQ, DM, DM}; pg8::StaticOrder S; S.init(SEQ, DM, G, vb);
        pg8::EpiResMix E{XB + (size_t)NMETA * DM, (bf16*)(ws + WS_H2B), ss2, (const float*)(ws + WS_CTL + CT_SSA), (const float*)(ws + WS_CTL + CT_SSF)};
        pg8::gemm_phase<pg8::EpiResMix, pg8::StaticOrder, false, PG8_SP2>(lds, g, S, E);
    }
    xcd_barrier(bar);
    if (PM & 256) {
        pg8::Gemm g{(const bf16*)(ws + WS_H2B), (const bf16*)(ws + WS_WGU2), SEQ, 2 * FF, DM}; pg8::StaticOrder S; S.init(SEQ, 2 * FF, G, vb);
        pg8::EpiSwiglu E{HID, ss2, FF};
        pg8::gemm_phase<pg8::EpiSwiglu, pg8::StaticOrder, PG8_ALIGN, PG8_SP2>(lds, g, S, E);
        if (vb >= 128) late_weights(args, lds, TR_N1 + 1408, TR_N1 + 2112, (vb - 128) * NWAVES + wave, 128 * NWAVES, lane, wave);
    }
    xcd_barrier(bar);
    if (PM & 512) {
        pg8::Gemm g{HID, (const bf16*)(ws + WS_WD2), SEQ, DM, FF}; pg8::StaticOrder S; S.init(SEQ, DM, G, vb);
        pg8::EpiResFinal E{(const bf16*)(ws + WS_H2B), args.out, (float*)(ws + WS_SLOT), (unsigned*)(ws + WS_CTL + CT_PCNT), args.in[18], 0.5f};
        pg8::gemm_phase<pg8::EpiResFinal, pg8::StaticOrder, false, PG8_SP2>(lds, g, S, E);
    }
}

extern "C" void kernel_launch(void* const* d_in, const int* in_sizes, int n_in, void* d_out, int out_size, void* d_ws, size_t ws_size, hipStream_t stream) {
    static int grid = 0;
    if (grid == 0) {
        if (n_in != 19 || out_size != SEQ * DM || ws_size < WS_END) { fprintf(stderr, "kernel_launch: unexpected shapes (n_in %d out %d ws %zu)\n", n_in, out_size, ws_size); grid = -1; return; }
        int dev = 0, cus = 0, per_cu = 0;
        hipGetDevice(&dev); hipDeviceGetAttribute(&cus, hipDeviceAttributeMultiprocessorCount, dev);
        hipFuncSetAttribute((const void*)mega_fwd, hipFuncAttributeMaxDynamicSharedMemorySize, LDS_BYTES);
        hipOccupancyMaxActiveBlocksPerMultiprocessor(&per_cu, (const void*)mega_fwd, NWAVES * 64, LDS_BYTES);
        (void)hipGetLastError();
        if (per_cu < 1) per_cu = 1;
        grid = cus;
        if (grid != 256) fprintf(stderr, "kernel_launch: %d CUs (expected 256)\n", cus);
    }
    if (grid < 0) return;
    hipMemsetAsync((char*)d_ws + WS_CTL, 0, CTL_BYTES, stream);
    Args a{};
    for (int i = 0; i < 19; ++i) a.in[i] = (const float*)d_in[i];
    a.out = (float*)d_out; a.ws = (unsigned char*)d_ws;
    void* kargs[] = {&a};
    hipError_t e = hipLaunchCooperativeKernel((const void*)mega_fwd, dim3(grid), dim3(NWAVES * 64), kargs, LDS_BYTES, stream);
    if (e != hipSuccess) fprintf(stderr, "cooperative launch failed: %s (grid %d)\n", hipGetErrorString(e), grid);
}
```

```cpp
#include <hip/hip_runtime.h>
#include <hip/hip_cooperative_groups.h>
#include <cstdio>
#include <cstdint>
namespace cg = cooperative_groups;
namespace pg8 {
#define PG8_LAS __attribute__((address_space(3)))
typedef unsigned short bf16_t;
typedef short bf16x8 __attribute__((ext_vector_type(8)));
typedef float f32x4 __attribute__((ext_vector_type(4)));
typedef unsigned u32x4 __attribute__((ext_vector_type(4)));
constexpr int BM = 256, BK = 64, HALF = 128, HTB = HALF * BK * 2  , STAGE_BYTES = 8 * HTB, NXCD = 8, WGM = 8;

__host__ __device__ __forceinline__ int lds_byte(int r, int c) { const int st = (r >> 4) * 2 + (c >> 5), rr = r & 15, cc = c & 31, ob = rr * 64 + cc * 2; return st * 1024 + (ob ^ (((ob >> 9) & 1) << 5)); }
__host__ __device__ __forceinline__ void stage_rc(int b, int& R, int& C) { const int st = b / 1024, sb = b % 1024, swz = sb ^ (((sb >> 9) & 1) << 5); R = (st >> 1) * 16 + swz / 64; C = (st & 1) * 32 + (swz % 64) / 2; }
__host__ __device__ __forceinline__ int perm32(int rho) { const int n = rho >> 4, i = rho & 15; return 8 * (i >> 2) + 4 * n + (i & 3); }

struct Unit { int pm, pn; };
struct Gemm { const bf16_t* A; const bf16_t* Bt; int M, N, K; };

struct StaticOrder {
    int nM, nN, nwg, G, c;
    __host__ __device__ void init(int M, int N, int G_, int c_) { nM = M / BM; nN = N / BM; nwg = nM * nN; G = G_; c = c_; }
    __host__ __device__ bool next(int i, Unit& u) const {
        const long L = (long)i * G + c; if (L >= nwg) return false;
        int wgid = (int)L; { const int q = nwg / NXCD, r = nwg % NXCD, xcd = wgid % NXCD, off = wgid / NXCD; wgid = (xcd < r ? xcd * (q + 1) : r * (q + 1) + (xcd - r) * q) + off; }
        const int nig = WGM * nN, gid = wgid / nig, fm = gid * WGM, gsz = (nM - fm) < WGM ? (nM - fm) : WGM;
        u.pm = fm + ((wgid % nig) % gsz); u.pn = (wgid % nig) / gsz; return true;
    }
    __device__ __forceinline__ void a_ready(const Unit&) const {}
    __device__ __forceinline__ void done(const Unit&) const {}
};
__device__ __forceinline__ unsigned cvt_pk_bf16(float lo, float hi) { unsigned r; asm volatile("v_cvt_pk_bf16_f32 %0, %1, %2" : "=v"(r) : "v"(lo), "v"(hi)); return r; }
typedef float f32x2 __attribute__((ext_vector_type(2)));
template <class Epi, class Sched, bool ALIGN_EPI = false, bool SP2 = false>
__device__ __forceinline__ void gemm_phase(PG8_LAS unsigned char* lds, const Gemm g, const Sched& S, const Epi& E) {
    int tid_ = threadIdx.x; asm volatile("" : "+v"(tid_));
    const int tid = tid_, wid = __builtin_amdgcn_readfirstlane(tid >> 6), lane = tid & 63, wr = wid >> 2, wc = wid & 3, fr = lane & 15, fq = lane >> 4;
    const int K = g.K, nt = K / BK;
    unsigned voffA[2], voffB[2];
#pragma unroll
    for (int i = 0; i < 2; ++i) { int R, C; stage_rc(tid * 16 + i * 8192, R, C); const int Rb = Epi::PERM ? ((R & ~31) + perm32(R & 31)) : R;
        voffA[i] = (unsigned)(R * K + C) * 2u; voffB[i] = (unsigned)(Rb * K + C) * 2u; }
    const size_t kstep = (size_t)(BK * 2);
    const size_t hstep = (size_t)HALF * K * 2;
    const size_t tstep = 2 * hstep;
    const unsigned ldsw = (unsigned)wid * 1024u;
    const int aoff = lds_byte(wr * 64 + fr, fq * 8), boff = lds_byte(wc * 32 + fr, fq * 8);
#define PG8_SA(b, h) (((b) * 2 + (h)) * HTB)
#define PG8_SB(b, h) ((4 + (b) * 2 + (h)) * HTB)
#define PG8_STAGE(bufoff, gbase, voff) do { _Pragma("unroll") for (int _i = 0; _i < 2; ++_i) \
        __builtin_amdgcn_global_load_lds((const unsigned*)((const char*)(gbase) + (voff)[_i]), (PG8_LAS unsigned*)(lds + (bufoff) + ldsw + _i * 8192), 16, 0, 0); } while (0)
#define PG8_LDA(dst, b, h) do { _Pragma("unroll") for (int m = 0; m < 4; ++m) _Pragma("unroll") for (int k = 0; k < 2; ++k) dst[m][k] = *(const PG8_LAS bf16x8*)(lds + PG8_SA(b, h) + aoff + m * 2048 + k * 1024); } while (0)
#define PG8_LDB(dst, b, h) do { _Pragma("unroll") for (int n = 0; n < 2; ++n) _Pragma("unroll") for (int k = 0; k < 2; ++k) dst[n][k] = *(const PG8_LAS bf16x8*)(lds + PG8_SB(b, h) + boff + n * 2048 + k * 1024); } while (0)
#define PG8_MMA(ai, bj, At, Bt) do { __builtin_amdgcn_s_setprio(1); _Pragma("unroll") for (int m = 0; m < 4; ++m) _Pragma("unroll") for (int n = 0; n < 2; ++n) _Pragma("unroll") for (int k = 0; k < 2; ++k) \
        acc[ai][bj][m][n] = __builtin_amdgcn_mfma_f32_16x16x32_bf16(Bt[n][k], At[m][k], acc[ai][bj][m][n], 0, 0, 0); __builtin_amdgcn_s_setprio(0); } while (0)
#define PG8_WAIT_V(n) asm volatile("s_waitcnt vmcnt(" #n ")" ::: "memory")
#define PG8_WAIT_L(n) asm volatile("s_waitcnt lgkmcnt(" #n ")" ::: "memory")
#define PG8_BAR __builtin_amdgcn_s_barrier()
#define PG8_SCHED __builtin_amdgcn_sched_barrier(0)
    Unit cur, nxt; int ui = 0;
    if (!S.next(0, cur)) return;
    f32x4 acc[2][2][4][2];
#pragma unroll
    for (int a = 0; a < 2; ++a)
#pragma unroll
        for (int b = 0; b < 2; ++b)
#pragma unroll
            for (int m = 0; m < 4; ++m)
#pragma unroll
                for (int n = 0; n < 2; ++n) acc[a][b][m][n] = (f32x4){0.f, 0.f, 0.f, 0.f};
    bf16x8 At[4][2], B0[2][2], B1[2][2];
    const char* cA = (const char*)g.A + (size_t)cur.pm * tstep; const char* cB = (const char*)g.Bt + (size_t)cur.pn * tstep;
    S.a_ready(cur);
    if constexpr (SP2) {
        PG8_STAGE(PG8_SB(0, 0), cB, voffB); PG8_STAGE(PG8_SB(0, 1), cB + hstep, voffB); PG8_STAGE(PG8_SA(0, 0), cA, voffA); PG8_STAGE(PG8_SA(0, 1), cA + hstep, voffA);
        if (wr == 1) PG8_BAR;
        PG8_WAIT_V(2); PG8_BAR;
        PG8_STAGE(PG8_SB(1, 0), cB + kstep, voffB); PG8_STAGE(PG8_SA(1, 0), cA + kstep, voffA); PG8_STAGE(PG8_SB(1, 1), cB + hstep + kstep, voffB);
        PG8_WAIT_V(6); PG8_BAR;
    } else {
        PG8_STAGE(PG8_SB(0, 0), cB, voffB); PG8_STAGE(PG8_SA(0, 0), cA, voffA); PG8_STAGE(PG8_SB(0, 1), cB + hstep, voffB); PG8_STAGE(PG8_SA(0, 1), cA + hstep, voffA);
        if (wr == 1) PG8_BAR;
        PG8_WAIT_V(4); PG8_BAR;
        PG8_STAGE(PG8_SB(1, 0), cB + kstep, voffB); PG8_STAGE(PG8_SA(1, 0), cA + kstep, voffA); PG8_STAGE(PG8_SB(1, 1), cB + hstep + kstep, voffB);
        PG8_WAIT_V(6); PG8_BAR;
    }
    for (;;) {
        const bool has_next = S.next(ui + 1, nxt);
        const char* nA = has_next ? (const char*)g.A + (size_t)nxt.pm * tstep : cA; const char* nB = has_next ? (const char*)g.Bt + (size_t)nxt.pn * tstep : cB;
        for (int t = 0; t < nt; t += 2) {
            const bool last = (t == nt - 2);
            const char* a1 = cA + (size_t)(t + 1) * kstep;
            const char* a2 = last ? nA : cA + (size_t)(t + 2) * kstep; const char* b2 = last ? nB : cB + (size_t)(t + 2) * kstep;
            const char* a3 = a2 + kstep; const char* b3 = b2 + kstep;
            if (last && has_next) S.a_ready(nxt);
            if constexpr (Epi::MIDSCALE) { if (t == (nt >> 1)) E.mid(acc, cur, wr, wc, fr, fq); }
            if constexpr (SP2) {
            PG8_LDB(B0, 0, 0); PG8_LDB(B1, 0, 1); PG8_SCHED; PG8_LDA(At, 0, 0); PG8_STAGE(PG8_SA(1, 1), a1 + hstep, voffA);
            PG8_WAIT_V(8); PG8_WAIT_L(0); PG8_BAR; PG8_MMA(0, 0, At, B0); PG8_MMA(0, 1, At, B1); PG8_BAR; PG8_SCHED;
            PG8_LDA(At, 0, 1); PG8_STAGE(PG8_SB(0, 0), b2, voffB); PG8_STAGE(PG8_SB(0, 1), b2 + hstep, voffB); PG8_STAGE(PG8_SA(0, 0), a2, voffA);
            PG8_WAIT_V(8); PG8_WAIT_L(0); PG8_BAR; PG8_MMA(1, 0, At, B0); PG8_MMA(1, 1, At, B1); PG8_BAR; PG8_SCHED;
            PG8_LDB(B0, 1, 0); PG8_LDB(B1, 1, 1); PG8_SCHED; PG8_LDA(At, 1, 0); PG8_STAGE(PG8_SA(0, 1), a2 + hstep, voffA);
            PG8_WAIT_V(8); PG8_WAIT_L(0); PG8_BAR; PG8_MMA(0, 0, At, B0); PG8_MMA(0, 1, At, B1); PG8_BAR; PG8_SCHED;
            PG8_LDA(At, 1, 1); PG8_STAGE(PG8_SB(1, 0), b3, voffB); PG8_STAGE(PG8_SB(1, 1), b3 + hstep, voffB); PG8_STAGE(PG8_SA(1, 0), a3, voffA);
            PG8_WAIT_V(8); PG8_WAIT_L(0); PG8_BAR; PG8_MMA(1, 0, At, B0); PG8_MMA(1, 1, At, B1); PG8_BAR; PG8_SCHED;
            } else {
            PG8_LDB(B0, 0, 0); PG8_SCHED; PG8_LDA(At, 0, 0); PG8_STAGE(PG8_SA(1, 1), a1 + hstep, voffA);
            PG8_WAIT_L(8); PG8_BAR; PG8_WAIT_L(0); PG8_MMA(0, 0, At, B0); PG8_BAR; PG8_SCHED;
            PG8_LDB(B1, 0, 1); PG8_STAGE(PG8_SB(0, 0), b2, voffB);
            PG8_BAR; PG8_WAIT_L(0); PG8_MMA(0, 1, At, B1); PG8_BAR;
            PG8_LDA(At, 0, 1); PG8_STAGE(PG8_SA(0, 0), a2, voffA);
            PG8_BAR; PG8_WAIT_L(0); PG8_MMA(1, 0, At, B0); PG8_BAR; PG8_SCHED;
            PG8_STAGE(PG8_SB(0, 1), b2 + hstep, voffB);
            PG8_WAIT_V(6); PG8_BAR; PG8_MMA(1, 1, At, B1); PG8_BAR;
            PG8_LDB(B0, 1, 0); PG8_SCHED; PG8_LDA(At, 1, 0); PG8_STAGE(PG8_SA(0, 1), a2 + hstep, voffA);
            PG8_WAIT_L(8); PG8_BAR; PG8_WAIT_L(0); PG8_MMA(0, 0, At, B0); PG8_BAR; PG8_SCHED;
            PG8_LDB(B1, 1, 1); PG8_STAGE(PG8_SB(1, 0), b3, voffB);
            PG8_BAR; PG8_WAIT_L(0); PG8_MMA(0, 1, At, B1); PG8_BAR;
            PG8_LDA(At, 1, 1); PG8_STAGE(PG8_SA(1, 0), a3, voffA);
            PG8_BAR; PG8_WAIT_L(0); PG8_MMA(1, 0, At, B0); PG8_BAR; PG8_SCHED;
            PG8_STAGE(PG8_SB(1, 1), b3 + hstep, voffB);
            PG8_WAIT_V(6); PG8_BAR; PG8_MMA(1, 1, At, B1); PG8_BAR;
            }
        }
        if constexpr (ALIGN_EPI) { if (wr == 0) PG8_BAR; }
        if constexpr (!Epi::AFTER_DRAIN) { E(acc, cur, wr, wc, fr, fq); S.done(cur); }
        if (!has_next) break;
#pragma unroll
        for (int a = 0; a < 2; ++a)
#pragma unroll
            for (int b = 0; b < 2; ++b)
#pragma unroll
                for (int m = 0; m < 4; ++m)
#pragma unroll
                    for (int n = 0; n < 2; ++n) acc[a][b][m][n] = (f32x4){0.f, 0.f, 0.f, 0.f};
        cur = nxt; cA = nA; cB = nB; ++ui;
        if constexpr (ALIGN_EPI) { if (wr == 1) PG8_BAR; }
    }
    PG8_WAIT_V(0);
    if constexpr (!ALIGN_EPI) { if (wr == 0) PG8_BAR; }
    PG8_BAR;
    if constexpr (Epi::AFTER_DRAIN) { E.fused(acc, cur, wr, wc, fr, fq, lds, wid, lane); S.done(cur); }
#undef PG8_SA
#undef PG8_SB
#undef PG8_STAGE
#undef PG8_LDA
#undef PG8_LDB
#undef PG8_MMA
#undef PG8_WAIT_V
#undef PG8_WAIT_L
#undef PG8_BAR
#undef PG8_SCHED
}

typedef unsigned u32x2 __attribute__((ext_vector_type(2)));
constexpr float RMS_EPS = 1e-6f;
__device__ __forceinline__ float rstd_of(float ss, float inv_n) { return __builtin_amdgcn_rsqf(ss * inv_n + RMS_EPS); }
__device__ __forceinline__ float silu_f(float x) { return x * __builtin_amdgcn_rcpf(1.0f + __builtin_amdgcn_exp2f(-1.4426950408889634f * x)); }

struct EpiSwiglu {
    static constexpr bool PERM = true, AFTER_DRAIN = false, MIDSCALE = false;
    bf16_t* H; const float* ss; int ldh;
    __device__ __forceinline__ void operator()(const f32x4 (&acc)[2][2][4][2], const Unit& u, int wr, int wc, int fr, int fq) const {
        asm volatile("" : "+v"(fr), "+v"(fq), "+s"(wr), "+s"(wc));
        const int row0 = u.pm * BM + wr * 64 + fr, col0 = u.pn * HALF + wc * 32 + 8 * fq;
        float rsv[8];
#pragma unroll
        for (int q = 0; q < 8; ++q) rsv[q] = ss[row0 + (q >> 2) * HALF + (q & 3) * 16];
#pragma unroll
        for (int ai = 0; ai < 2; ++ai)
#pragma unroll
            for (int m = 0; m < 4; ++m) {
                const int row = row0 + ai * HALF + m * 16;
                const float rs = rstd_of(rsv[ai * 4 + m], 1.0f / 1024.0f);
                float o[8];
#pragma unroll
                for (int n = 0; n < 2; ++n)
#pragma unroll
                    for (int j = 0; j < 4; ++j) { const float g = acc[ai][0][m][n][j] * rs, up = acc[ai][1][m][n][j] * rs; o[n * 4 + j] = silu_f(g) * up; }
                u32x4 w; w.x = cvt_pk_bf16(o[0], o[1]); w.y = cvt_pk_bf16(o[2], o[3]); w.z = cvt_pk_bf16(o[4], o[5]); w.w = cvt_pk_bf16(o[6], o[7]);
                *(u32x4*)(H + (size_t)row * ldh + col0) = w;
            }
    }
};

struct EpiRes {
    static constexpr bool PERM = true, AFTER_DRAIN = true, MIDSCALE = false;
    const bf16_t* residh; bf16_t* ob; bf16_t* operm; float* ss; float alpha;
    __device__ __forceinline__ void fused(f32x4 (&acc)[2][2][4][2], const Unit& u, int wr, int wc, int fr, int fq, PG8_LAS unsigned char* lds, int wid, int lane) const {
        PG8_LAS float* Pl = (PG8_LAS float*)lds;
        asm volatile("" : "+v"(fr), "+v"(fq), "+s"(wr), "+s"(wc));
        const int col0 = u.pn * BM + wc * 32 + 8 * fq, s0 = u.pm * BM + wr * 64 + fr;
        u32x4 rh[3][2];
#define EPI_LOADH(q) do { const size_t o_ = (size_t)(s0 + ((q) >> 2) * HALF + ((q) & 3) * 16) * 1024 + col0; \
        _Pragma("unroll") for (int x_ = 0; x_ < 2; ++x_) rh[(q) % 3][x_] = *(const u32x4*)(residh + o_ + x_ * HALF); } while (0)
#define EPI_UNLO(v_) ((f32x4){__builtin_bit_cast(float, (v_).x << 16), __builtin_bit_cast(float, (v_).x & 0xffff0000u), __builtin_bit_cast(float, (v_).y << 16), __builtin_bit_cast(float, (v_).y & 0xffff0000u)})
#define EPI_UNHI(v_) ((f32x4){__builtin_bit_cast(float, (v_).z << 16), __builtin_bit_cast(float, (v_).z & 0xffff0000u), __builtin_bit_cast(float, (v_).w << 16), __builtin_bit_cast(float, (v_).w & 0xffff0000u)})
        EPI_LOADH(0); EPI_LOADH(1);
#pragma unroll
        for (int q = 0; q < 8; ++q) {
            const int ai = q >> 2, m = q & 3;
            if (q + 2 < 8) EPI_LOADH(q + 2);
            const int s = s0 + ai * HALF + m * 16;
            const int t = s + 16, b = t / 164, a = t - b * 164; const size_t nperm = (size_t)(a * 100 + b);
            float ps = 0.f;
#pragma unroll
            for (int bj = 0; bj < 2; ++bj) {
                const int col = col0 + bj * HALF; const size_t off = (size_t)s * 1024 + col;
                const f32x4 o0 = EPI_UNLO(rh[q % 3][bj]) + acc[ai][bj][m][0] * alpha, o1 = EPI_UNHI(rh[q % 3][bj]) + acc[ai][bj][m][1] * alpha;
                ps += ((o0[0] * o0[0] + o0[1] * o0[1]) + (o0[2] * o0[2] + o0[3] * o0[3])) + ((o1[0] * o1[0] + o1[1] * o1[1]) + (o1[2] * o1[2] + o1[3] * o1[3]));
                u32x4 w; w.x = cvt_pk_bf16(o0[0], o0[1]); w.y = cvt_pk_bf16(o0[2], o0[3]); w.z = cvt_pk_bf16(o1[0], o1[1]); w.w = cvt_pk_bf16(o1[2], o1[3]);
                *(u32x4*)(ob + off) = w;
                *(u32x4*)(operm + nperm * 1024 + col) = w;
            }
            ps += __shfl_xor(ps, 16); ps += __shfl_xor(ps, 32); if (fq == 0) Pl[(ai * HALF + wr * 64 + m * 16 + fr) * 4 + wc] = ps;
        }
        asm volatile("s_waitcnt lgkmcnt(0)" ::: "memory"); __syncthreads();
        if (threadIdx.x < 256) { const int row = threadIdx.x; atomicAdd(ss + u.pm * BM + row, (Pl[row * 4 + 0] + Pl[row * 4 + 1]) + (Pl[row * 4 + 2] + Pl[row * 4 + 3])); }
    }
};

struct EpiQKV {
    static constexpr bool PERM = true, AFTER_DRAIN = false, MIDSCALE = false;
    bf16_t* Q; bf16_t* Kb; bf16_t* Vt; const float* ss; const float* qn; const float* kn; int LPv;
    __device__ __forceinline__ void operator()(const f32x4 (&acc)[2][2][4][2], const Unit& u, int wr, int wc, int fr, int fq) const {
        asm volatile("" : "+v"(fr), "+v"(fq), "+s"(wr), "+s"(wc));
        const int hs = 4 * u.pn + wc;
        f32x4 gn[2][2];
        const float* gp = hs < 8 ? qn : kn;
#pragma unroll
        for (int bj = 0; bj < 2; ++bj)
#pragma unroll
            for (int n = 0; n < 2; ++n) gn[bj][n] = *(const f32x4*)(gp + 32 * bj + 8 * fq + 4 * n);
        const float qs = hs < 8 ? 0.125f * 1.4426950408889634f : 1.0f;
        float rsv[8];
#pragma unroll
        for (int q = 0; q < 8; ++q) rsv[q] = ss[u.pm * BM + (q >> 2) * HALF + wr * 64 + (q & 3) * 16 + fr];
#pragma unroll
        for (int ai = 0; ai < 2; ++ai)
#pragma unroll
            for (int m = 0; m < 4; ++m) {
                const int t = u.pm * BM + ai * HALF + wr * 64 + m * 16 + fr;
                const float rs = rstd_of(rsv[ai * 4 + m], 1.0f / 1024.0f);
                f32x4 v[2][2]; float q = 0.f;
#pragma unroll
                for (int bj = 0; bj < 2; ++bj)
#pragma unroll
                    for (int n = 0; n < 2; ++n) { v[bj][n] = acc[ai][bj][m][n] * rs; const f32x4 x = v[bj][n]; q += (x[0] * x[0] + x[1] * x[1]) + (x[2] * x[2] + x[3] * x[3]); }
                q += __shfl_xor(q, 16); q += __shfl_xor(q, 32);
                if (hs < 10) { const float hr = rstd_of(q, 1.0f / 64.0f) * qs;
#pragma unroll
                    for (int bj = 0; bj < 2; ++bj)
#pragma unroll
                        for (int n = 0; n < 2; ++n) v[bj][n] = v[bj][n] * gn[bj][n] * hr; }
#pragma unroll
                for (int bj = 0; bj < 2; ++bj) {
                    const int d = 32 * bj + 8 * fq; const f32x4 x0 = v[bj][0], x1 = v[bj][1];
                    u32x4 w; w.x = cvt_pk_bf16(x0[0], x0[1]); w.y = cvt_pk_bf16(x0[2], x0[3]); w.z = cvt_pk_bf16(x1[0], x1[1]); w.w = cvt_pk_bf16(x1[2], x1[3]);
                    if (hs < 8) *(u32x4*)(Q + (size_t)t * 512 + hs * 64 + d) = w;
                    else if (hs < 10) *(u32x4*)(Kb + (size_t)t * 128 + (hs - 8) * 64 + d) = w;
                    else { bf16_t* vp = Vt + (size_t)((hs - 10) * 64 + d) * LPv + t; const size_t L_ = (size_t)LPv;
                        vp[0] = (bf16_t)(w.x & 0xffffu); vp[L_] = (bf16_t)(w.x >> 16); vp[2 * L_] = (bf16_t)(w.y & 0xffffu); vp[3 * L_] = (bf16_t)(w.y >> 16);
                        vp[4 * L_] = (bf16_t)(w.z & 0xffffu); vp[5 * L_] = (bf16_t)(w.z >> 16); vp[6 * L_] = (bf16_t)(w.w & 0xffffu); vp[7 * L_] = (bf16_t)(w.w >> 16); }
                }
            }
    }
};

struct EpiG0 {
    static constexpr bool PERM = true, AFTER_DRAIN = false, MIDSCALE = false;
    bf16_t* X; const float* ss;
    __device__ __forceinline__ void operator()(const f32x4 (&acc)[2][2][4][2], const Unit& u, int wr, int wc, int fr, int fq) const {
        asm volatile("" : "+v"(fr), "+v"(fq), "+s"(wr), "+s"(wc));
        const int part = u.pm >> 1;
#pragma unroll
        for (int bj = 0; bj < 2; ++bj) {
            const int nn = u.pn * BM + bj * HALF + wc * 32 + 8 * fq;
            if (nn >= 16400) continue;
            const int a = nn / 100, b = nn - a * 100;
            const bool cross = b == 96;
            const int a1 = cross ? a + 1 : a, b1 = cross ? 0 : b + 4;
            f32x4 rs0, rs1;
#pragma unroll
            for (int j = 0; j < 4; ++j) { rs0[j] = rstd_of(ss[a + 164 * (b + j)], 1.0f / 1024.0f); rs1[j] = rstd_of(ss[a1 + 164 * (b1 + j)], 1.0f / 1024.0f); }
#pragma unroll
            for (int ai = 0; ai < 2; ++ai)
#pragma unroll
                for (int m = 0; m < 4; ++m) {
                    const int c = ((u.pm & 1) * BM) + ai * HALF + wr * 64 + m * 16 + fr;
                    const f32x4 x0 = acc[ai][bj][m][0] * rs0, x1 = acc[ai][bj][m][1] * rs1;
                    const unsigned w0 = cvt_pk_bf16(x0[0], x0[1]), w1 = cvt_pk_bf16(x0[2], x0[3]), w2 = cvt_pk_bf16(x1[0], x1[1]), w3 = cvt_pk_bf16(x1[2], x1[3]);
                    bf16_t* p = X + ((size_t)(c * 164 + a) * 2 + part) * 128 + b;
                    if (!cross) *(u32x4*)p = (u32x4){w0, w1, w2, w3};
                    else {
                        *(u32x2*)p = (u32x2){w0, w1};
#pragma unroll
                        for (int z = 1; z < 8; ++z) *(u32x2*)(p + 4 * z) = (u32x2){0u, 0u};
                        *(u32x2*)(X + ((size_t)(c * 164 + a + 1) * 2 + part) * 128) = (u32x2){w2, w3};
                    }
                }
        }
    }
};

struct EpiG1 {
    static constexpr bool PERM = true, AFTER_DRAIN = false, MIDSCALE = false;
    bf16_t* X1;
    __device__ __forceinline__ void operator()(const f32x4 (&acc)[2][2][4][2], const Unit& u, int wr, int wc, int fr, int fq) const {
        asm volatile("" : "+v"(fr), "+v"(fq), "+s"(wr), "+s"(wc));
#pragma unroll
        for (int m = 0; m < 4; ++m) {
            const int beta = wr * 64 + m * 16 + fr;
            if (beta >= 100) continue;
            const float cd = __builtin_amdgcn_cosf((float)beta * (1.0f / 16400.0f)), sd = __builtin_amdgcn_sinf((float)beta * (1.0f / 16400.0f));
#pragma unroll
            for (int bj = 0; bj < 2; ++bj) {
                const int n1 = u.pn * BM + bj * HALF + wc * 32 + 8 * fq;
                const int c = n1 / 164, a0 = n1 - c * 164;
                const bool cross = a0 == 160;
                float cs = __builtin_amdgcn_cosf((float)(a0 * beta) * (1.0f / 16400.0f)), sn = __builtin_amdgcn_sinf((float)(a0 * beta) * (1.0f / 16400.0f));
                unsigned wre[4], wim[4];
#pragma unroll
                for (int n = 0; n < 2; ++n) {
                    const f32x4 re = acc[0][bj][m][n], im = acc[1][bj][m][n];
                    f32x4 ore, oim;
                    if (n == 1 && cross) { cs = 1.0f; sn = 0.0f; }
#pragma unroll
                    for (int j = 0; j < 4; ++j) {
                        ore[j] = re[j] * cs + im[j] * sn; oim[j] = im[j] * cs - re[j] * sn;
                        const float c2 = cs * cd - sn * sd; sn = sn * cd + cs * sd; cs = c2;
                    }
                    wre[2 * n] = cvt_pk_bf16(ore[0], ore[1]); wre[2 * n + 1] = cvt_pk_bf16(ore[2], ore[3]);
                    wim[2 * n] = cvt_pk_bf16(oim[0], oim[1]); wim[2 * n + 1] = cvt_pk_bf16(oim[2], oim[3]);
                }
                bf16_t* p = X1 + ((size_t)(beta * 512 + c) * 2) * 192 + a0;
                if (!cross) {
                    *(u32x4*)p = (u32x4){wre[0], wre[1], wre[2], wre[3]};
                    *(u32x4*)(p + 192) = (u32x4){wim[0], wim[1], wim[2], wim[3]};
                } else {
                    *(u32x2*)p = (u32x2){wre[0], wre[1]}; *(u32x2*)(p + 192) = (u32x2){wim[0], wim[1]};
#pragma unroll
                    for (int z = 1; z < 8; ++z) { *(u32x2*)(p + 4 * z) = (u32x2){0u, 0u}; *(u32x2*)(p + 192 + 4 * z) = (u32x2){0u, 0u}; }
                    bf16_t* p2 = X1 + ((size_t)(beta * 512 + c + 1) * 2) * 192;
                    *(u32x2*)p2 = (u32x2){wre[2], wre[3]}; *(u32x2*)(p2 + 192) = (u32x2){wim[2], wim[3]};
                }
            }
        }
    }
};

struct EpiG3 {
    static constexpr bool PERM = true, AFTER_DRAIN = false, MIDSCALE = false;
    bf16_t* MX; float* ssF;
    __device__ __forceinline__ void operator()(const f32x4 (&acc)[2][2][4][2], const Unit& u, int wr, int wc, int fr, int fq) const {
        asm volatile("" : "+v"(fr), "+v"(fq), "+s"(wr), "+s"(wc));
        const int beta = u.pn >> 1, cb = (u.pn & 1) * BM + wc * 32 + 8 * fq;
#pragma unroll
        for (int ai = 0; ai < 2; ++ai)
#pragma unroll
            for (int m = 0; m < 4; ++m) {
                const int alpha = ai * HALF + wr * 64 + m * 16 + fr;
                const int s = 100 * alpha + beta - 16;
                const bool ok = alpha < 164 && s >= 0;
                float ps = 0.f;
#pragma unroll
                for (int bj = 0; bj < 2; ++bj) {
                    const f32x4 x0 = acc[ai][bj][m][0], x1 = acc[ai][bj][m][1];
                    ps += ((x0[0] * x0[0] + x0[1] * x0[1]) + (x0[2] * x0[2] + x0[3] * x0[3])) + ((x1[0] * x1[0] + x1[1] * x1[1]) + (x1[2] * x1[2] + x1[3] * x1[3]));
                    if (ok) { u32x4 w; w.x = cvt_pk_bf16(x0[0], x0[1]); w.y = cvt_pk_bf16(x0[2], x0[3]); w.z = cvt_pk_bf16(x1[0], x1[1]); w.w = cvt_pk_bf16(x1[2], x1[3]);
                        *(u32x4*)(MX + (size_t)s * 1024 + 512 + cb + bj * HALF) = w; }
                }
                ps += __shfl_xor(ps, 16); ps += __shfl_xor(ps, 32);
                if (ok && fq == 0) atomicAdd(ssF + beta * 164 + alpha, ps);
            }
    }
};

struct EpiResMix {
    static constexpr bool PERM = true, AFTER_DRAIN = true, MIDSCALE = true;
    const bf16_t* residh; bf16_t* ob; float* ss; const float* ssA; const float* ssF;
    __device__ __forceinline__ void mid(f32x4 (&acc)[2][2][4][2], const Unit& u, int wr, int wc, int fr, int fq) const {
        asm volatile("" : "+v"(fr), "+s"(wr));
        const int s0 = u.pm * BM + wr * 64 + fr;
        float va[8], vf[8];
#pragma unroll
        for (int q = 0; q < 8; ++q) { const int s_ = s0 + (q >> 2) * HALF + (q & 3) * 16, al_ = (s_ + 16) / 100; va[q] = ssA[s_]; vf[q] = ssF[(s_ + 16 - 100 * al_) * 164 + al_]; }
#pragma unroll
        for (int q = 0; q < 8; ++q) {
            const float ratio = rstd_of(va[q], 1.0f / 512.0f) * __builtin_amdgcn_rcpf(rstd_of(vf[q], 1.0f / 512.0f));
#pragma unroll
            for (int bj = 0; bj < 2; ++bj)
#pragma unroll
                for (int n = 0; n < 2; ++n) acc[q >> 2][bj][q & 3][n] = acc[q >> 2][bj][q & 3][n] * ratio;
        }
    }
    __device__ __forceinline__ void fused(f32x4 (&acc)[2][2][4][2], const Unit& u, int wr, int wc, int fr, int fq, PG8_LAS unsigned char* lds, int wid, int lane) const {
        PG8_LAS float* Pl = (PG8_LAS float*)lds;
        asm volatile("" : "+v"(fr), "+v"(fq), "+s"(wr), "+s"(wc));
        const int col0 = u.pn * BM + wc * 32 + 8 * fq, s0 = u.pm * BM + wr * 64 + fr;
        float vf[8];
#pragma unroll
        for (int q = 0; q < 8; ++q) { const int s_ = s0 + (q >> 2) * HALF + (q & 3) * 16, al_ = (s_ + 16) / 100; vf[q] = ssF[(s_ + 16 - 100 * al_) * 164 + al_]; }
        u32x4 rh[3][2];
        EPI_LOADH(0); EPI_LOADH(1);
#pragma unroll
        for (int q = 0; q < 8; ++q) {
            const int ai = q >> 2, m = q & 3;
            if (q + 2 < 8) EPI_LOADH(q + 2);
            const int s = s0 + ai * HALF + m * 16;
            const float rf = rstd_of(vf[q], 1.0f / 512.0f);
            float ps = 0.f;
#pragma unroll
            for (int bj = 0; bj < 2; ++bj) {
                const size_t off = (size_t)s * 1024 + col0 + bj * HALF;
                const f32x4 o0 = EPI_UNLO(rh[q % 3][bj]) + acc[ai][bj][m][0] * rf, o1 = EPI_UNHI(rh[q % 3][bj]) + acc[ai][bj][m][1] * rf;
                ps += ((o0[0] * o0[0] + o0[1] * o0[1]) + (o0[2] * o0[2] + o0[3] * o0[3])) + ((o1[0] * o1[0] + o1[1] * o1[1]) + (o1[2] * o1[2] + o1[3] * o1[3]));
                u32x4 w; w.x = cvt_pk_bf16(o0[0], o0[1]); w.y = cvt_pk_bf16(o0[2], o0[3]); w.z = cvt_pk_bf16(o1[0], o1[1]); w.w = cvt_pk_bf16(o1[2], o1[3]);
                *(u32x4*)(ob + off) = w;
            }
            ps += __shfl_xor(ps, 16); ps += __shfl_xor(ps, 32); if (fq == 0) Pl[(ai * HALF + wr * 64 + m * 16 + fr) * 4 + wc] = ps;
        }
        asm volatile("s_waitcnt lgkmcnt(0)" ::: "memory"); __syncthreads();
        if (threadIdx.x < 256) { const int row = threadIdx.x; atomicAdd(ss + u.pm * BM + row, (Pl[row * 4 + 0] + Pl[row * 4 + 1]) + (Pl[row * 4 + 2] + Pl[row * 4 + 3])); }
    }
};


struct EpiResFinal {
    static constexpr bool PERM = true, AFTER_DRAIN = true, MIDSCALE = false;
    const bf16_t* residh; float* out; float* ss; unsigned* cnt; const float* gain; float alpha;
    __device__ __forceinline__ void fused(f32x4 (&acc)[2][2][4][2], const Unit& u, int wr, int wc, int fr, int fq, PG8_LAS unsigned char* lds, int wid, int lane) const {
        const int col0 = u.pn * BM + wc * 32 + 8 * fq, s0 = u.pm * BM + wr * 64 + fr;
        PG8_LAS float* Pl = (PG8_LAS float*)lds; PG8_LAS float* Tl = (PG8_LAS float*)(lds + 4096);
        u32x4 rh[3][2];
        EPI_LOADH(0); EPI_LOADH(1);
#pragma unroll
        for (int q = 0; q < 8; ++q) {
            const int ai = q >> 2, m = q & 3;
            if (q + 2 < 8) EPI_LOADH(q + 2);
            float ps = 0.f;
#pragma unroll
            for (int bj = 0; bj < 2; ++bj) {
                const f32x4 o0 = EPI_UNLO(rh[q % 3][bj]) + acc[ai][bj][m][0] * alpha, o1 = EPI_UNHI(rh[q % 3][bj]) + acc[ai][bj][m][1] * alpha;
                acc[ai][bj][m][0] = o0; acc[ai][bj][m][1] = o1;
                ps += ((o0[0] * o0[0] + o0[1] * o0[1]) + (o0[2] * o0[2] + o0[3] * o0[3])) + ((o1[0] * o1[0] + o1[1] * o1[1]) + (o1[2] * o1[2] + o1[3] * o1[3]));
            }
            ps += __shfl_xor(ps, 16); ps += __shfl_xor(ps, 32);
            if (fq == 0) Pl[(ai * HALF + wr * 64 + m * 16 + fr) * 4 + wc] = ps;
        }
        asm volatile("s_waitcnt lgkmcnt(0)" ::: "memory"); __syncthreads();
        if (threadIdx.x < 256) {
            const int row = threadIdx.x;
            const float part = (Pl[row * 4 + 0] + Pl[row * 4 + 1]) + (Pl[row * 4 + 2] + Pl[row * 4 + 3]);
            unsigned* sl = (unsigned*)ss + ((size_t)u.pm * 4) * 256 + row;
            __hip_atomic_store(sl + u.pn * 256, __builtin_bit_cast(unsigned, part) | 1u, __ATOMIC_RELAXED, __HIP_MEMORY_SCOPE_AGENT);
            float pv[4];
#pragma unroll
            for (int p2 = 0; p2 < 4; ++p2) { unsigned v = __builtin_bit_cast(unsigned, part) | 1u, spins = 0u;
                if (p2 != u.pn) { while ((v = __hip_atomic_load(sl + p2 * 256, __ATOMIC_RELAXED, __HIP_MEMORY_SCOPE_AGENT)) == 0u && ++spins < (1u << 20)) __builtin_amdgcn_s_sleep(1); }
                pv[p2] = __builtin_bit_cast(float, v); }
            const float tot = (pv[0] + pv[1]) + (pv[2] + pv[3]);
            Tl[row] = rstd_of(tot, 1.0f / 1024.0f);
        }
        asm volatile("s_waitcnt vmcnt(0) lgkmcnt(0)" ::: "memory"); __syncthreads();
        f32x4 gv[2][2];
#pragma unroll
        for (int bj = 0; bj < 2; ++bj)
#pragma unroll
            for (int n = 0; n < 2; ++n) gv[bj][n] = *(const f32x4*)(gain + col0 + bj * HALF + 4 * n);
#pragma unroll
        for (int q = 0; q < 8; ++q) {
            const int ai = q >> 2, m = q & 3; const int s = s0 + ai * HALF + m * 16;
            const float rs = Tl[ai * HALF + wr * 64 + m * 16 + fr];
#pragma unroll
            for (int bj = 0; bj < 2; ++bj)
#pragma unroll
                for (int n = 0; n < 2; ++n) *(f32x4*)(out + (size_t)s * 1024 + col0 + bj * HALF + 4 * n) = acc[ai][bj][m][n] * rs * gv[bj][n];
        }
    }
};
#undef EPI_LOADH
#undef EPI_UNLO
#undef EPI_UNHI
}

constexpr int NWAVES = 8;
constexpr int DM = 1024, LTOK = 16400, LP = 16640, SEQ = 16384, NMETA = 16, FF = 2816;
constexpr size_t MiB = 1u << 20;
constexpr size_t WS_CTL = 0, CTL_BYTES = MiB;
constexpr size_t CT_SS1 = 0, CT_SS2 = 128 * 1024, CT_MACC = 256 * 1024, CT_MCNT = 384 * 1024, CT_BAR = 512 * 1024, CT_TIX = 640 * 1024, CT_SSA = 768 * 1024, CT_SSF = 832 * 1024, CT_PCNT = 900 * 1024, CT_SS3 = 920 * 1024;
constexpr int MISC_OFF = 147456 - 256;
constexpr size_t WS_SS0 = 1 * MiB, WS_A1 = 1 * MiB + 128 * 1024, WS_A3 = 1 * MiB + 256 * 1024, WS_SLOT = 1 * MiB + 512 * 1024;
constexpr size_t WS_WGU1 = 2 * MiB, WS_WD1 = 13 * MiB, WS_WQKV = 19 * MiB, WS_WG = 21 * MiB, WS_WOUT = 23 * MiB, WS_WGU2 = 25 * MiB, WS_WD2 = 36 * MiB;
constexpr size_t WS_HID = 48 * MiB, WS_X = 48 * MiB, WS_X1 = 92 * MiB;
constexpr size_t WS_XB = 144 * MiB;
constexpr size_t WS_Q = 178 * MiB, WS_K = 195 * MiB, WS_VT = 200 * MiB;
constexpr size_t WS_Y = 178 * MiB, WS_H2B = 178 * MiB;
constexpr size_t WS_PERM = 212 * MiB, WS_O = 212 * MiB;
constexpr size_t WS_END = 246 * MiB;
constexpr int LDS_BYTES = 147456;

#define LAS __attribute__((address_space(3)))
typedef unsigned short bf16;
typedef unsigned v4u __attribute__((ext_vector_type(4)));
typedef unsigned v2u __attribute__((ext_vector_type(2)));
typedef float f32x4 __attribute__((ext_vector_type(4)));
typedef short bf16x8 __attribute__((ext_vector_type(8)));
#define LDS_WAIT() asm volatile("s_waitcnt lgkmcnt(0)" ::: "memory")
__device__ __forceinline__ unsigned f2bf(float f) { unsigned u = __builtin_bit_cast(unsigned, f); return (u + 0x7fffu + ((u >> 16) & 1u)) >> 16; }
__device__ __forceinline__ unsigned pk2(float lo, float hi) { return f2bf(lo) | (f2bf(hi) << 16); }
__device__ __forceinline__ float bf2f(unsigned h) { return __builtin_bit_cast(float, h << 16); }
__device__ __forceinline__ float wave_sum(float v) {
#pragma unroll
    for (int o = 1; o < 64; o <<= 1) v += __shfl_xor(v, o);
    return v;
}
__device__ __forceinline__ float wave_max(float v) {
#pragma unroll
    for (int o = 1; o < 64; o <<= 1) v = fmaxf(v, __shfl_xor(v, o));
    return v;
}

struct Args { const float* in[19]; float* out; unsigned char* ws; };

#define XB_TMO      128
#define XB_XCNT(j)  (256  + 64 * (j))
#define XB_XSUB(j)  (1280 + 64 * (j))
#define XB_XGEN(j)  (2304 + 64 * (j))
#define XB_TOP      3328
#define XB_TOPGEN   3392
#define XCD_BAR_WORDS 3456
#define XB_SPIN_CAP (1u << 18)

__device__ __forceinline__ unsigned xb_ld(unsigned* p)              { return __hip_atomic_load(p, __ATOMIC_RELAXED, __HIP_MEMORY_SCOPE_AGENT); }
__device__ __forceinline__ unsigned xb_add(unsigned* p, unsigned v) { return __hip_atomic_fetch_add(p, v, __ATOMIC_RELAXED, __HIP_MEMORY_SCOPE_AGENT); }
__device__ __forceinline__ unsigned xb_xcc_id() { return (unsigned)__builtin_amdgcn_s_getreg((3 << 11) | 20) & 0xFu; }
#define XB_SPIN(cond, bar) do { unsigned _sp = 0; while (cond) { __builtin_amdgcn_s_sleep(1); \
    if ((++_sp & 255u) == 0u) { if (xb_ld(&(bar)[XB_TMO])) break; if (_sp > XB_SPIN_CAP) { atomicAdd(&(bar)[XB_TMO], 1u); break; } } } } while (0)

struct XcdBarrier {
    unsigned* bar; unsigned x;
    volatile LAS unsigned* st;
};

__device__ __forceinline__ XcdBarrier xcd_barrier_post(unsigned* bar, volatile LAS unsigned* st) {
    XcdBarrier b; b.bar = bar; b.x = xb_xcc_id(); b.st = st;
    if (threadIdx.x == 0) (void)xb_add(&bar[XB_XCNT(b.x)], 1u);
    return b;
}
__device__ __forceinline__ void xcd_barrier_complete(unsigned* bar, unsigned x, unsigned& nloc, unsigned& nx) {
    const unsigned G = gridDim.x * gridDim.y * gridDim.z;
    unsigned sum, cnt, mine, sp = 0u;
    for (;;) {
        sum = 0u; cnt = 0u; mine = 0u;
#pragma unroll
        for (unsigned j = 0; j < 16; ++j) { const unsigned c = xb_ld(&bar[XB_XCNT(j)]); sum += c; cnt += (c > 0u) ? 1u : 0u; mine = (j == x) ? c : mine; }
        if (sum == G) break;
        __builtin_amdgcn_s_sleep(1);
        if ((++sp & 255u) == 0u) { if (xb_ld(&bar[XB_TMO])) break; if (sp > XB_SPIN_CAP) { atomicAdd(&bar[XB_TMO], 1u); break; } }
    }
    nloc = mine > 0u ? mine : 1u; nx = cnt > 0u ? cnt : 1u;
}

__device__ __forceinline__ void xcd_barrier(const XcdBarrier& b) {
    asm volatile("s_waitcnt vmcnt(0)" ::: "memory");
    __syncthreads();
    if (threadIdx.x == 0) {
        unsigned* bar = b.bar;
        __builtin_amdgcn_s_waitcnt(0);
        unsigned nloc = b.st[0], nx = b.st[1];
        if (nloc == 0u) { xcd_barrier_complete(bar, b.x, nloc, nx); b.st[0] = nloc; b.st[1] = nx; }
        const unsigned old = xb_add(&bar[XB_XSUB(b.x)], 1u);
        const unsigned gen = old / nloc;
        if (old + 1u == (gen + 1u) * nloc) {
            __builtin_amdgcn_fence(__ATOMIC_RELEASE, "agent");
            asm volatile("s_waitcnt vmcnt(0)" ::: "memory");
            const unsigned og = xb_add(&bar[XB_TOP], 1u);
            const unsigned tg = og / nx;
            if (og + 1u == (tg + 1u) * nx) xb_add(&bar[XB_TOPGEN], 1u);
            else XB_SPIN(xb_ld(&bar[XB_TOPGEN]) == tg, bar);
            __builtin_amdgcn_fence(__ATOMIC_ACQUIRE, "agent");
            xb_add(&bar[XB_XGEN(b.x)], 1u);
            asm volatile("s_waitcnt vmcnt(0)" ::: "memory");
        } else {
            XB_SPIN(xb_ld(&bar[XB_XGEN(b.x)]) == gen, bar);
            __builtin_amdgcn_fence(__ATOMIC_ACQUIRE, "agent");
            asm volatile("s_waitcnt vmcnt(0)" ::: "memory");
        }
    }
    __syncthreads();
}


__device__ __forceinline__ int dest_row(int mode, int n, int bj) {
    if (mode == 1) return 256 * (n >> 7) + 128 * bj + (n & 127);
    if (mode == 2) { const int hs = n >> 6, dd = n & 63; return 256 * (hs >> 2) + 128 * (dd >> 5) + 32 * (hs & 3) + (dd & 31); }
    return n;
}
#define TR_VARS(P) const float* P##W = nullptr; const float* P##gain = nullptr; bf16* P##WT = nullptr; int P##ldw = 0, P##K = 0, P##mode = 0, P##bj = 0, P##k0 = 0, P##n0 = 0
#define TR_SET(P, w_, g_, wt_, ldw_, K_, mode_, bj_, kb_, nb_) do { P##W = (w_); P##gain = (g_); P##WT = (bf16*)(wt_); P##ldw = (ldw_); P##K = (K_); P##mode = (mode_); P##bj = (bj_); P##k0 = 64 * (kb_); P##n0 = 64 * (nb_); } while (0)
#define TR_DECODE(P, it_) do { constexpr int I_GU = 16 * 44, I_DN = 44 * 16, I_QKV = 16 * 12; int r = (it_); \
    if (r < I_GU) { TR_SET(P, a.in[3], a.in[2], ws + WS_WGU1, FF, DM, 1, 0, r / 44, r % 44); break; } r -= I_GU; \
    if (r < I_GU) { TR_SET(P, a.in[4], a.in[2], ws + WS_WGU1, FF, DM, 1, 1, r / 44, r % 44); break; } r -= I_GU; \
    if (r < I_QKV) { TR_SET(P, a.in[7], a.in[6], ws + WS_WQKV, 1280, DM, 2, 0, r / 12, r % 12); break; } r -= I_QKV; \
    if (r < I_DN) { TR_SET(P, a.in[5], (const float*)nullptr, ws + WS_WD1, DM, FF, 0, 0, r / 16, r % 16); break; } r -= I_DN; \
    if (r < I_GU) { TR_SET(P, a.in[15], a.in[14], ws + WS_WGU2, FF, DM, 1, 0, r / 44, r % 44); break; } r -= I_GU; \
    if (r < I_GU) { TR_SET(P, a.in[16], a.in[14], ws + WS_WGU2, FF, DM, 1, 1, r / 44, r % 44); break; } r -= I_GU; \
    if (r < I_DN) { TR_SET(P, a.in[17], (const float*)nullptr, ws + WS_WD2, DM, FF, 0, 0, r / 16, r % 16); break; } r -= I_DN; \
    TR_SET(P, a.in[13], (r / 16) < 8 ? a.in[11] : a.in[12] - 512, ws + WS_WOUT, DM, DM, 0, 0, r / 16, r % 16); } while (0)
#define TR_LOAD(P, v) do { _Pragma("unroll") for (int i = 0; i < 16; ++i) { const int kk = 4 * i + (lane >> 4); \
        f32x4 x = __builtin_nontemporal_load((const f32x4*)(P##W + (size_t)(P##k0 + kk) * P##ldw + P##n0 + 4 * (lane & 15))); if (P##gain) x = x * P##gain[P##k0 + kk]; v[i] = x; } } while (0)
#define TR_FINISH(P, v) do { _Pragma("unroll") for (int i = 0; i < 16; ++i) { LAS float* w_ = scr + (4 * i + (lane >> 4)) * 65 + 4 * (lane & 15); w_[0] = v[i].x; w_[1] = v[i].y; w_[2] = v[i].z; w_[3] = v[i].w; } \
    LDS_WAIT(); asm volatile("" ::: "memory"); \
    _Pragma("unroll") for (int j = 0; j < 8; ++j) { const int n = (lane >> 3) + 8 * j; const LAS float* s_ = scr + (8 * (lane & 7)) * 65 + n; \
        v4u o; o.x = pk2(s_[0 * 65], s_[1 * 65]); o.y = pk2(s_[2 * 65], s_[3 * 65]); o.z = pk2(s_[4 * 65], s_[5 * 65]); o.w = pk2(s_[6 * 65], s_[7 * 65]); \
        *(v4u*)(P##WT + (size_t)dest_row(P##mode, P##n0 + n, P##bj) * P##K + P##k0 + 8 * (lane & 7)) = o; } \
    LDS_WAIT(); asm volatile("" ::: "memory"); } while (0)
__device__ __forceinline__ void wg_item(const float* Win, const float* gmix, bf16* WG, int g, int dq, int lane) {
    float re[4], im[4], gm[4];
#pragma unroll
    for (int dd = 0; dd < 4; ++dd) { re[dd] = 0.f; im[dd] = 0.f; gm[dd] = gmix[4 * dq + dd] * 0.125f; }
    const float* wrow = Win + (size_t)(4 * dq) * 1280 + 768 + 64 * g;
#pragma unroll 16
    for (int j = 0; j < 64; ++j) {
        const float ph = (float)((j * lane) & 63) * (1.0f / 64.0f);
        const float c = __builtin_amdgcn_cosf(ph), sn = __builtin_amdgcn_sinf(ph);
#pragma unroll
        for (int dd = 0; dd < 4; ++dd) { const float w = wrow[dd * 1280 + j]; re[dd] += w * c; im[dd] -= w * sn; }
    }
    *(v2u*)(WG + (size_t)(64 * g + lane) * 1024 + 4 * dq) = (v2u){pk2(re[0] * gm[0], re[1] * gm[1]), pk2(re[2] * gm[2], re[3] * gm[3])};
    *(v2u*)(WG + (size_t)(512 + 64 * g + lane) * 1024 + 4 * dq) = (v2u){pk2(im[0] * gm[0], im[1] * gm[1]), pk2(im[2] * gm[2], im[3] * gm[3])};
}

#define TR_RUN(it0_, stride_, itend_) do { f32x4 vA[16], vB[16]; TR_VARS(A_); TR_VARS(B_); \
        int it = (it0_); \
        if (it < (itend_)) { TR_DECODE(A_, it); TR_LOAD(A_, vA); } \
        while (it < (itend_)) { \
            const int it2 = it + (stride_); \
            if (it2 < (itend_)) { TR_DECODE(B_, it2); TR_LOAD(B_, vB); } \
            TR_FINISH(A_, vA); \
            if (it2 >= (itend_)) break; \
            const int it3 = it2 + (stride_); \
            if (it3 < (itend_)) { TR_DECODE(A_, it3); TR_LOAD(A_, vA); } \
            TR_FINISH(B_, vB); \
            it = it3; } } while (0)
__device__ __forceinline__ void late_weights(const Args& a, LAS unsigned char* lds, int first, int last, int widx, int nw, int lane, int wave) {
    unsigned char* ws = a.ws;
    LAS float* scr = (LAS float*)(lds + wave * 17408);
    TR_RUN(first + widx, nw, last);
}
constexpr int TR_N0 = 2 * (16 * 44), TR_N1 = TR_N0 + 16 * 12 + 44 * 16, TR_N = TR_N1 + 2 * (16 * 44) + 44 * 16 + 16 * 16;
__device__ __forceinline__ void p0_prologue(const Args& a, LAS unsigned char* lds, int tid, int lane, int wave) {
    unsigned char* ws = a.ws;
    LAS float* scr = (LAS float*)(lds + wave * 17408);
    const int gw = blockIdx.x * NWAVES + wave, NGW = gridDim.x * NWAVES;
    TR_RUN(gw, NGW, TR_N0);
    for (int it = gw; it < 2048; it += NGW) wg_item(a.in[7], a.in[6], (bf16*)(ws + WS_WG), it >> 8, it & 255, lane);
    {
        bf16* A1 = (bf16*)(ws + WS_A1); bf16* A3 = (bf16*)(ws + WS_A3);
        const int gt = gw * 64 + lane, NGT = NGW * 64;
        for (int e = gt; e < 256 * 256 + 256 * 384; e += NGT) {
            if (e < 65536) {
                const int rr = e >> 8, kk = e & 255, ai = rr >> 7, beta = rr & 127, part = kk >> 7, b = kk & 127; float v = 0.f;
                if (beta < 100 && b < 100) { const float ph = (float)((beta * b) % 100) * 0.01f; const float c = __builtin_amdgcn_cosf(ph) * 0.1f, s = __builtin_amdgcn_sinf(ph) * 0.1f;
                    v = ai == 0 ? (part == 0 ? c : s) : (part == 0 ? -s : c); }
                A1[e] = (bf16)f2bf(v);
            } else {
                const int e3 = e - 65536, al = e3 / 384, kk = e3 - al * 384, part = kk >= 192 ? 1 : 0, aa = kk - 192 * part; float v = 0.f;
                if (al < 164 && aa < 164) { const float ph = (float)((al * aa) % 164) * (1.0f / 164.0f); const float sc = 0.07808688094430304f;
                    v = (part == 0 ? __builtin_amdgcn_cosf(ph) : __builtin_amdgcn_sinf(ph)) * sc; }
                A3[e3] = (bf16)f2bf(v);
            }
        }
        v4u* pz = (v4u*)((bf16*)(ws + WS_PERM) + (size_t)LTOK * DM);
        for (int e = gt; e < (LP - LTOK) * DM / 8; e += NGT) pz[e] = (v4u){0u, 0u, 0u, 0u};
        v4u* ps_ = (v4u*)(ws + WS_SLOT);
        for (int e = gt; e < 256 * 1024 / 16; e += NGT) ps_[e] = (v4u){0u, 0u, 0u, 0u};
    }
    {
        bf16* xb = (bf16*)(ws + WS_XB); float* ss0 = (float*)(ws + WS_SS0);
#define XB_LOAD(V, T0) do { _Pragma("unroll") for (int r = 0; r < 4; ++r) { const int t = (T0) + r; \
            const float* src = t < NMETA ? a.in[1] + (size_t)t * DM : a.in[0] + (size_t)(t - NMETA) * DM; \
            _Pragma("unroll") for (int j = 0; j < 4; ++j) V[r][j] = t < LTOK ? __builtin_nontemporal_load((const f32x4*)src + lane + 64 * j) : (f32x4){0.f, 0.f, 0.f, 0.f}; } } while (0)
#define XB_FINISH(V, T0) do { float q[4]; \
            _Pragma("unroll") for (int r = 0; r < 4; ++r) { float s_ = 0.f; \
                _Pragma("unroll") for (int j = 0; j < 4; ++j) s_ += (V[r][j].x * V[r][j].x + V[r][j].y * V[r][j].y) + (V[r][j].z * V[r][j].z + V[r][j].w * V[r][j].w); q[r] = s_; } \
            _Pragma("unroll") for (int o = 1; o < 64; o <<= 1) { _Pragma("unroll") for (int r = 0; r < 4; ++r) q[r] += __shfl_xor(q[r], o); } \
            _Pragma("unroll") for (int r = 0; r < 4; ++r) { const int t = (T0) + r; if (lane == 0) ss0[t] = q[r]; \
                v2u* o8 = (v2u*)(xb + (size_t)t * DM) + lane; \
                _Pragma("unroll") for (int j = 0; j < 4; ++j) o8[64 * j] = (v2u){pk2(V[r][j].x, V[r][j].y), pk2(V[r][j].z, V[r][j].w)}; } } while (0)
        f32x4 va[4][4], vb4[4][4];
        int t0 = 4 * gw;
        if (t0 < LP) XB_LOAD(va, t0);
        while (t0 < LP) {
            const int t1 = t0 + 4 * NGW;
            if (t1 < LP) XB_LOAD(vb4, t1);
            XB_FINISH(va, t0);
            if (t1 >= LP) break;
            const int t2 = t1 + 4 * NGW;
            if (t2 < LP) XB_LOAD(va, t2);
            XB_FINISH(vb4, t1);
            t0 = t2;
        }
#undef XB_LOAD
#undef XB_FINISH
    }
}

__device__ __forceinline__ void meta_down(const Args& a, LAS unsigned char* lds, int tid, int lane, int wave) {
    unsigned char* ws = a.ws;
    const int cgp = blockIdx.x & 15, kq = (blockIdx.x >> 4) & 15, n0 = 64 * cgp, kbase = 176 * kq;
    LAS float* hk = (LAS float*)lds; LAS float* red = (LAS float*)(lds + 16384); LAS unsigned* flag = (LAS unsigned*)(lds + 16384 + 32768);
    const bf16* HID = (const bf16*)(ws + WS_HID);
    float* macc = (float*)(ws + WS_CTL + CT_MACC); unsigned* mcnt = (unsigned*)(ws + WS_CTL + CT_MCNT); float* ss1 = (float*)(ws + WS_CTL + CT_SS1);
    if (tid < 16 * 22) { const int r = tid / 22, k8 = (tid - r * 22) * 8; const v4u w = *(const v4u*)(HID + (size_t)r * FF + kbase + k8);
        hk[(k8 + 0) * 16 + r] = bf2f(w.x & 0xffffu); hk[(k8 + 1) * 16 + r] = bf2f(w.x >> 16); hk[(k8 + 2) * 16 + r] = bf2f(w.y & 0xffffu); hk[(k8 + 3) * 16 + r] = bf2f(w.y >> 16);
        hk[(k8 + 4) * 16 + r] = bf2f(w.z & 0xffffu); hk[(k8 + 5) * 16 + r] = bf2f(w.z >> 16); hk[(k8 + 6) * 16 + r] = bf2f(w.w & 0xffffu); hk[(k8 + 7) * 16 + r] = bf2f(w.w >> 16); }
    const float* wp = a.in[5] + (size_t)(kbase + 22 * wave) * DM + n0 + lane;
    float wv[22];
#pragma unroll
    for (int k = 0; k < 22; ++k) wv[k] = wp[(size_t)k * DM];
    __syncthreads();
    float acc[16];
#pragma unroll
    for (int r = 0; r < 16; ++r) acc[r] = 0.f;
#pragma unroll
    for (int k = 0; k < 22; ++k) {
        const float w = wv[k]; const LAS f32x4* h = (const LAS f32x4*)(hk + (22 * wave + k) * 16);
        const f32x4 h0 = h[0], h1 = h[1], h2 = h[2], h3 = h[3];
        acc[0] += w * h0.x; acc[1] += w * h0.y; acc[2] += w * h0.z; acc[3] += w * h0.w; acc[4] += w * h1.x; acc[5] += w * h1.y; acc[6] += w * h1.z; acc[7] += w * h1.w;
        acc[8] += w * h2.x; acc[9] += w * h2.y; acc[10] += w * h2.z; acc[11] += w * h2.w; acc[12] += w * h3.x; acc[13] += w * h3.y; acc[14] += w * h3.z; acc[15] += w * h3.w;
        if ((k & 3) == 3) asm volatile("" ::: "memory");
    }
#pragma unroll
    for (int r = 0; r < 16; ++r) red[(wave * 16 + r) * 64 + lane] = acc[r];
    __syncthreads();
    for (int o = tid; o < 1024; o += NWAVES * 64) { const int r = o >> 6, n = o & 63; float s = 0.f;
#pragma unroll
        for (int w = 0; w < 8; ++w) s += red[(w * 16 + r) * 64 + n];
        atomicAdd(macc + r * DM + n0 + n, s); }
    __syncthreads();
}
__device__ __forceinline__ void meta_down_finish(const Args& a, LAS unsigned char* lds, int tid) {
    unsigned char* ws = a.ws;
    const int cgp = blockIdx.x & 15, n0 = 64 * cgp;
    LAS unsigned* flag = (LAS unsigned*)(lds + 16384 + 32768);
    float* macc = (float*)(ws + WS_CTL + CT_MACC); unsigned* mcnt = (unsigned*)(ws + WS_CTL + CT_MCNT); float* ss1 = (float*)(ws + WS_CTL + CT_SS1);
    asm volatile("s_waitcnt vmcnt(0)" ::: "memory"); __syncthreads();
    if (tid == 0) { const unsigned old = atomicAdd(mcnt + cgp, 1u); flag[0] = (old == 15u) ? 1u : 0u; }
    __syncthreads();
    if (flag[0]) {
        const int r = tid >> 5, nn = (tid & 31) * 2;
        const float v0 = __hip_atomic_load(macc + r * DM + n0 + nn, __ATOMIC_RELAXED, __HIP_MEMORY_SCOPE_AGENT), v1 = __hip_atomic_load(macc + r * DM + n0 + nn + 1, __ATOMIC_RELAXED, __HIP_MEMORY_SCOPE_AGENT);
        const float h0 = a.in[1][r * DM + n0 + nn] + 0.5f * v0, h1 = a.in[1][r * DM + n0 + nn + 1] + 0.5f * v1;
        const unsigned w = pk2(h0, h1);
        *(unsigned*)((bf16*)(ws + WS_XB) + (size_t)r * DM + n0 + nn) = w;
        *(unsigned*)((bf16*)(ws + WS_PERM) + (size_t)(100 * r) * DM + n0 + nn) = w;
        float ps = h0 * h0 + h1 * h1;
#pragma unroll
        for (int o = 1; o < 32; o <<= 1) ps += __shfl_xor(ps, o);
        if ((tid & 31) == 0) atomicAdd(ss1 + r, ps);
    }
    __syncthreads();
}

#define ATT_LOAD(KF, VF, si) do { const int kk0_ = (si) == 0 ? 0 : ks + 32 * ((si) - 1); \
    _Pragma("unroll") for (int T = 0; T < 2; ++T) { const int krow = kk0_ + 8 * (i >> 2) + 4 * T + (i & 3); \
        _Pragma("unroll") for (int hf = 0; hf < 2; ++hf) KF[T][hf] = *(const bf16x8*)(Kb + (size_t)krow * 128 + kvh * 64 + hf * 32 + 8 * g); } \
    _Pragma("unroll") for (int dt = 0; dt < 4; ++dt) VF[dt] = *(const bf16x8*)(Vt + (size_t)(kvh * 64 + dt * 16 + i) * LP + kk0_ + 8 * g); } while (0)
#define ATT_COMPUTE(KF, VF, si) do { const bool metastep = (si) == 0; const int kk0_ = metastep ? 0 : ks + 32 * ((si) - 1); \
    float fd[8]; bool vl[8]; \
    _Pragma("unroll") for (int e = 0; e < 8; ++e) { const int tk = kk0_ + 8 * g + e; int dist = tq - tk; dist = dist < 0 ? -dist : dist; \
        vl[e] = metastep ? (tk < NMETA) : (dist <= 128 && tk >= NMETA && tk < LTOK); fd[e] = (float)(dist > 128 ? 128 : dist); } \
    _Pragma("unroll") for (int h = 0; h < 4; ++h) { float p[8]; \
        _Pragma("unroll") for (int T = 0; T < 2; ++T) { f32x4 S = (f32x4){0.f, 0.f, 0.f, 0.f}; \
            S = __builtin_amdgcn_mfma_f32_16x16x32_bf16(KF[T][0], Qf[h][0], S, 0, 0, 0); \
            S = __builtin_amdgcn_mfma_f32_16x16x32_bf16(KF[T][1], Qf[h][1], S, 0, 0, 0); \
            _Pragma("unroll") for (int j = 0; j < 4; ++j) { const float ex = __builtin_amdgcn_exp2f(S[j] - slope[h] * fd[4 * T + j] - M0); p[4 * T + j] = vl[4 * T + j] ? ex : 0.f; } } \
        l[h] += ((p[0] + p[1]) + (p[2] + p[3])) + ((p[4] + p[5]) + (p[6] + p[7])); \
        v4u pw; pw.x = pg8::cvt_pk_bf16(p[0], p[1]); pw.y = pg8::cvt_pk_bf16(p[2], p[3]); pw.z = pg8::cvt_pk_bf16(p[4], p[5]); pw.w = pg8::cvt_pk_bf16(p[6], p[7]); \
        const bf16x8 P = __builtin_bit_cast(bf16x8, pw); \
        _Pragma("unroll") for (int dt = 0; dt < 4; ++dt) Oa[h][dt] = __builtin_amdgcn_mfma_f32_16x16x32_bf16(VF[dt], P, Oa[h][dt], 0, 0, 0); } } while (0)
__device__ __forceinline__ void attn_phase(const Args& a, int lane, int wave) {
    unsigned char* ws = a.ws;
    const bf16* Q = (const bf16*)(ws + WS_Q); const bf16* Kb = (const bf16*)(ws + WS_K); const bf16* Vt = (const bf16*)(ws + WS_VT); bf16* O = (bf16*)(ws + WS_PERM); float* ssA = (float*)(ws + WS_CTL + CT_SSA);
    const int i = lane & 15, g = lane >> 4;
    constexpr float L2E = 1.4426950408889634f;
    const float gq = wave_max(fabsf(a.in[8][lane])), gk = wave_max(fabsf(a.in[9][lane]));
    const float M0 = fminf(8.0f * gq * gk, 80.0f) * L2E;
    const int gw = blockIdx.x * NWAVES + wave, NGW = gridDim.x * NWAVES;
    for (int unit = gw; unit < 2048; unit += NGW) {
        const int qt = unit >> 1, kvh = unit & 1;
        const int tq0 = NMETA + 16 * qt, tq = tq0 + i;
        bf16x8 Qf[4][2];
#pragma unroll
        for (int h = 0; h < 4; ++h)
#pragma unroll
            for (int hf = 0; hf < 2; ++hf) Qf[h][hf] = *(const bf16x8*)(Q + (size_t)tq * 512 + (kvh * 4 + h) * 64 + hf * 32 + 8 * g);
        f32x4 Oa[4][4]; float l[4], slope[4];
#pragma unroll
        for (int h = 0; h < 4; ++h) { l[h] = 0.f; slope[h] = __builtin_amdgcn_exp2f(-(float)(kvh * 4 + h + 1)) * L2E;
#pragma unroll
            for (int dt = 0; dt < 4; ++dt) Oa[h][dt] = (f32x4){0.f, 0.f, 0.f, 0.f}; }
        const int ks = (tq0 - 128) < 0 ? 0 : ((tq0 - 128) & ~31), ke = (tq0 + 143) & ~31;
        const int nsteps = 2 + (ke - ks) / 32;
        bf16x8 KfA[2][2], VfA[4], KfB[2][2], VfB[4];
        ATT_LOAD(KfA, VfA, 0);
        for (int si = 0; si < nsteps; si += 2) {
            if (si + 1 < nsteps) ATT_LOAD(KfB, VfB, si + 1);
            ATT_COMPUTE(KfA, VfA, si);
            if (si + 1 < nsteps) {
                if (si + 2 < nsteps) ATT_LOAD(KfA, VfA, si + 2);
                ATT_COMPUTE(KfB, VfB, si + 1);
            }
        }
        float sq = 0.f;
#pragma unroll
        for (int h = 0; h < 4; ++h) {
            float lt = l[h]; lt += __shfl_xor(lt, 16); lt += __shfl_xor(lt, 32);
            lt += __builtin_amdgcn_exp2f(a.in[10][kvh * 4 + h] * L2E - M0);
            const float inv = 1.0f / lt;
#pragma unroll
            for (int dt = 0; dt < 4; ++dt) { const f32x4 o = Oa[h][dt] * inv;
                sq += (o[0] * o[0] + o[1] * o[1]) + (o[2] * o[2] + o[3] * o[3]);
                *(v2u*)(O + (size_t)(tq - NMETA) * DM + (kvh * 4 + h) * 64 + dt * 16 + 4 * g) = (v2u){pg8::cvt_pk_bf16(o[0], o[1]), pg8::cvt_pk_bf16(o[2], o[3])}; }
        }
        sq += __shfl_xor(sq, 16); sq += __shfl_xor(sq, 32);
        if (g == 0) atomicAdd(ssA + (tq - NMETA), sq);
    }
}

__device__ __forceinline__ void mixnorm_phase(const Args& a, int lane, int wave) {
    unsigned char* ws = a.ws;
    const bf16* O = (const bf16*)(ws + WS_O); const float* Y = (const float*)(ws + WS_Y); bf16* MX = (bf16*)(ws + WS_XB);
    const int gw = blockIdx.x * NWAVES + wave, NGW = gridDim.x * NWAVES;
    for (int s0 = 4 * gw; s0 < SEQ; s0 += 4 * NGW) {
        v4u ov[4]; f32x4 y0[4], y1[4]; float sa[4], sf[4];
#pragma unroll
        for (int r = 0; r < 4; ++r) { const int s = s0 + r; ov[r] = *(const v4u*)(O + (size_t)s * 512 + 8 * lane);
            y0[r] = *(const f32x4*)(Y + (size_t)(NMETA + s) * 512 + 8 * lane); y1[r] = *(const f32x4*)(Y + (size_t)(NMETA + s) * 512 + 8 * lane + 4); }
        float of[4][8];
#pragma unroll
        for (int r = 0; r < 4; ++r) {
            of[r][0] = bf2f(ov[r].x & 0xffffu); of[r][1] = bf2f(ov[r].x >> 16); of[r][2] = bf2f(ov[r].y & 0xffffu); of[r][3] = bf2f(ov[r].y >> 16);
            of[r][4] = bf2f(ov[r].z & 0xffffu); of[r][5] = bf2f(ov[r].z >> 16); of[r][6] = bf2f(ov[r].w & 0xffffu); of[r][7] = bf2f(ov[r].w >> 16);
            float t = 0.f;
#pragma unroll
            for (int j = 0; j < 8; ++j) t += of[r][j] * of[r][j];
            sa[r] = t;
            sf[r] = (y0[r].x * y0[r].x + y0[r].y * y0[r].y) + (y0[r].z * y0[r].z + y0[r].w * y0[r].w) + (y1[r].x * y1[r].x + y1[r].y * y1[r].y) + (y1[r].z * y1[r].z + y1[r].w * y1[r].w);
        }
#pragma unroll
        for (int o = 1; o < 64; o <<= 1) {
#pragma unroll
            for (int r = 0; r < 4; ++r) { sa[r] += __shfl_xor(sa[r], o); sf[r] += __shfl_xor(sf[r], o); } }
#pragma unroll
        for (int r = 0; r < 4; ++r) { const int s = s0 + r;
            const float ra = pg8::rstd_of(sa[r], 1.0f / 512.0f), rf = pg8::rstd_of(sf[r], 1.0f / 512.0f);
            *(v4u*)(MX + (size_t)s * DM + 8 * lane) = (v4u){pk2(of[r][0] * ra, of[r][1] * ra), pk2(of[r][2] * ra, of[r][3] * ra), pk2(of[r][4] * ra, of[r][5] * ra), pk2(of[r][6] * ra, of[r][7] * ra)};
            *(v4u*)(MX + (size_t)s * DM + 512 + 8 * lane) = (v4u){pk2(y0[r].x * rf, y0[r].y * rf), pk2(y0[r].z * rf, y0[r].w * rf), pk2(y1[r].x * rf, y1[r].y * rf), pk2(y1[r].z * rf, y1[r].w * rf)};
        }
    }
}
__device__ __forceinline__ void finalnorm_phase(const Args& a, float* dst, int lane, int wave) {
    const int gw = blockIdx.x * NWAVES + wave, NGW = gridDim.x * NWAVES;
    const f32x4* gp = (const f32x4*)a.in[18];
    f32x4 gv[4];
#pragma unroll
    for (int j = 0; j < 4; ++j) gv[j] = gp[lane + 64 * j];
    for (int s0 = 4 * gw; s0 < SEQ; s0 += 4 * NGW) {
        f32x4 v[4][4]; float q[4];
#pragma unroll
        for (int r = 0; r < 4; ++r) { const f32x4* row = (const f32x4*)(a.out + (size_t)(s0 + r) * DM);
#pragma unroll
            for (int j = 0; j < 4; ++j) v[r][j] = row[lane + 64 * j]; }
#pragma unroll
        for (int r = 0; r < 4; ++r) { float t = 0.f;
#pragma unroll
            for (int j = 0; j < 4; ++j) t += (v[r][j].x * v[r][j].x + v[r][j].y * v[r][j].y) + (v[r][j].z * v[r][j].z + v[r][j].w * v[r][j].w);
            q[r] = t; }
#pragma unroll
        for (int o = 1; o < 64; o <<= 1) {
#pragma unroll
            for (int r = 0; r < 4; ++r) q[r] += __shfl_xor(q[r], o); }
#pragma unroll
        for (int r = 0; r < 4; ++r) { const float rs = pg8::rstd_of(q[r], 1.0f / 1024.0f); f32x4* orow = (f32x4*)(dst + (size_t)(s0 + r) * DM);
#pragma unroll
            for (int j = 0; j < 4; ++j) orow[lane + 64 * j] = v[r][j] * rs * gv[j]; }
    }
}

#ifndef PROBE_DUP
#define PROBE_DUP 0
#endif
#ifndef PHASE_MASK
#define PHASE_MASK 0xFFFF
#endif
constexpr int PM = PHASE_MASK;
#ifndef PG8_SP2
#define PG8_SP2 true
#endif
#ifndef PG8_ALIGN
#define PG8_ALIGN true
#endif

__global__ void __launch_bounds__(NWAVES * 64, 2) mega_fwd(Args args) {
    extern __shared__ __attribute__((aligned(16))) unsigned char lds_raw[];
    cg::grid_group grid = cg::this_grid();
    LAS unsigned char* lds = (LAS unsigned char*)lds_raw;
    const int tid = threadIdx.x, lane = tid & 63, wave = __builtin_amdgcn_readfirstlane(tid >> 6);
    const int G = gridDim.x, bx = blockIdx.x;
    unsigned char* ws = args.ws;
    float* ss0 = (float*)(ws + WS_SS0); float* ss1 = (float*)(ws + WS_CTL + CT_SS1); float* ss2 = (float*)(ws + WS_CTL + CT_SS2);
    bf16* XB = (bf16*)(ws + WS_XB); bf16* HID = (bf16*)(ws + WS_HID);

    if (tid < 16) ((LAS unsigned*)(lds + MISC_OFF))[tid] = 0u;
    __syncthreads();
    XcdBarrier bar = xcd_barrier_post((unsigned*)(ws + WS_CTL + CT_BAR), (volatile LAS unsigned*)(lds + MISC_OFF));
    if (tid == 0) { const unsigned r = xb_add((unsigned*)(ws + WS_CTL + CT_TIX) + 64 * bar.x, 1u); ((volatile LAS unsigned*)(lds + MISC_OFF))[4] = r * 8u + bar.x; }
    if (args.out == nullptr) grid.sync();
#if PROBE_DUP & 1
    p0_prologue(args, lds, tid, lane, wave); xcd_barrier(bar);
#endif
    if (PM & 1) p0_prologue(args, lds, tid, lane, wave);
    xcd_barrier(bar);
    int vb = bx;
    { bool ok = (G == 256);
      for (int j = 0; j < 8; ++j) ok = ok && (xb_ld((unsigned*)(ws + WS_CTL + CT_BAR) + XB_XCNT(j)) == 32u);
      if (ok) vb = (int)((volatile LAS unsigned*)(lds + MISC_OFF))[4]; vb = __builtin_amdgcn_readfirstlane(vb); }
    if (PM & 2) {
        pg8::Gemm g{XB, (const bf16*)(ws + WS_WGU1), LP, 2 * FF, DM}; pg8::StaticOrder S; S.init(LP, 2 * FF, G, vb);
        pg8::EpiSwiglu E{HID, ss0, FF};
        pg8::gemm_phase<pg8::EpiSwiglu, pg8::StaticOrder, PG8_ALIGN, PG8_SP2>(lds, g, S, E);
        if (vb >= 150) late_weights(args, lds, TR_N0, TR_N1, (vb - 150) * NWAVES + wave, (256 - 150) * NWAVES, lane, wave);
    }
    xcd_barrier(bar);
    if (PM & 4) {
        meta_down(args, lds, tid, lane, wave);
        pg8::Gemm g{HID + (size_t)NMETA * FF, (const bf16*)(ws + WS_WD1), SEQ, DM, FF}; pg8::StaticOrder S; S.init(SEQ, DM, G, vb);
        pg8::EpiRes E{XB + (size_t)NMETA * DM, XB + (size_t)NMETA * DM, (bf16*)(ws + WS_PERM), ss1 + NMETA, 0.5f};
        pg8::gemm_phase<pg8::EpiRes, pg8::StaticOrder, false, PG8_SP2>(lds, g, S, E);
        meta_down_finish(args, lds, tid);
    }
    xcd_barrier(bar);
    if (PM & 8) {
        pg8::Gemm g{XB, (const bf16*)(ws + WS_WQKV), LP, 768, DM}; pg8::StaticOrder S; S.init(LP, 768, G, vb);
        pg8::EpiQKV E{(bf16*)(ws + WS_Q), (bf16*)(ws + WS_K), (bf16*)(ws + WS_VT), ss1, args.in[8], args.in[9], LP};
        pg8::gemm_phase<pg8::EpiQKV, pg8::StaticOrder, PG8_ALIGN, PG8_SP2>(lds, g, S, E);
        pg8::Gemm g0{(const bf16*)(ws + WS_WG), (const bf16*)(ws + WS_PERM), 1024, LP, DM}; pg8::StaticOrder S0; S0.init(1024, LP, G, (vb + 61) & 255);
        pg8::EpiG0 E0{(bf16*)(ws + WS_X), ss1};
        pg8::gemm_phase<pg8::EpiG0, pg8::StaticOrder, PG8_ALIGN, PG8_SP2>(lds, g0, S0, E0);
    }
    xcd_barrier(bar);
    if (PM & 16) {
        int kdim = 256; asm volatile("" : "+s"(kdim));
        pg8::Gemm g{(const bf16*)(ws + WS_A1), (const bf16*)(ws + WS_X), 256, 512 * 164, kdim}; pg8::StaticOrder S; S.init(256, 512 * 164, G, vb);
        pg8::EpiG1 E{(bf16*)(ws + WS_X1)};
        pg8::gemm_phase<pg8::EpiG1, pg8::StaticOrder, PG8_ALIGN, PG8_SP2>(lds, g, S, E);
        attn_phase(args, lane, wave);
        if (vb >= 72) late_weights(args, lds, TR_N1, TR_N1 + 1408, (vb - 72) * NWAVES + wave, (256 - 72) * NWAVES, lane, wave);
    }
    xcd_barrier(bar);
#if PROBE_DUP & 2
    attn_phase(args, lane, wave); xcd_barrier(bar);
#endif
    if (PM & 32) {
        int kdim = 384; asm volatile("" : "+s"(kdim));
        pg8::Gemm g{(const bf16*)(ws + WS_A3), (const bf16*)(ws + WS_X1), 256, 100 * 512, kdim}; pg8::StaticOrder S; S.init(256, 100 * 512, G, vb);
        pg8::EpiG3 E{(bf16*)(ws + WS_PERM), (float*)(ws + WS_CTL + CT_SSF)};
        pg8::gemm_phase<pg8::EpiG3, pg8::StaticOrder, PG8_ALIGN, PG8_SP2>(lds, g, S, E);
        if (vb >= 200) late_weights(args, lds, TR_N1 + 2112, TR_N, (vb - 200) * NWAVES + wave, (256 - 200) * NWAVES, lane, wave);
    }
    xcd_barrier(bar);
    if (PM & 128) {
        pg8::Gemm g{(const bf16*)(ws + WS_PERM), (const bf16*)(ws + WS_WOUT), SEQ, DM, DM}; pg8::StaticOrder S; S.init(SEQ, DM, G, vb);
        pg8::EpiResMix E{XB + (size_t)NMETA * DM, (bf16*)(ws + WS_H2B), ss2, (const float*)(ws + WS_CTL + CT_SSA), (const float*)(ws + WS_CTL + CT_SSF)};
        pg8::gemm_phase<pg8::EpiResMix, pg8::StaticOrder, false, PG8_SP2>(lds, g, S, E);
    }
    xcd_barrier(bar);
    if (PM & 256) {
        pg8::Gemm g{(const bf16*)(ws + WS_H2B), (const bf16*)(ws + WS_WGU2), SEQ, 2 * FF, DM}; pg8::StaticOrder S; S.init(SEQ, 2 * FF, G, vb);
        pg8::EpiSwiglu E{HID, ss2, FF};
        pg8::gemm_phase<pg8::EpiSwiglu, pg8::StaticOrder, PG8_ALIGN, PG8_SP2>(lds, g, S, E);
        if (vb >= 128) late_weights(args, lds, TR_N1 + 1408, TR_N1 + 2112, (vb - 128) * NWAVES + wave, 128 * NWAVES, lane, wave);
    }
    xcd_barrier(bar);
    if (PM & 512) {
        pg8::Gemm g{HID, (const bf16*)(ws + WS_WD2), SEQ, DM, FF}; pg8::StaticOrder S; S.init(SEQ, DM, G, vb);
        pg8::EpiResFinal E{(const bf16*)(ws + WS_H2B), args.out, (float*)(ws + WS_SLOT), (unsigned*)(ws + WS_CTL + CT_PCNT), args.in[18], 0.5f};
        pg8::gemm_phase<pg8::EpiResFinal, pg8::StaticOrder, false, PG8_SP2>(lds, g, S, E);
    }
}

extern "C" void kernel_launch(void* const* d_in, const int* in_sizes, int n_in, void* d_out, int out_size, void* d_ws, size_t ws_size, hipStream_t stream) {
    static int grid = 0;
    if (grid == 0) {
        if (n_in != 19 || out_size != SEQ * DM || ws_size < WS_END) { fprintf(stderr, "kernel_launch: unexpected shapes (n_in %d out %d ws %zu)\n", n_in, out_size, ws_size); grid = -1; return; }
        int dev = 0, cus = 0, per_cu = 0;
        hipGetDevice(&dev); hipDeviceGetAttribute(&cus, hipDeviceAttributeMultiprocessorCount, dev);
        hipFuncSetAttribute((const void*)mega_fwd, hipFuncAttributeMaxDynamicSharedMemorySize, LDS_BYTES);
        hipOccupancyMaxActiveBlocksPerMultiprocessor(&per_cu, (const void*)mega_fwd, NWAVES * 64, LDS_BYTES);
        (void)hipGetLastError();
        if (per_cu < 1) per_cu = 1;
        grid = cus;
        if (grid != 256) fprintf(stderr, "kernel_launch: %d CUs (expected 256)\n", cus);
    }
    if (grid < 0) return;
    hipMemsetAsync((char*)d_ws + WS_CTL, 0, CTL_BYTES, stream);
    Args a{};
    for (int i = 0; i < 19; ++i) a.in[i] = (const float*)d_in[i];
    a.out = (float*)d_out; a.ws = (unsigned char*)d_ws;
    void* kargs[] = {&a};
    hipError_t e = hipLaunchCooperativeKernel((const void*)mega_fwd, dim3(grid), dim3(NWAVES * 64), kargs, LDS_BYTES, stream);
    if (e != hipSuccess) fprintf(stderr, "cooperative launch failed: %s (grid %d)\n", hipGetErrorString(e), grid);
}
```

```cpp
#include <hip/hip_runtime.h>
#include <hip/hip_cooperative_groups.h>
#include <cstdio>
#include <cstdint>
namespace cg = cooperative_groups;
namespace pg8 {
#define PG8_LAS __attribute__((address_space(3)))
typedef unsigned short bf16_t;
typedef short bf16x8 __attribute__((ext_vector_type(8)));
typedef float f32x4 __attribute__((ext_vector_type(4)));
typedef unsigned u32x4 __attribute__((ext_vector_type(4)));
constexpr int BM = 256, BK = 64, HALF = 128, HTB = HALF * BK * 2  , STAGE_BYTES = 8 * HTB, NXCD = 8, WGM = 8;

__host__ __device__ __forceinline__ int lds_byte(int r, int c) { const int st = (r >> 4) * 2 + (c >> 5), rr = r & 15, cc = c & 31, ob = rr * 64 + cc * 2; return st * 1024 + (ob ^ (((ob >> 9) & 1) << 5)); }
__host__ __device__ __forceinline__ void stage_rc(int b, int& R, int& C) { const int st = b / 1024, sb = b % 1024, swz = sb ^ (((sb >> 9) & 1) << 5); R = (st >> 1) * 16 + swz / 64; C = (st & 1) * 32 + (swz % 64) / 2; }
__host__ __device__ __forceinline__ int perm32(int rho) { const int n = rho >> 4, i = rho & 15; return 8 * (i >> 2) + 4 * n + (i & 3); }

struct Unit { int pm, pn; };
struct Gemm { const bf16_t* A; const bf16_t* Bt; int M, N, K; };

struct StaticOrder {
    int nM, nN, nwg, G, c;
    __host__ __device__ void init(int M, int N, int G_, int c_) { nM = M / BM; nN = N / BM; nwg = nM * nN; G = G_; c = c_; }
    __host__ __device__ bool next(int i, Unit& u) const {
        const long L = (long)i * G + c; if (L >= nwg) return false;
        int wgid = (int)L; { const int q = nwg / NXCD, r = nwg % NXCD, xcd = wgid % NXCD, off = wgid / NXCD; wgid = (xcd < r ? xcd * (q + 1) : r * (q + 1) + (xcd - r) * q) + off; }
        const int nig = WGM * nN, gid = wgid / nig, fm = gid * WGM, gsz = (nM - fm) < WGM ? (nM - fm) : WGM;
        u.pm = fm + ((wgid % nig) % gsz); u.pn = (wgid % nig) / gsz; return true;
    }
    __device__ __forceinline__ void a_ready(const Unit&) const {}
    __device__ __forceinline__ void done(const Unit&) const {}
};
__device__ __forceinline__ unsigned cvt_pk_bf16(float lo, float hi) { unsigned r; asm volatile("v_cvt_pk_bf16_f32 %0, %1, %2" : "=v"(r) : "v"(lo), "v"(hi)); return r; }
typedef float f32x2 __attribute__((ext_vector_type(2)));
template <class Epi, class Sched, bool ALIGN_EPI = false, bool SP2 = false>
__device__ __forceinline__ void gemm_phase(PG8_LAS unsigned char* lds, const Gemm g, const Sched& S, const Epi& E) {
    int tid_ = threadIdx.x; asm volatile("" : "+v"(tid_));
    const int tid = tid_, wid = __builtin_amdgcn_readfirstlane(tid >> 6), lane = tid & 63, wr = wid >> 2, wc = wid & 3, fr = lane & 15, fq = lane >> 4;
    const int K = g.K, nt = K / BK;
    unsigned voffA[2], voffB[2];
#pragma unroll
    for (int i = 0; i < 2; ++i) { int R, C; stage_rc(tid * 16 + i * 8192, R, C); const int Rb = Epi::PERM ? ((R & ~31) + perm32(R & 31)) : R;
        voffA[i] = (unsigned)(R * K + C) * 2u; voffB[i] = (unsigned)(Rb * K + C) * 2u; }
    const size_t kstep = (size_t)(BK * 2);
    const size_t hstep = (size_t)HALF * K * 2;
    const size_t tstep = 2 * hstep;
    const unsigned ldsw = (unsigned)wid * 1024u;
    const int aoff = lds_byte(wr * 64 + fr, fq * 8), boff = lds_byte(wc * 32 + fr, fq * 8);
#define PG8_SA(b, h) (((b) * 2 + (h)) * HTB)
#define PG8_SB(b, h) ((4 + (b) * 2 + (h)) * HTB)
#define PG8_STAGE(bufoff, gbase, voff) do { _Pragma("unroll") for (int _i = 0; _i < 2; ++_i) \
        __builtin_amdgcn_global_load_lds((const unsigned*)((const char*)(gbase) + (voff)[_i]), (PG8_LAS unsigned*)(lds + (bufoff) + ldsw + _i * 8192), 16, 0, 0); } while (0)
#define PG8_LDA(dst, b, h) do { _Pragma("unroll") for (int m = 0; m < 4; ++m) _Pragma("unroll") for (int k = 0; k < 2; ++k) dst[m][k] = *(const PG8_LAS bf16x8*)(lds + PG8_SA(b, h) + aoff + m * 2048 + k * 1024); } while (0)
#define PG8_LDB(dst, b, h) do { _Pragma("unroll") for (int n = 0; n < 2; ++n) _Pragma("unroll") for (int k = 0; k < 2; ++k) dst[n][k] = *(const PG8_LAS bf16x8*)(lds + PG8_SB(b, h) + boff + n * 2048 + k * 1024); } while (0)
#define PG8_MMA(ai, bj, At, Bt) do { __builtin_amdgcn_s_setprio(1); _Pragma("unroll") for (int m = 0; m < 4; ++m) _Pragma("unroll") for (int n = 0; n < 2; ++n) _Pragma("unroll") for (int k = 0; k < 2; ++k) \
        acc[ai][bj][m][n] = __builtin_amdgcn_mfma_f32_16x16x32_bf16(Bt[n][k], At[m][k], acc[ai][bj][m][n], 0, 0, 0); __builtin_amdgcn_s_setprio(0); } while (0)
#define PG8_WAIT_V(n) asm volatile("s_waitcnt vmcnt(" #n ")" ::: "memory")
#define PG8_WAIT_L(n) asm volatile("s_waitcnt lgkmcnt(" #n ")" ::: "memory")
#define PG8_BAR __builtin_amdgcn_s_barrier()
#define PG8_SCHED __builtin_amdgcn_sched_barrier(0)
    Unit cur, nxt; int ui = 0;
    if (!S.next(0, cur)) return;
    f32x4 acc[2][2][4][2];
#pragma unroll
    for (int a = 0; a < 2; ++a)
#pragma unroll
        for (int b = 0; b < 2; ++b)
#pragma unroll
            for (int m = 0; m < 4; ++m)
#pragma unroll
                for (int n = 0; n < 2; ++n) acc[a][b][m][n] = (f32x4){0.f, 0.f, 0.f, 0.f};
    bf16x8 At[4][2], B0[2][2], B1[2][2];
    const char* cA = (const char*)g.A + (size_t)cur.pm * tstep; const char* cB = (const char*)g.Bt + (size_t)cur.pn * tstep;
    S.a_ready(cur);
    if constexpr (SP2) {
        PG8_STAGE(PG8_SB(0, 0), cB, voffB); PG8_STAGE(PG8_SB(0, 1), cB + hstep, voffB); PG8_STAGE(PG8_SA(0, 0), cA, voffA); PG8_STAGE(PG8_SA(0, 1), cA + hstep, voffA);
        if (wr == 1) PG8_BAR;
        PG8_WAIT_V(2); PG8_BAR;
        PG8_STAGE(PG8_SB(1, 0), cB + kstep, voffB); PG8_STAGE(PG8_SA(1, 0), cA + kstep, voffA); PG8_STAGE(PG8_SB(1, 1), cB + hstep + kstep, voffB);
        PG8_WAIT_V(6); PG8_BAR;
    } else {
        PG8_STAGE(PG8_SB(0, 0), cB, voffB); PG8_STAGE(PG8_SA(0, 0), cA, voffA); PG8_STAGE(PG8_SB(0, 1), cB + hstep, voffB); PG8_STAGE(PG8_SA(0, 1), cA + hstep, voffA);
        if (wr == 1) PG8_BAR;
        PG8_WAIT_V(4); PG8_BAR;
        PG8_STAGE(PG8_SB(1, 0), cB + kstep, voffB); PG8_STAGE(PG8_SA(1, 0), cA + kstep, voffA); PG8_STAGE(PG8_SB(1, 1), cB + hstep + kstep, voffB);
        PG8_WAIT_V(6); PG8_BAR;
    }
    for (;;) {
        const bool has_next = S.next(ui + 1, nxt);
        const char* nA = has_next ? (const char*)g.A + (size_t)nxt.pm * tstep : cA; const char* nB = has_next ? (const char*)g.Bt + (size_t)nxt.pn * tstep : cB;
        for (int t = 0; t < nt; t += 2) {
            const bool last = (t == nt - 2);
            const char* a1 = cA + (size_t)(t + 1) * kstep;
            const char* a2 = last ? nA : cA + (size_t)(t + 2) * kstep; const char* b2 = last ? nB : cB + (size_t)(t + 2) * kstep;
            const char* a3 = a2 + kstep; const char* b3 = b2 + kstep;
            if (last && has_next) S.a_ready(nxt);
            if constexpr (Epi::MIDSCALE) { if (t == (nt >> 1)) E.mid(acc, cur, wr, wc, fr, fq); }
            if constexpr (SP2) {
            PG8_LDB(B0, 0, 0); PG8_LDB(B1, 0, 1); PG8_SCHED; PG8_LDA(At, 0, 0); PG8_STAGE(PG8_SA(1, 1), a1 + hstep, voffA);
            PG8_WAIT_V(8); PG8_WAIT_L(0); PG8_BAR; PG8_MMA(0, 0, At, B0); PG8_MMA(0, 1, At, B1); PG8_BAR; PG8_SCHED;
            PG8_LDA(At, 0, 1); PG8_STAGE(PG8_SB(0, 0), b2, voffB); PG8_STAGE(PG8_SB(0, 1), b2 + hstep, voffB); PG8_STAGE(PG8_SA(0, 0), a2, voffA);
            PG8_WAIT_V(8); PG8_WAIT_L(0); PG8_BAR; PG8_MMA(1, 0, At, B0); PG8_MMA(1, 1, At, B1); PG8_BAR; PG8_SCHED;
            PG8_LDB(B0, 1, 0); PG8_LDB(B1, 1, 1); PG8_SCHED; PG8_LDA(At, 1, 0); PG8_STAGE(PG8_SA(0, 1), a2 + hstep, voffA);
            PG8_WAIT_V(8); PG8_WAIT_L(0); PG8_BAR; PG8_MMA(0, 0, At, B0); PG8_MMA(0, 1, At, B1); PG8_BAR; PG8_SCHED;
            PG8_LDA(At, 1, 1); PG8_STAGE(PG8_SB(1, 0), b3, voffB); PG8_STAGE(PG8_SB(1, 1), b3 + hstep, voffB); PG8_STAGE(PG8_SA(1, 0), a3, voffA);
            PG8_WAIT_V(8); PG8_WAIT_L(0); PG8_BAR; PG8_MMA(1, 0, At, B0); PG8_MMA(1, 1, At, B1); PG8_BAR; PG8_SCHED;
            } else {
            PG8_LDB(B0, 0, 0); PG8_SCHED; PG8_LDA(At, 0, 0); PG8_STAGE(PG8_SA(1, 1), a1 + hstep, voffA);
            PG8_WAIT_L(8); PG8_BAR; PG8_WAIT_L(0); PG8_MMA(0, 0, At, B0); PG8_BAR; PG8_SCHED;
            PG8_LDB(B1, 0, 1); PG8_STAGE(PG8_SB(0, 0), b2, voffB);
            PG8_BAR; PG8_WAIT_L(0); PG8_MMA(0, 1, At, B1); PG8_BAR;
            PG8_LDA(At, 0, 1); PG8_STAGE(PG8_SA(0, 0), a2, voffA);
            PG8_BAR; PG8_WAIT_L(0); PG8_MMA(1, 0, At, B0); PG8_BAR; PG8_SCHED;
            PG8_STAGE(PG8_SB(0, 1), b2 + hstep, voffB);
            PG8_WAIT_V(6); PG8_BAR; PG8_MMA(1, 1, At, B1); PG8_BAR;
            PG8_LDB(B0, 1, 0); PG8_SCHED; PG8_LDA(At, 1, 0); PG8_STAGE(PG8_SA(0, 1), a2 + hstep, voffA);
            PG8_WAIT_L(8); PG8_BAR; PG8_WAIT_L(0); PG8_MMA(0, 0, At, B0); PG8_BAR; PG8_SCHED;
            PG8_LDB(B1, 1, 1); PG8_STAGE(PG8_SB(1, 0), b3, voffB);
            PG8_BAR; PG8_WAIT_L(0); PG8_MMA(0, 1, At, B1); PG8_BAR;
            PG8_LDA(At, 1, 1); PG8_STAGE(PG8_SA(1, 0), a3, voffA);
            PG8_BAR; PG8_WAIT_L(0); PG8_MMA(1, 0, At, B0); PG8_BAR; PG8_SCHED;
            PG8_STAGE(PG8_SB(1, 1), b3 + hstep, voffB);
            PG8_WAIT_V(6); PG8_BAR; PG8_MMA(1, 1, At, B1); PG8_BAR;
            }
        }
        if constexpr (ALIGN_EPI) { if (wr == 0) PG8_BAR; }
        if constexpr (!Epi::AFTER_DRAIN) { E(acc, cur, wr, wc, fr, fq); S.done(cur); }
        if (!has_next) break;
#pragma unroll
        for (int a = 0; a < 2; ++a)
#pragma unroll
            for (int b = 0; b < 2; ++b)
#pragma unroll
                for (int m = 0; m < 4; ++m)
#pragma unroll
                    for (int n = 0; n < 2; ++n) acc[a][b][m][n] = (f32x4){0.f, 0.f, 0.f, 0.f};
        cur = nxt; cA = nA; cB = nB; ++ui;
        if constexpr (ALIGN_EPI) { if (wr == 1) PG8_BAR; }
    }
    PG8_WAIT_V(0);
    if constexpr (!ALIGN_EPI) { if (wr == 0) PG8_BAR; }
    PG8_BAR;
    if constexpr (Epi::AFTER_DRAIN) { E.fused(acc, cur, wr, wc, fr, fq, lds, wid, lane); S.done(cur); }
#undef PG8_SA
#undef PG8_SB
#undef PG8_STAGE
#undef PG8_LDA
#undef PG8_LDB
#undef PG8_MMA
#undef PG8_WAIT_V
#undef PG8_WAIT_L
#undef PG8_BAR
#undef PG8_SCHED
}

typedef unsigned u32x2 __attribute__((ext_vector_type(2)));
constexpr float RMS_EPS = 1e-6f;
__device__ __forceinline__ float rstd_of(float ss, float inv_n) { return __builtin_amdgcn_rsqf(ss * inv_n + RMS_EPS); }
__device__ __forceinline__ float silu_f(float x) { return x * __builtin_amdgcn_rcpf(1.0f + __builtin_amdgcn_exp2f(-1.4426950408889634f * x)); }

struct EpiSwiglu {
    static constexpr bool PERM = true, AFTER_DRAIN = false, MIDSCALE = false;
    bf16_t* H; const float* ss; int ldh;
    __device__ __forceinline__ void operator()(const f32x4 (&acc)[2][2][4][2], const Unit& u, int wr, int wc, int fr, int fq) const {
        asm volatile("" : "+v"(fr), "+v"(fq), "+s"(wr), "+s"(wc));
        const int row0 = u.pm * BM + wr * 64 + fr, col0 = u.pn * HALF + wc * 32 + 8 * fq;
        float rsv[8];
#pragma unroll
        for (int q = 0; q < 8; ++q) rsv[q] = ss[row0 + (q >> 2) * HALF + (q & 3) * 16];
#pragma unroll
        for (int ai = 0; ai < 2; ++ai)
#pragma unroll
            for (int m = 0; m < 4; ++m) {
                const int row = row0 + ai * HALF + m * 16;
                const float rs = rstd_of(rsv[ai * 4 + m], 1.0f / 1024.0f);
                float o[8];
#pragma unroll
                for (int n = 0; n < 2; ++n)
#pragma unroll
                    for (int j = 0; j < 4; ++j) { const float g = acc[ai][0][m][n][j] * rs, up = acc[ai][1][m][n][j] * rs; o[n * 4 + j] = silu_f(g) * up; }
                u32x4 w; w.x = cvt_pk_bf16(o[0], o[1]); w.y = cvt_pk_bf16(o[2], o[3]); w.z = cvt_pk_bf16(o[4], o[5]); w.w = cvt_pk_bf16(o[6], o[7]);
                *(u32x4*)(H + (size_t)row * ldh + col0) = w;
            }
    }
};

struct EpiRes {
    static constexpr bool PERM = true, AFTER_DRAIN = true, MIDSCALE = false;
    const bf16_t* residh; bf16_t* ob; bf16_t* operm; float* ss; float alpha;
    __device__ __forceinline__ void fused(f32x4 (&acc)[2][2][4][2], const Unit& u, int wr, int wc, int fr, int fq, PG8_LAS unsigned char* lds, int wid, int lane) const {
        PG8_LAS float* Pl = (PG8_LAS float*)lds;
        asm volatile("" : "+v"(fr), "+v"(fq), "+s"(wr), "+s"(wc));
        const int col0 = u.pn * BM + wc * 32 + 8 * fq, s0 = u.pm * BM + wr * 64 + fr;
        u32x4 rh[3][2];
#define EPI_LOADH(q) do { const size_t o_ = (size_t)(s0 + ((q) >> 2) * HALF + ((q) & 3) * 16) * 1024 + col0; \
        _Pragma("unroll") for (int x_ = 0; x_ < 2; ++x_) rh[(q) % 3][x_] = *(const u32x4*)(residh + o_ + x_ * HALF); } while (0)
#define EPI_UNLO(v_) ((f32x4){__builtin_bit_cast(float, (v_).x << 16), __builtin_bit_cast(float, (v_).x & 0xffff0000u), __builtin_bit_cast(float, (v_).y << 16), __builtin_bit_cast(float, (v_).y & 0xffff0000u)})
#define EPI_UNHI(v_) ((f32x4){__builtin_bit_cast(float, (v_).z << 16), __builtin_bit_cast(float, (v_).z & 0xffff0000u), __builtin_bit_cast(float, (v_).w << 16), __builtin_bit_cast(float, (v_).w & 0xffff0000u)})
        EPI_LOADH(0); EPI_LOADH(1);
#pragma unroll
        for (int q = 0; q < 8; ++q) {
            const int ai = q >> 2, m = q & 3;
            if (q + 2 < 8) EPI_LOADH(q + 2);
            const int s = s0 + ai * HALF + m * 16;
            const int t = s + 16, b = t / 164, a = t - b * 164; const size_t nperm = (size_t)(a * 100 + b);
            float ps = 0.f;
#pragma unroll
            for (int bj = 0; bj < 2; ++bj) {
                const int col = col0 + bj * HALF; const size_t off = (size_t)s * 1024 + col;
                const f32x4 o0 = EPI_UNLO(rh[q % 3][bj]) + acc[ai][bj][m][0] * alpha, o1 = EPI_UNHI(rh[q % 3][bj]) + acc[ai][bj][m][1] * alpha;
                ps += ((o0[0] * o0[0] + o0[1] * o0[1]) + (o0[2] * o0[2] + o0[3] * o0[3])) + ((o1[0] * o1[0] + o1[1] * o1[1]) + (o1[2] * o1[2] + o1[3] * o1[3]));
                u32x4 w; w.x = cvt_pk_bf16(o0[0], o0[1]); w.y = cvt_pk_bf16(o0[2], o0[3]); w.z = cvt_pk_bf16(o1[0], o1[1]); w.w = cvt_pk_bf16(o1[2], o1[3]);
                *(u32x4*)(ob + off) = w;
                *(u32x4*)(operm + nperm * 1024 + col) = w;
            }
            ps += __shfl_xor(ps, 16); ps += __shfl_xor(ps, 32); if (fq == 0) Pl[(ai * HALF + wr * 64 + m * 16 + fr) * 4 + wc] = ps;
        }
        asm volatile("s_waitcnt lgkmcnt(0)" ::: "memory"); __syncthreads();
        if (threadIdx.x < 256) { const int row = threadIdx.x; atomicAdd(ss + u.pm * BM + row, (Pl[row * 4 + 0] + Pl[row * 4 + 1]) + (Pl[row * 4 + 2] + Pl[row * 4 + 3])); }
    }
};

struct EpiQKV {
    static constexpr bool PERM = true, AFTER_DRAIN = false, MIDSCALE = false;
    bf16_t* Q; bf16_t* Kb; bf16_t* Vt; const float* ss; const float* qn; const float* kn; int LPv;
    __device__ __forceinline__ void operator()(const f32x4 (&acc)[2][2][4][2], const Unit& u, int wr, int wc, int fr, int fq) const {
        asm volatile("" : "+v"(fr), "+v"(fq), "+s"(wr), "+s"(wc));
        const int hs = 4 * u.pn + wc;
        f32x4 gn[2][2];
        const float* gp = hs < 8 ? qn : kn;
#pragma unroll
        for (int bj = 0; bj < 2; ++bj)
#pragma unroll
            for (int n = 0; n < 2; ++n) gn[bj][n] = *(const f32x4*)(gp + 32 * bj + 8 * fq + 4 * n);
        const float qs = hs < 8 ? 0.125f * 1.4426950408889634f : 1.0f;
        float rsv[8];
#pragma unroll
        for (int q = 0; q < 8; ++q) rsv[q] = ss[u.pm * BM + (q >> 2) * HALF + wr * 64 + (q & 3) * 16 + fr];
#pragma unroll
        for (int ai = 0; ai < 2; ++ai)
#pragma unroll
            for (int m = 0; m < 4; ++m) {
                const int t = u.pm * BM + ai * HALF + wr * 64 + m * 16 + fr;
                const float rs = rstd_of(rsv[ai * 4 + m], 1.0f / 1024.0f);
                f32x4 v[2][2]; float q = 0.f;
#pragma unroll
                for (int bj = 0; bj < 2; ++bj)
#pragma unroll
                    for (int n = 0; n < 2; ++n) { v[bj][n] = acc[ai][bj][m][n] * rs; const f32x4 x = v[bj][n]; q += (x[0] * x[0] + x[1] * x[1]) + (x[2] * x[2] + x[3] * x[3]); }
                q += __shfl_xor(q, 16); q += __shfl_xor(q, 32);
                if (hs < 10) { const float hr = rstd_of(q, 1.0f / 64.0f) * qs;
#pragma unroll
                    for (int bj = 0; bj < 2; ++bj)
#pragma unroll
                        for (int n = 0; n < 2; ++n) v[bj][n] = v[bj][n] * gn[bj][n] * hr; }
#pragma unroll
                for (int bj = 0; bj < 2; ++bj) {
                    const int d = 32 * bj + 8 * fq; const f32x4 x0 = v[bj][0], x1 = v[bj][1];
                    u32x4 w; w.x = cvt_pk_bf16(x0[0], x0[1]); w.y = cvt_pk_bf16(x0[2], x0[3]); w.z = cvt_pk_bf16(x1[0], x1[1]); w.w = cvt_pk_bf16(x1[2], x1[3]);
                    if (hs < 8) *(u32x4*)(Q + (size_t)t * 512 + hs * 64 + d) = w;
                    else if (hs < 10) *(u32x4*)(Kb + (size_t)t * 128 + (hs - 8) * 64 + d) = w;
                    else {
                        const bool odd = (fr & 1) != 0;
                        const unsigned r0 = __shfl_xor(odd ? w.x : w.z, 1), r1 = __shfl_xor(odd ? w.y : w.w, 1);
                        const unsigned m0 = odd ? w.z : w.x, m1 = odd ? w.w : w.y;
                        const unsigned e0 = odd ? r0 : m0, o0 = odd ? m0 : r0, e1 = odd ? r1 : m1, o1 = odd ? m1 : r1;
                        bf16_t* vp = Vt + (size_t)((hs - 10) * 64 + d + (odd ? 4 : 0)) * LPv + (t & ~1); const size_t L_ = (size_t)LPv;
                        *(unsigned*)vp = (e0 & 0xffffu) | (o0 << 16); *(unsigned*)(vp + L_) = (e0 >> 16) | (o0 & 0xffff0000u);
                        *(unsigned*)(vp + 2 * L_) = (e1 & 0xffffu) | (o1 << 16); *(unsigned*)(vp + 3 * L_) = (e1 >> 16) | (o1 & 0xffff0000u); }
                }
            }
    }
};

struct EpiG0 {
    static constexpr bool PERM = true, AFTER_DRAIN = false, MIDSCALE = false;
    bf16_t* X; const float* ss;
    __device__ __forceinline__ void operator()(const f32x4 (&acc)[2][2][4][2], const Unit& u, int wr, int wc, int fr, int fq) const {
        asm volatile("" : "+v"(fr), "+v"(fq), "+s"(wr), "+s"(wc));
        const int part = u.pm >> 1;
#pragma unroll
        for (int bj = 0; bj < 2; ++bj) {
            const int nn = u.pn * BM + bj * HALF + wc * 32 + 8 * fq;
            if (nn >= 16400) continue;
            const int a = nn / 100, b = nn - a * 100;
            const bool cross = b == 96;
            const int a1 = cross ? a + 1 : a, b1 = cross ? 0 : b + 4;
            f32x4 rs0, rs1;
#pragma unroll
            for (int j = 0; j < 4; ++j) { rs0[j] = rstd_of(ss[a + 164 * (b + j)], 1.0f / 1024.0f); rs1[j] = rstd_of(ss[a1 + 164 * (b1 + j)], 1.0f / 1024.0f); }
#pragma unroll
            for (int ai = 0; ai < 2; ++ai)
#pragma unroll
                for (int m = 0; m < 4; ++m) {
                    const int c = ((u.pm & 1) * BM) + ai * HALF + wr * 64 + m * 16 + fr;
                    const f32x4 x0 = acc[ai][bj][m][0] * rs0, x1 = acc[ai][bj][m][1] * rs1;
                    const unsigned w0 = cvt_pk_bf16(x0[0], x0[1]), w1 = cvt_pk_bf16(x0[2], x0[3]), w2 = cvt_pk_bf16(x1[0], x1[1]), w3 = cvt_pk_bf16(x1[2], x1[3]);
                    bf16_t* p = X + ((size_t)(c * 164 + a) * 2 + part) * 128 + b;
                    if (!cross) *(u32x4*)p = (u32x4){w0, w1, w2, w3};
                    else {
                        *(u32x2*)p = (u32x2){w0, w1};
#pragma unroll
                        for (int z = 1; z < 8; ++z) *(u32x2*)(p + 4 * z) = (u32x2){0u, 0u};
                        *(u32x2*)(X + ((size_t)(c * 164 + a + 1) * 2 + part) * 128) = (u32x2){w2, w3};
                    }
                }
        }
    }
};

struct EpiG1 {
    static constexpr bool PERM = true, AFTER_DRAIN = false, MIDSCALE = false;
    bf16_t* X1;
    __device__ __forceinline__ void operator()(const f32x4 (&acc)[2][2][4][2], const Unit& u, int wr, int wc, int fr, int fq) const {
        asm volatile("" : "+v"(fr), "+v"(fq), "+s"(wr), "+s"(wc));
#pragma unroll
        for (int m = 0; m < 4; ++m) {
            const int beta = wr * 64 + m * 16 + fr;
            if (beta >= 100) continue;
            const float cd = __builtin_amdgcn_cosf((float)beta * (1.0f / 16400.0f)), sd = __builtin_amdgcn_sinf((float)beta * (1.0f / 16400.0f));
#pragma unroll
            for (int bj = 0; bj < 2; ++bj) {
                const int n1 = u.pn * BM + bj * HALF + wc * 32 + 8 * fq;
                const int c = n1 / 164, a0 = n1 - c * 164;
                const bool cross = a0 == 160;
                float cs = __builtin_amdgcn_cosf((float)(a0 * beta) * (1.0f / 16400.0f)), sn = __builtin_amdgcn_sinf((float)(a0 * beta) * (1.0f / 16400.0f));
                unsigned wre[4], wim[4];
#pragma unroll
                for (int n = 0; n < 2; ++n) {
                    const f32x4 re = acc[0][bj][m][n], im = acc[1][bj][m][n];
                    f32x4 ore, oim;
                    if (n == 1 && cross) { cs = 1.0f; sn = 0.0f; }
#pragma unroll
                    for (int j = 0; j < 4; ++j) {
                        ore[j] = re[j] * cs + im[j] * sn; oim[j] = im[j] * cs - re[j] * sn;
                        const float c2 = cs * cd - sn * sd; sn = sn * cd + cs * sd; cs = c2;
                    }
                    wre[2 * n] = cvt_pk_bf16(ore[0], ore[1]); wre[2 * n + 1] = cvt_pk_bf16(ore[2], ore[3]);
                    wim[2 * n] = cvt_pk_bf16(oim[0], oim[1]); wim[2 * n + 1] = cvt_pk_bf16(oim[2], oim[3]);
                }
                bf16_t* p = X1 + ((size_t)(beta * 512 + c) * 2) * 192 + a0;
                if (!cross) {
                    *(u32x4*)p = (u32x4){wre[0], wre[1], wre[2], wre[3]};
                    *(u32x4*)(p + 192) = (u32x4){wim[0], wim[1], wim[2], wim[3]};
                } else {
                    *(u32x2*)p = (u32x2){wre[0], wre[1]}; *(u32x2*)(p + 192) = (u32x2){wim[0], wim[1]};
#pragma unroll
                    for (int z = 1; z < 8; ++z) { *(u32x2*)(p + 4 * z) = (u32x2){0u, 0u}; *(u32x2*)(p + 192 + 4 * z) = (u32x2){0u, 0u}; }
                    bf16_t* p2 = X1 + ((size_t)(beta * 512 + c + 1) * 2) * 192;
                    *(u32x2*)p2 = (u32x2){wre[2], wre[3]}; *(u32x2*)(p2 + 192) = (u32x2){wim[2], wim[3]};
                }
            }
        }
    }
};

struct EpiG3 {
    static constexpr bool PERM = true, AFTER_DRAIN = false, MIDSCALE = false;
    bf16_t* MX; float* ssF;
    __device__ __forceinline__ void operator()(const f32x4 (&acc)[2][2][4][2], const Unit& u, int wr, int wc, int fr, int fq) const {
        asm volatile("" : "+v"(fr), "+v"(fq), "+s"(wr), "+s"(wc));
        const int beta = u.pn >> 1, cb = (u.pn & 1) * BM + wc * 32 + 8 * fq;
#pragma unroll
        for (int ai = 0; ai < 2; ++ai)
#pragma unroll
            for (int m = 0; m < 4; ++m) {
                const int alpha = ai * HALF + wr * 64 + m * 16 + fr;
                const int s = 100 * alpha + beta - 16;
                const bool ok = alpha < 164 && s >= 0;
                float ps = 0.f;
#pragma unroll
                for (int bj = 0; bj < 2; ++bj) {
                    const f32x4 x0 = acc[ai][bj][m][0], x1 = acc[ai][bj][m][1];
                    ps += ((x0[0] * x0[0] + x0[1] * x0[1]) + (x0[2] * x0[2] + x0[3] * x0[3])) + ((x1[0] * x1[0] + x1[1] * x1[1]) + (x1[2] * x1[2] + x1[3] * x1[3]));
                    if (ok) { u32x4 w; w.x = cvt_pk_bf16(x0[0], x0[1]); w.y = cvt_pk_bf16(x0[2], x0[3]); w.z = cvt_pk_bf16(x1[0], x1[1]); w.w = cvt_pk_bf16(x1[2], x1[3]);
                        *(u32x4*)(MX + (size_t)s * 1024 + 512 + cb + bj * HALF) = w; }
                }
                ps += __shfl_xor(ps, 16); ps += __shfl_xor(ps, 32);
                if (ok && fq == 0) atomicAdd(ssF + beta * 164 + alpha, ps);
            }
    }
};

struct EpiResMix {
    static constexpr bool PERM = true, AFTER_DRAIN = true, MIDSCALE = true;
    const bf16_t* residh; bf16_t* ob; float* ss; const float* ssA; const float* ssF;
    __device__ __forceinline__ void mid(f32x4 (&acc)[2][2][4][2], const Unit& u, int wr, int wc, int fr, int fq) const {
        asm volatile("" : "+v"(fr), "+s"(wr));
        const int s0 = u.pm * BM + wr * 64 + fr;
        float va[8], vf[8];
#pragma unroll
        for (int q = 0; q < 8; ++q) { const int s_ = s0 + (q >> 2) * HALF + (q & 3) * 16, al_ = (s_ + 16) / 100; va[q] = ssA[s_]; vf[q] = ssF[(s_ + 16 - 100 * al_) * 164 + al_]; }
#pragma unroll
        for (int q = 0; q < 8; ++q) {
            const float ratio = rstd_of(va[q], 1.0f / 512.0f) * __builtin_amdgcn_rcpf(rstd_of(vf[q], 1.0f / 512.0f));
#pragma unroll
            for (int bj = 0; bj < 2; ++bj)
#pragma unroll
                for (int n = 0; n < 2; ++n) acc[q >> 2][bj][q & 3][n] = acc[q >> 2][bj][q & 3][n] * ratio;
        }
    }
    __device__ __forceinline__ void fused(f32x4 (&acc)[2][2][4][2], const Unit& u, int wr, int wc, int fr, int fq, PG8_LAS unsigned char* lds, int wid, int lane) const {
        PG8_LAS float* Pl = (PG8_LAS float*)lds;
        asm volatile("" : "+v"(fr), "+v"(fq), "+s"(wr), "+s"(wc));
        const int col0 = u.pn * BM + wc * 32 + 8 * fq, s0 = u.pm * BM + wr * 64 + fr;
        float vf[8];
#pragma unroll
        for (int q = 0; q < 8; ++q) { const int s_ = s0 + (q >> 2) * HALF + (q & 3) * 16, al_ = (s_ + 16) / 100; vf[q] = ssF[(s_ + 16 - 100 * al_) * 164 + al_]; }
        u32x4 rh[3][2];
        EPI_LOADH(0); EPI_LOADH(1);
#pragma unroll
        for (int q = 0; q < 8; ++q) {
            const int ai = q >> 2, m = q & 3;
            if (q + 2 < 8) EPI_LOADH(q + 2);
            const int s = s0 + ai * HALF + m * 16;
            const float rf = rstd_of(vf[q], 1.0f / 512.0f);
            float ps = 0.f;
#pragma unroll
            for (int bj = 0; bj < 2; ++bj) {
                const size_t off = (size_t)s * 1024 + col0 + bj * HALF;
                const f32x4 o0 = EPI_UNLO(rh[q % 3][bj]) + acc[ai][bj][m][0] * rf, o1 = EPI_UNHI(rh[q % 3][bj]) + acc[ai][bj][m][1] * rf;
                ps += ((o0[0] * o0[0] + o0[1] * o0[1]) + (o0[2] * o0[2] + o0[3] * o0[3])) + ((o1[0] * o1[0] + o1[1] * o1[1]) + (o1[2] * o1[2] + o1[3] * o1[3]));
                u32x4 w; w.x = cvt_pk_bf16(o0[0], o0[1]); w.y = cvt_pk_bf16(o0[2], o0[3]); w.z = cvt_pk_bf16(o1[0], o1[1]); w.w = cvt_pk_bf16(o1[2], o1[3]);
                *(u32x4*)(ob + off) = w;
            }
            ps += __shfl_xor(ps, 16); ps += __shfl_xor(ps, 32); if (fq == 0) Pl[(ai * HALF + wr * 64 + m * 16 + fr) * 4 + wc] = ps;
        }
        asm volatile("s_waitcnt lgkmcnt(0)" ::: "memory"); __syncthreads();
        if (threadIdx.x < 256) { const int row = threadIdx.x; atomicAdd(ss + u.pm * BM + row, (Pl[row * 4 + 0] + Pl[row * 4 + 1]) + (Pl[row * 4 + 2] + Pl[row * 4 + 3])); }
    }
};


struct EpiResFinal {
    static constexpr bool PERM = true, AFTER_DRAIN = true, MIDSCALE = false;
    const bf16_t* residh; float* out; float* ss; unsigned* cnt; const float* gain; float alpha;
    __device__ __forceinline__ void fused(f32x4 (&acc)[2][2][4][2], const Unit& u, int wr, int wc, int fr, int fq, PG8_LAS unsigned char* lds, int wid, int lane) const {
        const int col0 = u.pn * BM + wc * 32 + 8 * fq, s0 = u.pm * BM + wr * 64 + fr;
        PG8_LAS float* Pl = (PG8_LAS float*)lds; PG8_LAS float* Tl = (PG8_LAS float*)(lds + 4096);
        u32x4 rh[3][2];
        EPI_LOADH(0); EPI_LOADH(1);
#pragma unroll
        for (int q = 0; q < 8; ++q) {
            const int ai = q >> 2, m = q & 3;
            if (q + 2 < 8) EPI_LOADH(q + 2);
            float ps = 0.f;
#pragma unroll
            for (int bj = 0; bj < 2; ++bj) {
                const f32x4 o0 = EPI_UNLO(rh[q % 3][bj]) + acc[ai][bj][m][0] * alpha, o1 = EPI_UNHI(rh[q % 3][bj]) + acc[ai][bj][m][1] * alpha;
                acc[ai][bj][m][0] = o0; acc[ai][bj][m][1] = o1;
                ps += ((o0[0] * o0[0] + o0[1] * o0[1]) + (o0[2] * o0[2] + o0[3] * o0[3])) + ((o1[0] * o1[0] + o1[1] * o1[1]) + (o1[2] * o1[2] + o1[3] * o1[3]));
            }
            ps += __shfl_xor(ps, 16); ps += __shfl_xor(ps, 32);
            if (fq == 0) Pl[(ai * HALF + wr * 64 + m * 16 + fr) * 4 + wc] = ps;
        }
        asm volatile("s_waitcnt lgkmcnt(0)" ::: "memory"); __syncthreads();
        if (threadIdx.x < 256) {
            const int row = threadIdx.x;
            const float part = (Pl[row * 4 + 0] + Pl[row * 4 + 1]) + (Pl[row * 4 + 2] + Pl[row * 4 + 3]);
            unsigned* sl = (unsigned*)ss + ((size_t)u.pm * 4) * 256 + row;
            __hip_atomic_store(sl + u.pn * 256, __builtin_bit_cast(unsigned, part) | 1u, __ATOMIC_RELAXED, __HIP_MEMORY_SCOPE_AGENT);
            float pv[4];
#pragma unroll
            for (int p2 = 0; p2 < 4; ++p2) { unsigned v = __builtin_bit_cast(unsigned, part) | 1u, spins = 0u;
                if (p2 != u.pn) { while ((v = __hip_atomic_load(sl + p2 * 256, __ATOMIC_RELAXED, __HIP_MEMORY_SCOPE_AGENT)) == 0u && ++spins < (1u << 20)) __builtin_amdgcn_s_sleep(1); }
                pv[p2] = __builtin_bit_cast(float, v); }
            const float tot = (pv[0] + pv[1]) + (pv[2] + pv[3]);
            Tl[row] = rstd_of(tot, 1.0f / 1024.0f);
        }
        asm volatile("s_waitcnt vmcnt(0) lgkmcnt(0)" ::: "memory"); __syncthreads();
        f32x4 gv[2][2];
#pragma unroll
        for (int bj = 0; bj < 2; ++bj)
#pragma unroll
            for (int n = 0; n < 2; ++n) gv[bj][n] = *(const f32x4*)(gain + col0 + bj * HALF + 4 * n);
#pragma unroll
        for (int q = 0; q < 8; ++q) {
            const int ai = q >> 2, m = q & 3; const int s = s0 + ai * HALF + m * 16;
            const float rs = Tl[ai * HALF + wr * 64 + m * 16 + fr];
#pragma unroll
            for (int bj = 0; bj < 2; ++bj)
#pragma unroll
                for (int n = 0; n < 2; ++n) *(f32x4*)(out + (size_t)s * 1024 + col0 + bj * HALF + 4 * n) = acc[ai][bj][m][n] * rs * gv[bj][n];
        }
    }
};
#undef EPI_LOADH
#undef EPI_UNLO
#undef EPI_UNHI
}

constexpr int NWAVES = 8;
constexpr int DM = 1024, LTOK = 16400, LP = 16640, SEQ = 16384, NMETA = 16, FF = 2816;
constexpr size_t MiB = 1u << 20;
constexpr size_t WS_CTL = 0, CTL_BYTES = MiB;
constexpr size_t CT_SS1 = 0, CT_SS2 = 128 * 1024, CT_MACC = 256 * 1024, CT_MCNT = 384 * 1024, CT_BAR = 512 * 1024, CT_TIX = 640 * 1024, CT_SSA = 768 * 1024, CT_SSF = 832 * 1024, CT_PCNT = 900 * 1024, CT_SS3 = 920 * 1024;
constexpr int MISC_OFF = 147456 - 256;
constexpr size_t WS_SS0 = 1 * MiB, WS_A1 = 1 * MiB + 128 * 1024, WS_A3 = 1 * MiB + 256 * 1024, WS_SLOT = 1 * MiB + 512 * 1024;
constexpr size_t WS_WGU1 = 2 * MiB, WS_WD1 = 13 * MiB, WS_WQKV = 19 * MiB, WS_WG = 21 * MiB, WS_WOUT = 23 * MiB, WS_WGU2 = 25 * MiB, WS_WD2 = 36 * MiB;
constexpr size_t WS_HID = 48 * MiB, WS_X = 48 * MiB, WS_X1 = 92 * MiB;
constexpr size_t WS_XB = 144 * MiB;
constexpr size_t WS_Q = 178 * MiB, WS_K = 195 * MiB, WS_VT = 200 * MiB;
constexpr size_t WS_Y = 178 * MiB, WS_H2B = 178 * MiB;
constexpr size_t WS_PERM = 212 * MiB, WS_O = 212 * MiB;
constexpr size_t WS_END = 246 * MiB;
constexpr int LDS_BYTES = 147456;

#define LAS __attribute__((address_space(3)))
typedef unsigned short bf16;
typedef unsigned v4u __attribute__((ext_vector_type(4)));
typedef unsigned v2u __attribute__((ext_vector_type(2)));
typedef float f32x4 __attribute__((ext_vector_type(4)));
typedef short bf16x8 __attribute__((ext_vector_type(8)));
#define LDS_WAIT() asm volatile("s_waitcnt lgkmcnt(0)" ::: "memory")
__device__ __forceinline__ unsigned f2bf(float f) { unsigned u = __builtin_bit_cast(unsigned, f); return (u + 0x7fffu + ((u >> 16) & 1u)) >> 16; }
__device__ __forceinline__ unsigned pk2(float lo, float hi) { return f2bf(lo) | (f2bf(hi) << 16); }
__device__ __forceinline__ float bf2f(unsigned h) { return __builtin_bit_cast(float, h << 16); }
__device__ __forceinline__ float wave_sum(float v) {
#pragma unroll
    for (int o = 1; o < 64; o <<= 1) v += __shfl_xor(v, o);
    return v;
}
__device__ __forceinline__ float wave_max(float v) {
#pragma unroll
    for (int o = 1; o < 64; o <<= 1) v = fmaxf(v, __shfl_xor(v, o));
    return v;
}

struct Args { const float* in[19]; float* out; unsigned char* ws; };

#define XB_TMO      128
#define XB_XCNT(j)  (256  + 64 * (j))
#define XB_XSUB(j)  (1280 + 64 * (j))
#define XB_XGEN(j)  (2304 + 64 * (j))
#define XB_TOP      3328
#define XB_TOPGEN   3392
#define XCD_BAR_WORDS 3456
#define XB_SPIN_CAP (1u << 18)

__device__ __forceinline__ unsigned xb_ld(unsigned* p)              { return __hip_atomic_load(p, __ATOMIC_RELAXED, __HIP_MEMORY_SCOPE_AGENT); }
__device__ __forceinline__ unsigned xb_add(unsigned* p, unsigned v) { return __hip_atomic_fetch_add(p, v, __ATOMIC_RELAXED, __HIP_MEMORY_SCOPE_AGENT); }
__device__ __forceinline__ unsigned xb_xcc_id() { return (unsigned)__builtin_amdgcn_s_getreg((3 << 11) | 20) & 0xFu; }
#define XB_SPIN(cond, bar) do { unsigned _sp = 0; while (cond) { __builtin_amdgcn_s_sleep(1); \
    if ((++_sp & 255u) == 0u) { if (xb_ld(&(bar)[XB_TMO])) break; if (_sp > XB_SPIN_CAP) { atomicAdd(&(bar)[XB_TMO], 1u); break; } } } } while (0)

struct XcdBarrier {
    unsigned* bar; unsigned x;
    volatile LAS unsigned* st;
};

__device__ __forceinline__ XcdBarrier xcd_barrier_post(unsigned* bar, volatile LAS unsigned* st) {
    XcdBarrier b; b.bar = bar; b.x = xb_xcc_id(); b.st = st;
    if (threadIdx.x == 0) (void)xb_add(&bar[XB_XCNT(b.x)], 1u);
    return b;
}
__device__ __forceinline__ void xcd_barrier_complete(unsigned* bar, unsigned x, unsigned& nloc, unsigned& nx) {
    const unsigned G = gridDim.x * gridDim.y * gridDim.z;
    unsigned sum, cnt, mine, sp = 0u;
    for (;;) {
        sum = 0u; cnt = 0u; mine = 0u;
#pragma unroll
        for (unsigned j = 0; j < 16; ++j) { const unsigned c = xb_ld(&bar[XB_XCNT(j)]); sum += c; cnt += (c > 0u) ? 1u : 0u; mine = (j == x) ? c : mine; }
        if (sum == G) break;
        __builtin_amdgcn_s_sleep(1);
        if ((++sp & 255u) == 0u) { if (xb_ld(&bar[XB_TMO])) break; if (sp > XB_SPIN_CAP) { atomicAdd(&bar[XB_TMO], 1u); break; } }
    }
    nloc = mine > 0u ? mine : 1u; nx = cnt > 0u ? cnt : 1u;
}

__device__ __forceinline__ void xcd_barrier(const XcdBarrier& b) {
    asm volatile("s_waitcnt vmcnt(0)" ::: "memory");
    __syncthreads();
    if (threadIdx.x == 0) {
        unsigned* bar = b.bar;
        __builtin_amdgcn_s_waitcnt(0);
        unsigned nloc = b.st[0], nx = b.st[1];
        if (nloc == 0u) { xcd_barrier_complete(bar, b.x, nloc, nx); b.st[0] = nloc; b.st[1] = nx; }
        const unsigned old = xb_add(&bar[XB_XSUB(b.x)], 1u);
        const unsigned gen = old / nloc;
        if (old + 1u == (gen + 1u) * nloc) {
            __builtin_amdgcn_fence(__ATOMIC_RELEASE, "agent");
            asm volatile("s_waitcnt vmcnt(0)" ::: "memory");
            const unsigned og = xb_add(&bar[XB_TOP], 1u);
            const unsigned tg = og / nx;
            if (og + 1u == (tg + 1u) * nx) xb_add(&bar[XB_TOPGEN], 1u);
            else XB_SPIN(xb_ld(&bar[XB_TOPGEN]) == tg, bar);
            __builtin_amdgcn_fence(__ATOMIC_ACQUIRE, "agent");
            xb_add(&bar[XB_XGEN(b.x)], 1u);
            asm volatile("s_waitcnt vmcnt(0)" ::: "memory");
        } else {
            XB_SPIN(xb_ld(&bar[XB_XGEN(b.x)]) == gen, bar);
            __builtin_amdgcn_fence(__ATOMIC_ACQUIRE, "agent");
            asm volatile("s_waitcnt vmcnt(0)" ::: "memory");
        }
    }
    __syncthreads();
}


__device__ __forceinline__ int dest_row(int mode, int n, int bj) {
    if (mode == 1) return 256 * (n >> 7) + 128 * bj + (n & 127);
    if (mode == 2) { const int hs = n >> 6, dd = n & 63; return 256 * (hs >> 2) + 128 * (dd >> 5) + 32 * (hs & 3) + (dd & 31); }
    return n;
}
#define TR_VARS(P) const float* P##W = nullptr; const float* P##gain = nullptr; bf16* P##WT = nullptr; int P##ldw = 0, P##K = 0, P##mode = 0, P##bj = 0, P##k0 = 0, P##n0 = 0
#define TR_SET(P, w_, g_, wt_, ldw_, K_, mode_, bj_, kb_, nb_) do { P##W = (w_); P##gain = (g_); P##WT = (bf16*)(wt_); P##ldw = (ldw_); P##K = (K_); P##mode = (mode_); P##bj = (bj_); P##k0 = 64 * (kb_); P##n0 = 64 * (nb_); } while (0)
#define TR_DECODE(P, it_) do { constexpr int I_GU = 16 * 44, I_DN = 44 * 16, I_QKV = 16 * 12; int r = (it_); \
    if (r < I_GU) { TR_SET(P, a.in[3], a.in[2], ws + WS_WGU1, FF, DM, 1, 0, r / 44, r % 44); break; } r -= I_GU; \
    if (r < I_GU) { TR_SET(P, a.in[4], a.in[2], ws + WS_WGU1, FF, DM, 1, 1, r / 44, r % 44); break; } r -= I_GU; \
    if (r < I_QKV) { TR_SET(P, a.in[7], a.in[6], ws + WS_WQKV, 1280, DM, 2, 0, r / 12, r % 12); break; } r -= I_QKV; \
    if (r < I_DN) { TR_SET(P, a.in[5], (const float*)nullptr, ws + WS_WD1, DM, FF, 0, 0, r / 16, r % 16); break; } r -= I_DN; \
    if (r < I_GU) { TR_SET(P, a.in[15], a.in[14], ws + WS_WGU2, FF, DM, 1, 0, r / 44, r % 44); break; } r -= I_GU; \
    if (r < I_GU) { TR_SET(P, a.in[16], a.in[14], ws + WS_WGU2, FF, DM, 1, 1, r / 44, r % 44); break; } r -= I_GU; \
    if (r < I_DN) { TR_SET(P, a.in[17], (const float*)nullptr, ws + WS_WD2, DM, FF, 0, 0, r / 16, r % 16); break; } r -= I_DN; \
    TR_SET(P, a.in[13], (r / 16) < 8 ? a.in[11] : a.in[12] - 512, ws + WS_WOUT, DM, DM, 0, 0, r / 16, r % 16); } while (0)
#define TR_LOAD(P, v) do { _Pragma("unroll") for (int i = 0; i < 16; ++i) { const int kk = 4 * i + (lane >> 4); \
        f32x4 x = __builtin_nontemporal_load((const f32x4*)(P##W + (size_t)(P##k0 + kk) * P##ldw + P##n0 + 4 * (lane & 15))); if (P##gain) x = x * P##gain[P##k0 + kk]; v[i] = x; } } while (0)
#define TR_FINISH(P, v) do { _Pragma("unroll") for (int i = 0; i < 16; ++i) { LAS float* w_ = scr + (4 * i + (lane >> 4)) * 65 + 4 * (lane & 15); w_[0] = v[i].x; w_[1] = v[i].y; w_[2] = v[i].z; w_[3] = v[i].w; } \
    LDS_WAIT(); asm volatile("" ::: "memory"); \
    _Pragma("unroll") for (int j = 0; j < 8; ++j) { const int n = (lane >> 3) + 8 * j; const LAS float* s_ = scr + (8 * (lane & 7)) * 65 + n; \
        v4u o; o.x = pk2(s_[0 * 65], s_[1 * 65]); o.y = pk2(s_[2 * 65], s_[3 * 65]); o.z = pk2(s_[4 * 65], s_[5 * 65]); o.w = pk2(s_[6 * 65], s_[7 * 65]); \
        *(v4u*)(P##WT + (size_t)dest_row(P##mode, P##n0 + n, P##bj) * P##K + P##k0 + 8 * (lane & 7)) = o; } \
    LDS_WAIT(); asm volatile("" ::: "memory"); } while (0)
__device__ __forceinline__ void wg_item(const float* Win, const float* gmix, bf16* WG, int g, int dq, int lane) {
    float re[4], im[4], gm[4];
#pragma unroll
    for (int dd = 0; dd < 4; ++dd) { re[dd] = 0.f; im[dd] = 0.f; gm[dd] = gmix[4 * dq + dd] * 0.125f; }
    const float* wrow = Win + (size_t)(4 * dq) * 1280 + 768 + 64 * g;
#pragma unroll 16
    for (int j = 0; j < 64; ++j) {
        const float ph = (float)((j * lane) & 63) * (1.0f / 64.0f);
        const float c = __builtin_amdgcn_cosf(ph), sn = __builtin_amdgcn_sinf(ph);
#pragma unroll
        for (int dd = 0; dd < 4; ++dd) { const float w = wrow[dd * 1280 + j]; re[dd] += w * c; im[dd] -= w * sn; }
    }
    *(v2u*)(WG + (size_t)(64 * g + lane) * 1024 + 4 * dq) = (v2u){pk2(re[0] * gm[0], re[1] * gm[1]), pk2(re[2] * gm[2], re[3] * gm[3])};
    *(v2u*)(WG + (size_t)(512 + 64 * g + lane) * 1024 + 4 * dq) = (v2u){pk2(im[0] * gm[0], im[1] * gm[1]), pk2(im[2] * gm[2], im[3] * gm[3])};
}

#define TR_RUN(it0_, stride_, itend_) do { f32x4 vA[16], vB[16]; TR_VARS(A_); TR_VARS(B_); \
        int it = (it0_); \
        if (it < (itend_)) { TR_DECODE(A_, it); TR_LOAD(A_, vA); } \
        while (it < (itend_)) { \
            const int it2 = it + (stride_); \
            if (it2 < (itend_)) { TR_DECODE(B_, it2); TR_LOAD(B_, vB); } \
            TR_FINISH(A_, vA); \
            if (it2 >= (itend_)) break; \
            const int it3 = it2 + (stride_); \
            if (it3 < (itend_)) { TR_DECODE(A_, it3); TR_LOAD(A_, vA); } \
            TR_FINISH(B_, vB); \
            it = it3; } } while (0)
__device__ __forceinline__ void late_weights(const Args& a, LAS unsigned char* lds, int first, int last, int widx, int nw, int lane, int wave) {
    unsigned char* ws = a.ws;
    LAS float* scr = (LAS float*)(lds + wave * 17408);
    TR_RUN(first + widx, nw, last);
}
constexpr int TR_N0 = 2 * (16 * 44), TR_N1 = TR_N0 + 16 * 12 + 44 * 16, TR_N = TR_N1 + 2 * (16 * 44) + 44 * 16 + 16 * 16;
__device__ __forceinline__ void p0_prologue(const Args& a, LAS unsigned char* lds, int tid, int lane, int wave) {
    unsigned char* ws = a.ws;
    LAS float* scr = (LAS float*)(lds + wave * 17408);
    const int gw = blockIdx.x * NWAVES + wave, NGW = gridDim.x * NWAVES;
    TR_RUN(gw, NGW, TR_N0);
    for (int it = gw; it < 2048; it += NGW) wg_item(a.in[7], a.in[6], (bf16*)(ws + WS_WG), it >> 8, it & 255, lane);
    {
        bf16* A1 = (bf16*)(ws + WS_A1); bf16* A3 = (bf16*)(ws + WS_A3);
        const int gt = gw * 64 + lane, NGT = NGW * 64;
        for (int e = gt; e < 256 * 256 + 256 * 384; e += NGT) {
            if (e < 65536) {
                const int rr = e >> 8, kk = e & 255, ai = rr >> 7, beta = rr & 127, part = kk >> 7, b = kk & 127; float v = 0.f;
                if (beta < 100 && b < 100) { const float ph = (float)((beta * b) % 100) * 0.01f; const float c = __builtin_amdgcn_cosf(ph) * 0.1f, s = __builtin_amdgcn_sinf(ph) * 0.1f;
                    v = ai == 0 ? (part == 0 ? c : s) : (part == 0 ? -s : c); }
                A1[e] = (bf16)f2bf(v);
            } else {
                const int e3 = e - 65536, al = e3 / 384, kk = e3 - al * 384, part = kk >= 192 ? 1 : 0, aa = kk - 192 * part; float v = 0.f;
                if (al < 164 && aa < 164) { const float ph = (float)((al * aa) % 164) * (1.0f / 164.0f); const float sc = 0.07808688094430304f;
                    v = (part == 0 ? __builtin_amdgcn_cosf(ph) : __builtin_amdgcn_sinf(ph)) * sc; }
                A3[e3] = (bf16)f2bf(v);
            }
        }
        v4u* pz = (v4u*)((bf16*)(ws + WS_PERM) + (size_t)LTOK * DM);
        for (int e = gt; e < (LP - LTOK) * DM / 8; e += NGT) pz[e] = (v4u){0u, 0u, 0u, 0u};
        v4u* ps_ = (v4u*)(ws + WS_SLOT);
        for (int e = gt; e < 256 * 1024 / 16; e += NGT) ps_[e] = (v4u){0u, 0u, 0u, 0u};
    }
    {
        bf16* xb = (bf16*)(ws + WS_XB); float* ss0 = (float*)(ws + WS_SS0);
#define XB_LOAD(V, T0) do { _Pragma("unroll") for (int r = 0; r < 4; ++r) { const int t = (T0) + r; \
            const float* src = t < NMETA ? a.in[1] + (size_t)t * DM : a.in[0] + (size_t)(t - NMETA) * DM; \
            _Pragma("unroll") for (int j = 0; j < 4; ++j) V[r][j] = t < LTOK ? __builtin_nontemporal_load((const f32x4*)src + lane + 64 * j) : (f32x4){0.f, 0.f, 0.f, 0.f}; } } while (0)
#define XB_FINISH(V, T0) do { float q[4]; \
            _Pragma("unroll") for (int r = 0; r < 4; ++r) { float s_ = 0.f; \
                _Pragma("unroll") for (int j = 0; j < 4; ++j) s_ += (V[r][j].x * V[r][j].x + V[r][j].y * V[r][j].y) + (V[r][j].z * V[r][j].z + V[r][j].w * V[r][j].w); q[r] = s_; } \
            _Pragma("unroll") for (int o = 1; o < 64; o <<= 1) { _Pragma("unroll") for (int r = 0; r < 4; ++r) q[r] += __shfl_xor(q[r], o); } \
            _Pragma("unroll") for (int r = 0; r < 4; ++r) { const int t = (T0) + r; if (lane == 0) ss0[t] = q[r]; \
                v2u* o8 = (v2u*)(xb + (size_t)t * DM) + lane; \
                _Pragma("unroll") for (int j = 0; j < 4; ++j) o8[64 * j] = (v2u){pk2(V[r][j].x, V[r][j].y), pk2(V[r][j].z, V[r][j].w)}; } } while (0)
        f32x4 va[4][4], vb4[4][4];
        int t0 = 4 * gw;
        if (t0 < LP) XB_LOAD(va, t0);
        while (t0 < LP) {
            const int t1 = t0 + 4 * NGW;
            if (t1 < LP) XB_LOAD(vb4, t1);
            XB_FINISH(va, t0);
            if (t1 >= LP) break;
            const int t2 = t1 + 4 * NGW;
            if (t2 < LP) XB_LOAD(va, t2);
            XB_FINISH(vb4, t1);
            t0 = t2;
        }
#undef XB_LOAD
#undef XB_FINISH
    }
}

__device__ __forceinline__ void meta_down(const Args& a, LAS unsigned char* lds, int tid, int lane, int wave) {
    unsigned char* ws = a.ws;
    const int cgp = blockIdx.x & 15, kq = (blockIdx.x >> 4) & 15, n0 = 64 * cgp, kbase = 176 * kq;
    LAS float* hk = (LAS float*)lds; LAS float* red = (LAS float*)(lds + 16384); LAS unsigned* flag = (LAS unsigned*)(lds + 16384 + 32768);
    const bf16* HID = (const bf16*)(ws + WS_HID);
    float* macc = (float*)(ws + WS_CTL + CT_MACC); unsigned* mcnt = (unsigned*)(ws + WS_CTL + CT_MCNT); float* ss1 = (float*)(ws + WS_CTL + CT_SS1);
    if (tid < 16 * 22) { const int r = tid / 22, k8 = (tid - r * 22) * 8; const v4u w = *(const v4u*)(HID + (size_t)r * FF + kbase + k8);
        hk[(k8 + 0) * 16 + r] = bf2f(w.x & 0xffffu); hk[(k8 + 1) * 16 + r] = bf2f(w.x >> 16); hk[(k8 + 2) * 16 + r] = bf2f(w.y & 0xffffu); hk[(k8 + 3) * 16 + r] = bf2f(w.y >> 16);
        hk[(k8 + 4) * 16 + r] = bf2f(w.z & 0xffffu); hk[(k8 + 5) * 16 + r] = bf2f(w.z >> 16); hk[(k8 + 6) * 16 + r] = bf2f(w.w & 0xffffu); hk[(k8 + 7) * 16 + r] = bf2f(w.w >> 16); }
    const float* wp = a.in[5] + (size_t)(kbase + 22 * wave) * DM + n0 + lane;
    float wv[22];
#pragma unroll
    for (int k = 0; k < 22; ++k) wv[k] = wp[(size_t)k * DM];
    __syncthreads();
    float acc[16];
#pragma unroll
    for (int r = 0; r < 16; ++r) acc[r] = 0.f;
#pragma unroll
    for (int k = 0; k < 22; ++k) {
        const float w = wv[k]; const LAS f32x4* h = (const LAS f32x4*)(hk + (22 * wave + k) * 16);
        const f32x4 h0 = h[0], h1 = h[1], h2 = h[2], h3 = h[3];
        acc[0] += w * h0.x; acc[1] += w * h0.y; acc[2] += w * h0.z; acc[3] += w * h0.w; acc[4] += w * h1.x; acc[5] += w * h1.y; acc[6] += w * h1.z; acc[7] += w * h1.w;
        acc[8] += w * h2.x; acc[9] += w * h2.y; acc[10] += w * h2.z; acc[11] += w * h2.w; acc[12] += w * h3.x; acc[13] += w * h3.y; acc[14] += w * h3.z; acc[15] += w * h3.w;
        if ((k & 3) == 3) asm volatile("" ::: "memory");
    }
#pragma unroll
    for (int r = 0; r < 16; ++r) red[(wave * 16 + r) * 64 + lane] = acc[r];
    __syncthreads();
    for (int o = tid; o < 1024; o += NWAVES * 64) { const int r = o >> 6, n = o & 63; float s = 0.f;
#pragma unroll
        for (int w = 0; w < 8; ++w) s += red[(w * 16 + r) * 64 + n];
        atomicAdd(macc + r * DM + n0 + n, s); }
    __syncthreads();
}
__device__ __forceinline__ void meta_down_finish(const Args& a, LAS unsigned char* lds, int tid) {
    unsigned char* ws = a.ws;
    const int cgp = blockIdx.x & 15, n0 = 64 * cgp;
    LAS unsigned* flag = (LAS unsigned*)(lds + 16384 + 32768);
    float* macc = (float*)(ws + WS_CTL + CT_MACC); unsigned* mcnt = (unsigned*)(ws + WS_CTL + CT_MCNT); float* ss1 = (float*)(ws + WS_CTL + CT_SS1);
    asm volatile("s_waitcnt vmcnt(0)" ::: "memory"); __syncthreads();
    if (tid == 0) { const unsigned old = atomicAdd(mcnt + cgp, 1u); flag[0] = (old == 15u) ? 1u : 0u; }
    __syncthreads();
    if (flag[0]) {
        const int r = tid >> 5, nn = (tid & 31) * 2;
        const float v0 = __hip_atomic_load(macc + r * DM + n0 + nn, __ATOMIC_RELAXED, __HIP_MEMORY_SCOPE_AGENT), v1 = __hip_atomic_load(macc + r * DM + n0 + nn + 1, __ATOMIC_RELAXED, __HIP_MEMORY_SCOPE_AGENT);
        const float h0 = a.in[1][r * DM + n0 + nn] + 0.5f * v0, h1 = a.in[1][r * DM + n0 + nn + 1] + 0.5f * v1;
        const unsigned w = pk2(h0, h1);
        *(unsigned*)((bf16*)(ws + WS_XB) + (size_t)r * DM + n0 + nn) = w;
        *(unsigned*)((bf16*)(ws + WS_PERM) + (size_t)(100 * r) * DM + n0 + nn) = w;
        float ps = h0 * h0 + h1 * h1;
#pragma unroll
        for (int o = 1; o < 32; o <<= 1) ps += __shfl_xor(ps, o);
        if ((tid & 31) == 0) atomicAdd(ss1 + r, ps);
    }
    __syncthreads();
}

#define ATT_LOAD(KF, VF, si) do { const int kk0_ = (si) == 0 ? 0 : ks + 32 * ((si) - 1); \
    _Pragma("unroll") for (int T = 0; T < 2; ++T) { const int krow = kk0_ + 8 * (i >> 2) + 4 * T + (i & 3); \
        _Pragma("unroll") for (int hf = 0; hf < 2; ++hf) KF[T][hf] = *(const bf16x8*)(Kb + (size_t)krow * 128 + kvh * 64 + hf * 32 + 8 * g); } \
    _Pragma("unroll") for (int dt = 0; dt < 4; ++dt) VF[dt] = *(const bf16x8*)(Vt + (size_t)(kvh * 64 + dt * 16 + i) * LP + kk0_ + 8 * g); } while (0)
#define ATT_COMPUTE(KF, VF, si) do { const bool metastep = (si) == 0; const int kk0_ = metastep ? 0 : ks + 32 * ((si) - 1); \
    float fd[8]; bool vl[8]; \
    _Pragma("unroll") for (int e = 0; e < 8; ++e) { const int tk = kk0_ + 8 * g + e; int dist = tq - tk; dist = dist < 0 ? -dist : dist; \
        vl[e] = metastep ? (tk < NMETA) : (dist <= 128 && tk >= NMETA && tk < LTOK); fd[e] = (float)(dist > 128 ? 128 : dist); } \
    _Pragma("unroll") for (int h = 0; h < 4; ++h) { float p[8]; \
        _Pragma("unroll") for (int T = 0; T < 2; ++T) { f32x4 S = (f32x4){0.f, 0.f, 0.f, 0.f}; \
            S = __builtin_amdgcn_mfma_f32_16x16x32_bf16(KF[T][0], Qf[h][0], S, 0, 0, 0); \
            S = __builtin_amdgcn_mfma_f32_16x16x32_bf16(KF[T][1], Qf[h][1], S, 0, 0, 0); \
            _Pragma("unroll") for (int j = 0; j < 4; ++j) { const float ex = __builtin_amdgcn_exp2f(S[j] - slope[h] * fd[4 * T + j] - M0); p[4 * T + j] = vl[4 * T + j] ? ex : 0.f; } } \
        l[h] += ((p[0] + p[1]) + (p[2] + p[3])) + ((p[4] + p[5]) + (p[6] + p[7])); \
        v4u pw; pw.x = pg8::cvt_pk_bf16(p[0], p[1]); pw.y = pg8::cvt_pk_bf16(p[2], p[3]); pw.z = pg8::cvt_pk_bf16(p[4], p[5]); pw.w = pg8::cvt_pk_bf16(p[6], p[7]); \
        const bf16x8 P = __builtin_bit_cast(bf16x8, pw); \
        _Pragma("unroll") for (int dt = 0; dt < 4; ++dt) Oa[h][dt] = __builtin_amdgcn_mfma_f32_16x16x32_bf16(VF[dt], P, Oa[h][dt], 0, 0, 0); } } while (0)
__device__ __forceinline__ void attn_phase(const Args& a, int lane, int wave) {
    unsigned char* ws = a.ws;
    const bf16* Q = (const bf16*)(ws + WS_Q); const bf16* Kb = (const bf16*)(ws + WS_K); const bf16* Vt = (const bf16*)(ws + WS_VT); bf16* O = (bf16*)(ws + WS_PERM); float* ssA = (float*)(ws + WS_CTL + CT_SSA);
    const int i = lane & 15, g = lane >> 4;
    constexpr float L2E = 1.4426950408889634f;
    const float gq = wave_max(fabsf(a.in[8][lane])), gk = wave_max(fabsf(a.in[9][lane]));
    const float M0 = fminf(8.0f * gq * gk, 80.0f) * L2E;
    const int gw = blockIdx.x * NWAVES + wave, NGW = gridDim.x * NWAVES;
    for (int unit = gw; unit < 2048; unit += NGW) {
        const int qt = unit >> 1, kvh = unit & 1;
        const int tq0 = NMETA + 16 * qt, tq = tq0 + i;
        bf16x8 Qf[4][2];
#pragma unroll
        for (int h = 0; h < 4; ++h)
#pragma unroll
            for (int hf = 0; hf < 2; ++hf) Qf[h][hf] = *(const bf16x8*)(Q + (size_t)tq * 512 + (kvh * 4 + h) * 64 + hf * 32 + 8 * g);
        f32x4 Oa[4][4]; float l[4], slope[4];
#pragma unroll
        for (int h = 0; h < 4; ++h) { l[h] = 0.f; slope[h] = __builtin_amdgcn_exp2f(-(float)(kvh * 4 + h + 1)) * L2E;
#pragma unroll
            for (int dt = 0; dt < 4; ++dt) Oa[h][dt] = (f32x4){0.f, 0.f, 0.f, 0.f}; }
        const int ks = (tq0 - 128) < 0 ? 0 : ((tq0 - 128) & ~31), ke = (tq0 + 143) & ~31;
        const int nsteps = 2 + (ke - ks) / 32;
        bf16x8 KfA[2][2], VfA[4], KfB[2][2], VfB[4];
        ATT_LOAD(KfA, VfA, 0);
        for (int si = 0; si < nsteps; si += 2) {
            if (si + 1 < nsteps) ATT_LOAD(KfB, VfB, si + 1);
            ATT_COMPUTE(KfA, VfA, si);
            if (si + 1 < nsteps) {
                if (si + 2 < nsteps) ATT_LOAD(KfA, VfA, si + 2);
                ATT_COMPUTE(KfB, VfB, si + 1);
            }
        }
        float sq = 0.f;
#pragma unroll
        for (int h = 0; h < 4; ++h) {
            float lt = l[h]; lt += __shfl_xor(lt, 16); lt += __shfl_xor(lt, 32);
            lt += __builtin_amdgcn_exp2f(a.in[10][kvh * 4 + h] * L2E - M0);
            const float inv = 1.0f / lt;
#pragma unroll
            for (int dt = 0; dt < 4; ++dt) { const f32x4 o = Oa[h][dt] * inv;
                sq += (o[0] * o[0] + o[1] * o[1]) + (o[2] * o[2] + o[3] * o[3]);
                *(v2u*)(O + (size_t)(tq - NMETA) * DM + (kvh * 4 + h) * 64 + dt * 16 + 4 * g) = (v2u){pg8::cvt_pk_bf16(o[0], o[1]), pg8::cvt_pk_bf16(o[2], o[3])}; }
        }
        sq += __shfl_xor(sq, 16); sq += __shfl_xor(sq, 32);
        if (g == 0) atomicAdd(ssA + (tq - NMETA), sq);
    }
}

__device__ __forceinline__ void mixnorm_phase(const Args& a, int lane, int wave) {
    unsigned char* ws = a.ws;
    const bf16* O = (const bf16*)(ws + WS_O); const float* Y = (const float*)(ws + WS_Y); bf16* MX = (bf16*)(ws + WS_XB);
    const int gw = blockIdx.x * NWAVES + wave, NGW = gridDim.x * NWAVES;
    for (int s0 = 4 * gw; s0 < SEQ; s0 += 4 * NGW) {
        v4u ov[4]; f32x4 y0[4], y1[4]; float sa[4], sf[4];
#pragma unroll
        for (int r = 0; r < 4; ++r) { const int s = s0 + r; ov[r] = *(const v4u*)(O + (size_t)s * 512 + 8 * lane);
            y0[r] = *(const f32x4*)(Y + (size_t)(NMETA + s) * 512 + 8 * lane); y1[r] = *(const f32x4*)(Y + (size_t)(NMETA + s) * 512 + 8 * lane + 4); }
        float of[4][8];
#pragma unroll
        for (int r = 0; r < 4; ++r) {
            of[r][0] = bf2f(ov[r].x & 0xffffu); of[r][1] = bf2f(ov[r].x >> 16); of[r][2] = bf2f(ov[r].y & 0xffffu); of[r][3] = bf2f(ov[r].y >> 16);
            of[r][4] = bf2f(ov[r].z & 0xffffu); of[r][5] = bf2f(ov[r].z >> 16); of[r][6] = bf2f(ov[r].w & 0xffffu); of[r][7] = bf2f(ov[r].w >> 16);
            float t = 0.f;
#pragma unroll
            for (int j = 0; j < 8; ++j) t += of[r][j] * of[r][j];
            sa[r] = t;
            sf[r] = (y0[r].x * y0[r].x + y0[r].y * y0[r].y) + (y0[r].z * y0[r].z + y0[r].w * y0[r].w) + (y1[r].x * y1[r].x + y1[r].y * y1[r].y) + (y1[r].z * y1[r].z + y1[r].w * y1[r].w);
        }
#pragma unroll
        for (int o = 1; o < 64; o <<= 1) {
#pragma unroll
            for (int r = 0; r < 4; ++r) { sa[r] += __shfl_xor(sa[r], o); sf[r] += __shfl_xor(sf[r], o); } }
#pragma unroll
        for (int r = 0; r < 4; ++r) { const int s = s0 + r;
            const float ra = pg8::rstd_of(sa[r], 1.0f / 512.0f), rf = pg8::rstd_of(sf[r], 1.0f / 512.0f);
            *(v4u*)(MX + (size_t)s * DM + 8 * lane) = (v4u){pk2(of[r][0] * ra, of[r][1] * ra), pk2(of[r][2] * ra, of[r][3] * ra), pk2(of[r][4] * ra, of[r][5] * ra), pk2(of[r][6] * ra, of[r][7] * ra)};
            *(v4u*)(MX + (size_t)s * DM + 512 + 8 * lane) = (v4u){pk2(y0[r].x * rf, y0[r].y * rf), pk2(y0[r].z * rf, y0[r].w * rf), pk2(y1[r].x * rf, y1[r].y * rf), pk2(y1[r].z * rf, y1[r].w * rf)};
        }
    }
}
__device__ __forceinline__ void finalnorm_phase(const Args& a, float* dst, int lane, int wave) {
    const int gw = blockIdx.x * NWAVES + wave, NGW = gridDim.x * NWAVES;
    const f32x4* gp = (const f32x4*)a.in[18];
    f32x4 gv[4];
#pragma unroll
    for (int j = 0; j < 4; ++j) gv[j] = gp[lane + 64 * j];
    for (int s0 = 4 * gw; s0 < SEQ; s0 += 4 * NGW) {
        f32x4 v[4][4]; float q[4];
#pragma unroll
        for (int r = 0; r < 4; ++r) { const f32x4* row = (const f32x4*)(a.out + (size_t)(s0 + r) * DM);
#pragma unroll
            for (int j = 0; j < 4; ++j) v[r][j] = row[lane + 64 * j]; }
#pragma unroll
        for (int r = 0; r < 4; ++r) { float t = 0.f;
#pragma unroll
            for (int j = 0; j < 4; ++j) t += (v[r][j].x * v[r][j].x + v[r][j].y * v[r][j].y) + (v[r][j].z * v[r][j].z + v[r][j].w * v[r][j].w);
            q[r] = t; }
#pragma unroll
        for (int o = 1; o < 64; o <<= 1) {
#pragma unroll
            for (int r = 0; r < 4; ++r) q[r] += __shfl_xor(q[r], o); }
#pragma unroll
        for (int r = 0; r < 4; ++r) { const float rs = pg8::rstd_of(q[r], 1.0f / 1024.0f); f32x4* orow = (f32x4*)(dst + (size_t)(s0 + r) * DM);
#pragma unroll
            for (int j = 0; j < 4; ++j) orow[lane + 64 * j] = v[r][j] * rs * gv[j]; }
    }
}

#ifndef PROBE_DUP
#define PROBE_DUP 0
#endif
#ifndef PHASE_MASK
#define PHASE_MASK 0xFFFF
#endif
constexpr int PM = PHASE_MASK;
#ifndef PG8_SP2
#define PG8_SP2 true
#endif
#ifndef PG8_ALIGN
#define PG8_ALIGN true
#endif

__global__ void __launch_bounds__(NWAVES * 64, 2) mega_fwd(Args args) {
    extern __shared__ __attribute__((aligned(16))) unsigned char lds_raw[];
    cg::grid_group grid = cg::this_grid();
    LAS unsigned char* lds = (LAS unsigned char*)lds_raw;
    const int tid = threadIdx.x, lane = tid & 63, wave = __builtin_amdgcn_readfirstlane(tid >> 6);
    const int G = gridDim.x, bx = blockIdx.x;
    unsigned char* ws = args.ws;
    float* ss0 = (float*)(ws + WS_SS0); float* ss1 = (float*)(ws + WS_CTL + CT_SS1); float* ss2 = (float*)(ws + WS_CTL + CT_SS2);
    bf16* XB = (bf16*)(ws + WS_XB); bf16* HID = (bf16*)(ws + WS_HID);

    if (tid < 16) ((LAS unsigned*)(lds + MISC_OFF))[tid] = 0u;
    __syncthreads();
    XcdBarrier bar = xcd_barrier_post((unsigned*)(ws + WS_CTL + CT_BAR), (volatile LAS unsigned*)(lds + MISC_OFF));
    if (tid == 0) { const unsigned r = xb_add((unsigned*)(ws + WS_CTL + CT_TIX) + 64 * bar.x, 1u); ((volatile LAS unsigned*)(lds + MISC_OFF))[4] = r * 8u + bar.x; }
    if (args.out == nullptr) grid.sync();
#if PROBE_DUP & 1
    p0_prologue(args, lds, tid, lane, wave); xcd_barrier(bar);
#endif
    if (PM & 1) p0_prologue(args, lds, tid, lane, wave);
    xcd_barrier(bar);
    int vb = bx;
    { bool ok = (G == 256);
      for (int j = 0; j < 8; ++j) ok = ok && (xb_ld((unsigned*)(ws + WS_CTL + CT_BAR) + XB_XCNT(j)) == 32u);
      if (ok) vb = (int)((volatile LAS unsigned*)(lds + MISC_OFF))[4]; vb = __builtin_amdgcn_readfirstlane(vb); }
    if (PM & 2) {
        pg8::Gemm g{XB, (const bf16*)(ws + WS_WGU1), LP, 2 * FF, DM}; pg8::StaticOrder S; S.init(LP, 2 * FF, G, vb);
        pg8::EpiSwiglu E{HID, ss0, FF};
        pg8::gemm_phase<pg8::EpiSwiglu, pg8::StaticOrder, PG8_ALIGN, PG8_SP2>(lds, g, S, E);
        if (vb >= 150) late_weights(args, lds, TR_N0, TR_N1, (vb - 150) * NWAVES + wave, (256 - 150) * NWAVES, lane, wave);
    }
    xcd_barrier(bar);
    if (PM & 4) {
        meta_down(args, lds, tid, lane, wave);
        pg8::Gemm g{HID + (size_t)NMETA * FF, (const bf16*)(ws + WS_WD1), SEQ, DM, FF}; pg8::StaticOrder S; S.init(SEQ, DM, G, vb);
        pg8::EpiRes E{XB + (size_t)NMETA * DM, XB + (size_t)NMETA * DM, (bf16*)(ws + WS_PERM), ss1 + NMETA, 0.5f};
        pg8::gemm_phase<pg8::EpiRes, pg8::StaticOrder, false, PG8_SP2>(lds, g, S, E);
        meta_down_finish(args, lds, tid);
    }
    xcd_barrier(bar);
    if (PM & 8) {
        pg8::Gemm g{XB, (const bf16*)(ws + WS_WQKV), LP, 768, DM}; pg8::StaticOrder S; S.init(LP, 768, G, vb);
        pg8::EpiQKV E{(bf16*)(ws + WS_Q), (bf16*)(ws + WS_K), (bf16*)(ws + WS_VT), ss1, args.in[8], args.in[9], LP};
        pg8::gemm_phase<pg8::EpiQKV, pg8::StaticOrder, PG8_ALIGN, PG8_SP2>(lds, g, S, E);
        pg8::Gemm g0{(const bf16*)(ws + WS_WG), (const bf16*)(ws + WS_PERM), 1024, LP, DM}; pg8::StaticOrder S0; S0.init(1024, LP, G, (vb + 61) & 255);
        pg8::EpiG0 E0{(bf16*)(ws + WS_X), ss1};
        pg8::gemm_phase<pg8::EpiG0, pg8::StaticOrder, PG8_ALIGN, PG8_SP2>(lds, g0, S0, E0);
    }
    xcd_barrier(bar);
    if (PM & 16) {
        int kdim = 256; asm volatile("" : "+s"(kdim));
        pg8::Gemm g{(const bf16*)(ws + WS_A1), (const bf16*)(ws + WS_X), 256, 512 * 164, kdim}; pg8::StaticOrder S; S.init(256, 512 * 164, G, vb);
        pg8::EpiG1 E{(bf16*)(ws + WS_X1)};
        pg8::gemm_phase<pg8::EpiG1, pg8::StaticOrder, PG8_ALIGN, PG8_SP2>(lds, g, S, E);
        attn_phase(args, lane, wave);
        if (vb >= 72) late_weights(args, lds, TR_N1, TR_N1 + 1408, (vb - 72) * NWAVES + wave, (256 - 72) * NWAVES, lane, wave);
    }
    xcd_barrier(bar);
#if PROBE_DUP & 2
    attn_phase(args, lane, wave); xcd_barrier(bar);
#endif
    if (PM & 32) {
        int kdim = 384; asm volatile("" : "+s"(kdim));
        pg8::Gemm g{(const bf16*)(ws + WS_A3), (const bf16*)(ws + WS_X1), 256, 100 * 512, kdim}; pg8::StaticOrder S; S.init(256, 100 * 512, G, vb);
        pg8::EpiG3 E{(bf16*)(ws + WS_PERM), (float*)(ws + WS_CTL + CT_SSF)};
        pg8::gemm_phase<pg8::EpiG3, pg8::StaticOrder, PG8_ALIGN, PG8_SP2>(lds, g, S, E);
        if (vb >= 200) late_weights(args, lds, TR_N1 + 2112, TR_N, (vb - 200) * NWAVES + wave, (256 - 200) * NWAVES, lane, wave);
    }
    xcd_barrier(bar);
    if (PM & 128) {
        pg8::Gemm g{(const bf16*)(ws + WS_PERM), (const bf16*)(ws + WS_WOUT), SEQ, DM, DM}; pg8::StaticOrder S; S.init(SEQ, DM, G, vb);
        pg8::EpiResMix E{XB + (size_t)NMETA * DM, (bf16*)(ws + WS_H2B), ss2, (const float*)(ws + WS_CTL + CT_SSA), (const float*)(ws + WS_CTL + CT_SSF)};
        pg8::gemm_phase<pg8::EpiResMix, pg8::StaticOrder, false, PG8_SP2>(lds, g, S, E);
    }
    xcd_barrier(bar);
    if (PM & 256) {
        pg8::Gemm g{(const bf16*)(ws + WS_H2B), (const bf16*)(ws + WS_WGU2), SEQ, 2 * FF, DM}; pg8::StaticOrder S; S.init(SEQ, 2 * FF, G, vb);
        pg8::EpiSwiglu E{HID, ss2, FF};
        pg8::gemm_phase<pg8::EpiSwiglu, pg8::StaticOrder, PG8_ALIGN, PG8_SP2>(lds, g, S, E);
        if (vb >= 128) late_weights(args, lds, TR_N1 + 1408, TR_N1 + 2112, (vb - 128) * NWAVES + wave, 128 * NWAVES, lane, wave);
    }
    xcd_barrier(bar);
    if (PM & 512) {
        pg8::Gemm g{HID, (const bf16*)(ws + WS_WD2), SEQ, DM, FF}; pg8::StaticOrder S; S.init(SEQ, DM, G, vb);
        pg8::EpiResFinal E{(const bf16*)(ws + WS_H2B), args.out, (float*)(ws + WS_SLOT), (unsigned*)(ws + WS_CTL + CT_PCNT), args.in[18], 0.5f};
        pg8::gemm_phase<pg8::EpiResFinal, pg8::StaticOrder, false, PG8_SP2>(lds, g, S, E);
    }
}

extern "C" void kernel_launch(void* const* d_in, const int* in_sizes, int n_in, void* d_out, int out_size, void* d_ws, size_t ws_size, hipStream_t stream) {
    static int grid = 0;
    if (grid == 0) {
        if (n_in != 19 || out_size != SEQ * DM || ws_size < WS_END) { fprintf(stderr, "kernel_launch: unexpected shapes (n_in %d out %d ws %zu)\n", n_in, out_size, ws_size); grid = -1; return; }
        int dev = 0, cus = 0, per_cu = 0;
        hipGetDevice(&dev); hipDeviceGetAttribute(&cus, hipDeviceAttributeMultiprocessorCount, dev);
        hipFuncSetAttribute((const void*)mega_fwd, hipFuncAttributeMaxDynamicSharedMemorySize, LDS_BYTES);
        hipOccupancyMaxActiveBlocksPerMultiprocessor(&per_cu, (const void*)mega_fwd, NWAVES * 64, LDS_BYTES);
        (void)hipGetLastError();
        if (per_cu < 1) per_cu = 1;
        grid = cus;
        if (grid != 256) fprintf(stderr, "kernel_launch: %d CUs (expected 256)\n", cus);
    }
    if (grid < 0) return;
    hipMemsetAsync((char*)d_ws + WS_CTL, 0, CTL_BYTES, stream);
    Args a{};
    for (int i = 0; i < 19; ++i) a.in[i] = (const float*)d_in[i];
    a.out = (float*)d_out; a.ws = (unsigned char*)d_ws;
    void* kargs[] = {&a};
    hipError_t e = hipLaunchCooperativeKernel((const void*)mega_fwd, dim3(grid), dim3(NWAVES * 64), kargs, LDS_BYTES, stream);
    if (e != hipSuccess) fprintf(stderr, "cooperative launch failed: %s (grid %d)\n", hipGetErrorString(e), grid);
}
```
